# Optimizing an MI355X kernel written in HIP

```python
import math
import jax
import jax.numpy as jnp
from jax import lax
import numpy as np

D_MODEL = 1024
BATCH = 8
SEQ = 2048
DEPTH = 2
DEC_BATCH = 128
DEC_SEQ = 1
PAST_LEN = 16384
PAGE_SIZE = 128

N_META = 16
N_S5_LAYERS = (DEPTH + 1) // 2
N_GDN_LAYERS = DEPTH // 2
S5_GROUP = 16
S5_GROUPS = D_MODEL // S5_GROUP
S5_STATE = 64
S5_BLOCK = 128
S5_DT_MIN = 1e-3
S5_DT_MAX = 1e-1
GDN_HEADS = 8
GDN_DK = D_MODEL // GDN_HEADS
GDN_DV = D_MODEL // GDN_HEADS
GDN_QK = GDN_HEADS * GDN_DK
GDN_VW = GDN_HEADS * GDN_DV
GDN_CONV = 4
GDN_CONV_CH = 2 * GDN_QK + GDN_VW
GDN_IN = GDN_CONV_CH + GDN_VW + 2 * GDN_HEADS
GDN_CHUNK = 64
D_FF = 2816
FFN_CONV = 3
EPS = 1e-6

kernel_name = 'hybrid_s5_gdn_convffn_step'


def rmsnorm(x, w):
    xf = x.astype(jnp.float32)
    y = xf * lax.rsqrt(jnp.mean(xf * xf, axis=-1, keepdims=True) + EPS)
    return (y * w.astype(jnp.float32)).astype(x.dtype)


def l2norm(x):
    xf = x.astype(jnp.float32)
    return xf * lax.rsqrt(jnp.sum(xf * xf, axis=-1, keepdims=True) + 1e-6)


def causal_dwconv(x, buf, w):
    K = w.shape[0]
    T = x.shape[1]
    xp = jnp.concatenate([buf.astype(x.dtype), x], axis=1)
    y = sum(xp[:, j:j + T] * w[j] for j in range(K))
    return y, xp[:, -(K - 1):]


def _linear_combine(e1, e2):
    a1, b1 = e1
    a2, b2 = e2
    return a1 * a2, a2 * b1 + b2


def s5_blocks(u, h0, lam_bar, b_bar, c):
    Bsz, T = u.shape[0], u.shape[1]
    L = math.gcd(T, S5_BLOCK)
    N = T // L
    ub = jnp.moveaxis(u.reshape(Bsz, N, L, S5_GROUPS, S5_GROUP), 1, 0)

    def step(h, u_blk):
        bu = jnp.einsum('blgc,gpc->blgp', u_blk.astype(jnp.complex64), b_bar)
        bu = bu.at[:, 0].add(lam_bar * h)
        a = jnp.broadcast_to(lam_bar, bu.shape)
        _, hs = lax.associative_scan(_linear_combine, (a, bu), axis=1)
        y = jnp.real(jnp.einsum('blgp,gcp->blgc', hs, c))
        return hs[:, -1], y

    h, y = lax.scan(step, h0, ub)
    y = jnp.moveaxis(y, 0, 1).reshape(Bsz, T, D_MODEL)
    return y, h


def s5_mixer(h, st_re, st_im, lam_re, lam_im, log_step, b_re, b_im, c_re, c_im, d_skip, w_glu, segments):
    f32 = jnp.float32
    Bsz, T, _ = h.shape
    lam = lax.complex(lam_re.astype(f32), lam_im.astype(f32))
    delta = jnp.exp(log_step.astype(f32))[:, None]
    lam_bar = jnp.exp(lam * delta)
    b_bar = ((lam_bar - 1.0) / lam)[..., None] * lax.complex(b_re.astype(f32), b_im.astype(f32))
    c = lax.complex(c_re.astype(f32), c_im.astype(f32))
    u = h.astype(f32)
    state = lax.complex(st_re.astype(f32), st_im.astype(f32))
    ys = []
    for s0, s1 in segments:
        y_seg, state = s5_blocks(u[:, s0:s1].reshape(Bsz, s1 - s0, S5_GROUPS, S5_GROUP), state, lam_bar, b_bar, c)
        ys.append(y_seg)
    y = jnp.concatenate(ys, axis=1) + d_skip.astype(f32) * u
    y = jax.nn.gelu(y).astype(h.dtype)
    ag = y @ w_glu
    out = ag[..., :D_MODEL] * jax.nn.sigmoid(ag[..., D_MODEL:])
    return out, jnp.real(state), jnp.imag(state)


def _to_chunks(x, N, C):
    Bsz = x.shape[0]
    x = x.reshape((Bsz, N, C) + x.shape[2:])
    return jnp.transpose(x, (1, 0, 3, 2) + tuple(range(4, x.ndim)))


def gated_delta_chunks(q, k, v, g, beta, S0):
    Bsz, T, H, dk = q.shape
    dv = v.shape[-1]
    C = math.gcd(T, GDN_CHUNK)
    N = T // C
    qc, kc, vc, gc, bc = [_to_chunks(t, N, C) for t in (q, k, v, g, beta)]
    tri_incl = jnp.tril(jnp.ones((C, C), dtype=bool))
    tri_strict = jnp.tril(jnp.ones((C, C), dtype=bool), -1)
    eye = jnp.eye(C, dtype=jnp.float32)

    def step(S, inp):
        qi, ki, vi, gi, bi = inp
        gcum = jnp.cumsum(gi, axis=-1)
        diff = gcum[..., :, None] - gcum[..., None, :]
        decay = jnp.exp(jnp.where(tri_incl, diff, -jnp.inf))
        kb = ki * bi[..., None]
        Lm = jnp.where(tri_strict, jnp.einsum('bhik,bhjk->bhij', kb, ki) * decay, 0.0)
        rhs = jnp.concatenate([kb * jnp.exp(gcum)[..., None], vi * bi[..., None]], axis=-1)
        sol = lax.linalg.triangular_solve(eye + Lm, rhs, left_side=True, lower=True, unit_diagonal=True)
        w_, u_ = sol[..., :dk], sol[..., dk:]
        v_new = u_ - jnp.einsum('bhck,bhkv->bhcv', w_, S)
        attn = jnp.einsum('bhik,bhjk->bhij', qi, ki) * decay
        o = (jnp.einsum('bhck,bhkv->bhcv', qi * jnp.exp(gcum)[..., None], S)
             + jnp.einsum('bhij,bhjv->bhiv', attn, v_new))
        g_last = gcum[..., -1:]
        S_new = (S * jnp.exp(g_last)[..., None]
                 + jnp.einsum('bhck,bhcv->bhkv', ki * jnp.exp(g_last - gcum)[..., None], v_new))
        return S_new, o

    S, o = lax.scan(step, S0, (qc, kc, vc, gc, bc))
    o = jnp.transpose(o, (1, 0, 3, 2, 4)).reshape(Bsz, T, H, dv)
    return o, S


def gdn_mixer(h, st_S, st_conv, w_in, conv_w, a_log, dt_bias, o_norm, w_o, segments):
    f32 = jnp.float32
    Bsz, T, _ = h.shape
    proj = h @ w_in
    qkv = proj[..., :GDN_CONV_CH]
    gate = proj[..., GDN_CONV_CH:GDN_CONV_CH + GDN_VW].reshape(Bsz, T, GDN_HEADS, GDN_DV)
    a = proj[..., GDN_CONV_CH + GDN_VW:GDN_CONV_CH + GDN_VW + GDN_HEADS]
    b = proj[..., GDN_CONV_CH + GDN_VW + GDN_HEADS:]
    qkv, conv_buf = causal_dwconv(qkv, st_conv, conv_w)
    qkv = jax.nn.silu(qkv.astype(f32))
    q = l2norm(qkv[..., :GDN_QK].reshape(Bsz, T, GDN_HEADS, GDN_DK)) * (GDN_DK ** -0.5)
    k = l2norm(qkv[..., GDN_QK:2 * GDN_QK].reshape(Bsz, T, GDN_HEADS, GDN_DK))
    v = qkv[..., 2 * GDN_QK:].reshape(Bsz, T, GDN_HEADS, GDN_DV)
    g = -jnp.exp(a_log.astype(f32)) * jax.nn.softplus(a.astype(f32) + dt_bias.astype(f32))
    beta = jax.nn.sigmoid(b.astype(f32))
    S = st_S.astype(f32)
    outs = []
    for s0, s1 in segments:
        o_seg, S = gated_delta_chunks(q[:, s0:s1], k[:, s0:s1], v[:, s0:s1], g[:, s0:s1], beta[:, s0:s1], S)
        outs.append(o_seg)
    o = rmsnorm(jnp.concatenate(outs, axis=1), o_norm) * jax.nn.silu(gate.astype(f32))
    out = o.reshape(Bsz, T, GDN_VW).astype(h.dtype) @ w_o
    return out, S, conv_buf


def conv_ffn(h, st, w_up, conv_w, w_down):
    up = h @ w_up
    up, buf = causal_dwconv(up, st, conv_w)
    act = jax.nn.silu(up[..., :D_FF]) * up[..., D_FF:]
    return act @ w_down, buf


def trunk(x, st_s5_re, st_s5_im, st_gdn, st_gdn_conv, st_ffn_conv, segments, w):
    s5_re, s5_im, gdn_S, gdn_conv, ffn_conv = [], [], [], [], []
    for i in range(DEPTH):
        j = i // 2
        h = rmsnorm(x, w['norm_mix'][i])
        if i % 2 == 0:
            y, r, im = s5_mixer(h, st_s5_re[j], st_s5_im[j], w['s5_lam_re'][j], w['s5_lam_im'][j],
                                w['s5_log_step'][j], w['s5_b_re'][j], w['s5_b_im'][j], w['s5_c_re'][j],
                                w['s5_c_im'][j], w['s5_d'][j], w['s5_w_glu'][j], segments)
            s5_re.append(r)
            s5_im.append(im)
        else:
            y, S, cb = gdn_mixer(h, st_gdn[j], st_gdn_conv[j], w['gdn_w_in'][j], w['gdn_conv_w'][j],
                                 w['gdn_a_log'][j], w['gdn_dt_bias'][j], w['gdn_o_norm'][j], w['gdn_w_o'][j],
                                 segments)
            gdn_S.append(S)
            gdn_conv.append(cb)
        x = x + y
        h = rmsnorm(x, w['norm_ffn'][i])
        y, fb = conv_ffn(h, st_ffn_conv[i], w['ffn_w_up'][i], w['ffn_conv_w'][i], w['ffn_w_down'][i])
        ffn_conv.append(fb)
        x = x + y
    x = rmsnorm(x, w['norm_final'])
    return x, jnp.stack(s5_re), jnp.stack(s5_im), jnp.stack(gdn_S), jnp.stack(gdn_conv), jnp.stack(ffn_conv)


def setup_inputs(seed: int = 0) -> dict:
    key = jax.random.key(seed)
    ks = iter(jax.random.split(key, 40))
    f32 = jnp.float32

    def nrm(shape, scale):
        return scale * jax.random.normal(next(ks), shape, f32)

    x_prompt = nrm((BATCH, SEQ, D_MODEL), 1.0)
    x_sample = nrm((DEC_BATCH, DEC_SEQ, D_MODEL), 1.0)
    state_s5_re = nrm((N_S5_LAYERS, DEC_BATCH, S5_GROUPS, S5_STATE), 0.5)
    state_s5_im = nrm((N_S5_LAYERS, DEC_BATCH, S5_GROUPS, S5_STATE), 0.5)
    state_gdn = nrm((N_GDN_LAYERS, DEC_BATCH, GDN_HEADS, GDN_DK, GDN_DV), 0.1)
    state_gdn_conv = nrm((N_GDN_LAYERS, DEC_BATCH, GDN_CONV - 1, GDN_CONV_CH), 1.0)
    state_ffn_conv = nrm((DEPTH, DEC_BATCH, FFN_CONV - 1, 2 * D_FF), 1.0)
    meta_tokens = nrm((N_META, D_MODEL), 1.0)
    norm_mix = 1.0 + nrm((DEPTH, D_MODEL), 0.01)
    norm_ffn = 1.0 + nrm((DEPTH, D_MODEL), 0.01)
    norm_final = 1.0 + nrm((D_MODEL,), 0.01)
    s5_lam_re = -0.5 + nrm((N_S5_LAYERS, S5_GROUPS, S5_STATE), 0.01)
    s5_lam_im = (jnp.pi * jnp.arange(S5_STATE, dtype=f32))[None, None, :] + nrm((N_S5_LAYERS, S5_GROUPS, S5_STATE), 0.01)
    s5_log_step = jax.random.uniform(next(ks), (N_S5_LAYERS, S5_GROUPS), f32, math.log(S5_DT_MIN), math.log(S5_DT_MAX))
    s5_b_re = nrm((N_S5_LAYERS, S5_GROUPS, S5_STATE, S5_GROUP), (2 * S5_GROUP) ** -0.5)
    s5_b_im = nrm((N_S5_LAYERS, S5_GROUPS, S5_STATE, S5_GROUP), (2 * S5_GROUP) ** -0.5)
    s5_c_re = nrm((N_S5_LAYERS, S5_GROUPS, S5_GROUP, S5_STATE), S5_STATE ** -0.5)
    s5_c_im = nrm((N_S5_LAYERS, S5_GROUPS, S5_GROUP, S5_STATE), S5_STATE ** -0.5)
    s5_d = nrm((N_S5_LAYERS, D_MODEL), 1.0)
    s5_w_glu = nrm((N_S5_LAYERS, D_MODEL, 2 * D_MODEL), D_MODEL ** -0.5)
    gdn_w_in = nrm((N_GDN_LAYERS, D_MODEL, GDN_IN), D_MODEL ** -0.5)
    gdn_conv_w = nrm((N_GDN_LAYERS, GDN_CONV, GDN_CONV_CH), GDN_CONV ** -0.5)
    gdn_a_log = jnp.log(jax.random.uniform(next(ks), (N_GDN_LAYERS, GDN_HEADS), f32, 1.0, 16.0))
    dt = jnp.exp(jax.random.uniform(next(ks), (N_GDN_LAYERS, GDN_HEADS), f32, math.log(1e-3), math.log(1e-1)))
    gdn_dt_bias = dt + jnp.log(-jnp.expm1(-dt))
    gdn_o_norm = 1.0 + nrm((N_GDN_LAYERS, GDN_DV), 0.01)
    gdn_w_o = nrm((N_GDN_LAYERS, GDN_VW, D_MODEL), GDN_VW ** -0.5)
    ffn_w_up = nrm((DEPTH, D_MODEL, 2 * D_FF), D_MODEL ** -0.5)
    ffn_conv_w = nrm((DEPTH, FFN_CONV, 2 * D_FF), FFN_CONV ** -0.5)
    ffn_w_down = nrm((DEPTH, D_FF, D_MODEL), D_FF ** -0.5)
    return {'x_prompt': x_prompt, 'x_sample': x_sample,
            'state_s5_re': state_s5_re, 'state_s5_im': state_s5_im, 'state_gdn': state_gdn,
            'state_gdn_conv': state_gdn_conv, 'state_ffn_conv': state_ffn_conv,
            'meta_tokens': meta_tokens, 'norm_mix': norm_mix, 'norm_ffn': norm_ffn, 'norm_final': norm_final,
            's5_lam_re': s5_lam_re, 's5_lam_im': s5_lam_im, 's5_log_step': s5_log_step,
            's5_b_re': s5_b_re, 's5_b_im': s5_b_im, 's5_c_re': s5_c_re, 's5_c_im': s5_c_im,
            's5_d': s5_d, 's5_w_glu': s5_w_glu,
            'gdn_w_in': gdn_w_in, 'gdn_conv_w': gdn_conv_w, 'gdn_a_log': gdn_a_log, 'gdn_dt_bias': gdn_dt_bias,
            'gdn_o_norm': gdn_o_norm, 'gdn_w_o': gdn_w_o,
            'ffn_w_up': ffn_w_up, 'ffn_conv_w': ffn_conv_w, 'ffn_w_down': ffn_w_down}


def reference(x_prompt, x_sample, state_s5_re, state_s5_im, state_gdn, state_gdn_conv, state_ffn_conv,
              meta_tokens, norm_mix, norm_ffn, norm_final,
              s5_lam_re, s5_lam_im, s5_log_step, s5_b_re, s5_b_im, s5_c_re, s5_c_im, s5_d, s5_w_glu,
              gdn_w_in, gdn_conv_w, gdn_a_log, gdn_dt_bias, gdn_o_norm, gdn_w_o,
              ffn_w_up, ffn_conv_w, ffn_w_down):
    w = {'norm_mix': norm_mix, 'norm_ffn': norm_ffn, 'norm_final': norm_final,
         's5_lam_re': s5_lam_re, 's5_lam_im': s5_lam_im, 's5_log_step': s5_log_step,
         's5_b_re': s5_b_re, 's5_b_im': s5_b_im, 's5_c_re': s5_c_re, 's5_c_im': s5_c_im,
         's5_d': s5_d, 's5_w_glu': s5_w_glu,
         'gdn_w_in': gdn_w_in, 'gdn_conv_w': gdn_conv_w, 'gdn_a_log': gdn_a_log, 'gdn_dt_bias': gdn_dt_bias,
         'gdn_o_norm': gdn_o_norm, 'gdn_w_o': gdn_w_o,
         'ffn_w_up': ffn_w_up, 'ffn_conv_w': ffn_conv_w, 'ffn_w_down': ffn_w_down}
    bp = x_prompt.shape[0]
    meta = jnp.broadcast_to(meta_tokens.astype(x_prompt.dtype)[None], (bp, N_META, D_MODEL))
    xp = jnp.concatenate([meta, x_prompt], axis=1)
    tp = xp.shape[1]
    z_s5 = jnp.zeros((N_S5_LAYERS, bp, S5_GROUPS, S5_STATE), jnp.float32)
    z_gdn = jnp.zeros((N_GDN_LAYERS, bp, GDN_HEADS, GDN_DK, GDN_DV), jnp.float32)
    z_gconv = jnp.zeros((N_GDN_LAYERS, bp, GDN_CONV - 1, GDN_CONV_CH), xp.dtype)
    z_fconv = jnp.zeros((DEPTH, bp, FFN_CONV - 1, 2 * D_FF), xp.dtype)
    yp, p_s5_re, p_s5_im, p_gdn, p_gdn_conv, p_ffn_conv = trunk(
        xp, z_s5, z_s5, z_gdn, z_gconv, z_fconv, ((0, N_META), (N_META, tp)), w)
    y_prompt = yp[:, N_META:]
    y_sample, s_s5_re, s_s5_im, s_gdn, s_gdn_conv, s_ffn_conv = trunk(
        x_sample, state_s5_re, state_s5_im, state_gdn, state_gdn_conv, state_ffn_conv,
        ((0, x_sample.shape[1]),), w)
    return (y_prompt, y_sample, p_s5_re, p_s5_im, p_gdn, p_gdn_conv, p_ffn_conv,
            s_s5_re, s_s5_im, s_gdn, s_gdn_conv, s_ffn_conv)
```

```cpp
#include <hip/hip_runtime.h>
#include <cstdio>
#include <cstdint>

#ifndef MK_PER_PHASE
#define MK_PER_PHASE 0
#endif

#define GAS __attribute__((address_space(1)))
#define LAS __attribute__((address_space(3)))
typedef unsigned short bf16;
typedef unsigned short bf16_t;
typedef short bf16x8 __attribute__((ext_vector_type(8)));
typedef float f32x4 __attribute__((ext_vector_type(4)));
typedef float f32x2 __attribute__((ext_vector_type(2)));
typedef unsigned u32x4 __attribute__((ext_vector_type(4)));
typedef unsigned u32x2 __attribute__((ext_vector_type(2)));

constexpr int DM = 1024, NB = 8, SEQ = 2048, NMETA = 16, TP = NMETA + SEQ  , NS = 128;
constexpr int ROWS_P = NB * TP  , ROWS = ROWS_P + NS  , ROWS_PAD = 16896;
constexpr int S5G = 64, S5P = 64, S5L = 16, S5NCH = TP / S5L  , S5NCHP = 144;
constexpr int DFF = 2816, UPN = 2 * DFF;
constexpr int GH = 8, GDK = 128, GCONV = 3072, GIN = 4112, GINP = 4352;
constexpr int GNCH = 33, GNULL = 48;
constexpr float EPS = 1e-6f;

constexpr size_t O_YP = 0, O_YS = 16777216, O_PS5RE = 16908288, O_PS5IM = 16941056, O_PGDN = 16973824, O_PGCONV = 18022400, O_PFCONV = 18096128,
                 O_SS5RE = 18276352, O_SS5IM = 18800640, O_SGDN = 19324928, O_SGCONV = 36102144, O_SFCONV = 37281792, O_END = 40165376;

constexpr size_t MiB = 1u << 20;
constexpr size_t WS_CTL = 0, CTL_ZERO_BYTES = 1 * MiB;
constexpr size_t WS_SS = 1 * MiB;
constexpr size_t WS_AB = 3 * MiB + 512 * 1024;
constexpr size_t WS_XS = 5 * MiB;
constexpr size_t WS_MISC = 6 * MiB;
constexpr size_t WS_HS = 7 * MiB;
constexpr size_t WS_C0 = 8 * MiB;
constexpr size_t WS_W1 = 12 * MiB;
constexpr size_t WS_WIN = WS_W1, WS_WO = WS_WIN + (size_t)GINP * DM * 2, WS_WUP1 = WS_WO + (size_t)DM * DM * 2, WS_WDN1 = WS_WUP1 + (size_t)UPN * DM * 2;
constexpr size_t WS_W0 = 40 * MiB;
constexpr size_t WS_WGLU = WS_W0, WS_WUP0 = WS_WGLU + (size_t)2048 * DM * 2, WS_WDN0 = WS_WUP0 + (size_t)UPN * DM * 2, WS_S5M = WS_WDN0 + (size_t)DM * DFF * 2;
constexpr size_t S5M_WG = 128 * 256 * 2, S5M_TV = 256 * 384 * 2, S5M_G = S5M_WG + S5M_TV;
constexpr size_t WS_WX = WS_W0;
constexpr size_t WS_B1 = 77 * MiB;
constexpr size_t WS_B2 = 110 * MiB;
constexpr size_t WS_BIG = 143 * MiB;
constexpr size_t WS_END = 241 * MiB;
static_assert(WS_WDN1 + (size_t)DM * DFF * 2 <= WS_W0 && WS_S5M + 64 * S5M_G <= WS_B1 && WS_WX + (size_t)NB * GH * GNCH * 16384 <= WS_B1, "ws map");
static_assert(WS_B1 + (size_t)ROWS_PAD * DM * 2 <= WS_B2 && WS_B2 + (size_t)ROWS_PAD * DM * 2 <= WS_BIG && WS_BIG + (size_t)ROWS * GCONV * 2 <= WS_END, "ws map");
static_assert(WS_BIG + (size_t)ROWS_PAD * DFF * 2 <= WS_END && WS_BIG + (size_t)NB * S5G * S5NCHP * 512 <= WS_END, "ws map");

constexpr int LDS_BYTES = 147456;
constexpr int LDSCTL_OFF = LDS_BYTES - 512;
constexpr int EXCH_OFF = 131072;

__device__ __forceinline__ unsigned f2bf(float f) { unsigned u = __builtin_bit_cast(unsigned, f); return (u + 0x7fffu + ((u >> 16) & 1u)) >> 16; }
__device__ __forceinline__ unsigned pk2(float lo, float hi) { return f2bf(lo) | (f2bf(hi) << 16); }
__device__ __forceinline__ float bflo(unsigned u) { return __builtin_bit_cast(float, u << 16); }
__device__ __forceinline__ float bfhi(unsigned u) { return __builtin_bit_cast(float, u & 0xffff0000u); }
__device__ __forceinline__ float sigmoidf_(float x) { return 1.f / (1.f + __expf(-x)); }
__device__ __forceinline__ float siluf_(float x) { return x / (1.f + __expf(-x)); }
__device__ __forceinline__ float gelu_tanh(float x) { const float z = 1.5957691216057308f * (x + 0.044715f * x * x * x); return x / (1.f + __expf(-z)); }

__device__ __forceinline__ float* xrow_ptr(float* yp, float* xs, int row) {
    if (row >= ROWS_P) return xs + (size_t)(128 + row - ROWS_P) * DM;
    const int b = row / TP, pos = row - b * TP;
    return pos < NMETA ? xs + (size_t)(b * NMETA + pos) * DM : yp + ((size_t)b * SEQ + (pos - NMETA)) * DM;
}
__device__ __forceinline__ const float* xin_ptr(const float* xp, const float* xsmp, const float* meta, int row) {
    if (row >= ROWS_P) return xsmp + (size_t)(row - ROWS_P) * DM;
    const int b = row / TP, pos = row - b * TP;
    return pos < NMETA ? meta + (size_t)pos * DM : xp + ((size_t)b * SEQ + (pos - NMETA)) * DM;
}

namespace pg8 {
#define PG8_LAS __attribute__((address_space(3)))
constexpr int BM = 256, BK = 64, HALF = 128, HTB = HALF * BK * 2  , STAGE_BYTES = 8 * HTB, NXCD = 8, WGM = 8;
__host__ __device__ __forceinline__ int lds_byte(int r, int c) { const int st = (r >> 4) * 2 + (c >> 5), rr = r & 15, cc = c & 31, ob = rr * 64 + cc * 2; return st * 1024 + (ob ^ (((ob >> 9) & 1) << 5)); }
__host__ __device__ __forceinline__ void stage_rc(int b, int& R, int& C) { const int st = b / 1024, sb = b % 1024, swz = sb ^ (((sb >> 9) & 1) << 5); R = (st >> 1) * 16 + swz / 64; C = (st & 1) * 32 + (swz % 64) / 2; }
__host__ __device__ __forceinline__ int perm32(int rho) { const int n = rho >> 4, i = rho & 15; return 8 * (i >> 2) + 4 * n + (i & 3); }

struct Unit { int pm, pn; };
struct Gemm { const bf16_t* A; const bf16_t* Bt; int K, halo, nMp; };
__device__ __forceinline__ int tile_row0(const Gemm& g, int pm) { return g.halo == 0 ? 256 * pm : (pm >= g.nMp ? ROWS_P : (256 - g.halo) * pm); }

struct StaticOrder {
    int nM, nN, nwg, G, c;
    __host__ __device__ void init(int nM_, int nN_, int G_, int c_) { nM = nM_; nN = nN_; nwg = nM * nN; G = G_; c = c_; }
    __host__ __device__ bool next(int i, Unit& u) const {
        const long L = (long)i * G + c; if (L >= nwg) return false;
        int wgid = (int)L; { const int q = nwg / NXCD, r = nwg % NXCD, xcd = wgid % NXCD, off = wgid / NXCD; wgid = (xcd < r ? xcd * (q + 1) : r * (q + 1) + (xcd - r) * q) + off; }
        const int nig = WGM * nN, gid = wgid / nig, fm = gid * WGM, gsz = (nM - fm) < WGM ? (nM - fm) : WGM;
        u.pm = fm + ((wgid % nig) % gsz); u.pn = (wgid % nig) / gsz; return true;
    }
};

template <class Epi, class Sched, bool ALIGN_EPI = false, bool SP2 = false>
__device__ __forceinline__ void gemm_phase(PG8_LAS unsigned char* lds, const Gemm g, const Sched& S, const Epi& E) {
    const int tid = threadIdx.x, wid = __builtin_amdgcn_readfirstlane(tid >> 6), lane = tid & 63, wr = wid >> 2, wc = wid & 3, fr = lane & 15, fq = lane >> 4;
    const int K = g.K, nt = K / BK;
    unsigned voffA[2], voffB[2];
#pragma unroll
    for (int i = 0; i < 2; ++i) { int R, C; stage_rc(tid * 16 + i * 8192, R, C); const int Rb = Epi::PERM ? ((R & ~31) + perm32(R & 31)) : R;
        voffA[i] = (unsigned)(R * K + C) * 2u; voffB[i] = (unsigned)(Rb * K + C) * 2u; }
    const size_t kstep = (size_t)(BK * 2);
    const size_t hstep = (size_t)HALF * K * 2;
    const size_t tstep = 2 * hstep;
    const size_t rstep = (size_t)K * 2;
    const unsigned ldsw = (unsigned)wid * 1024u;
    const int aoff = lds_byte(wr * 64 + fr, fq * 8), boff = lds_byte(wc * 32 + fr, fq * 8);
#define PG8_SA(b, h) (((b) * 2 + (h)) * HTB)
#define PG8_SB(b, h) ((4 + (b) * 2 + (h)) * HTB)
#define PG8_STAGE(bufoff, gbase, voff) do { _Pragma("unroll") for (int _i = 0; _i < 2; ++_i) \
        __builtin_amdgcn_global_load_lds((const unsigned*)((const char*)(gbase) + (voff)[_i]), (PG8_LAS unsigned*)(lds + (bufoff) + ldsw + _i * 8192), 16, 0, 0); } while (0)
#define PG8_LDA(dst, b, h) do { _Pragma("unroll") for (int m = 0; m < 4; ++m) _Pragma("unroll") for (int k = 0; k < 2; ++k) dst[m][k] = *(const PG8_LAS bf16x8*)(lds + PG8_SA(b, h) + aoff + m * 2048 + k * 1024); } while (0)
#define PG8_LDB(dst, b, h) do { _Pragma("unroll") for (int n = 0; n < 2; ++n) _Pragma("unroll") for (int k = 0; k < 2; ++k) dst[n][k] = *(const PG8_LAS bf16x8*)(lds + PG8_SB(b, h) + boff + n * 2048 + k * 1024); } while (0)
#define PG8_MMA(ai, bj, At, Bt) do { __builtin_amdgcn_s_setprio(1); _Pragma("unroll") for (int m = 0; m < 4; ++m) _Pragma("unroll") for (int n = 0; n < 2; ++n) _Pragma("unroll") for (int k = 0; k < 2; ++k) \
        acc[ai][bj][m][n] = __builtin_amdgcn_mfma_f32_16x16x32_bf16(Bt[n][k], At[m][k], acc[ai][bj][m][n], 0, 0, 0); __builtin_amdgcn_s_setprio(0); } while (0)
#define PG8_WAIT_V(n) asm volatile("s_waitcnt vmcnt(" #n ")" ::: "memory")
#define PG8_WAIT_L(n) asm volatile("s_waitcnt lgkmcnt(" #n ")" ::: "memory")
#define PG8_BAR __builtin_amdgcn_s_barrier()
#define PG8_SCHED __builtin_amdgcn_sched_barrier(0)
    Unit cur, nxt; int ui = 0;
    if (!S.next(0, cur)) return;
    f32x4 acc[2][2][4][2];
#pragma unroll
    for (int a = 0; a < 2; ++a)
#pragma unroll
        for (int b = 0; b < 2; ++b)
#pragma unroll
            for (int m = 0; m < 4; ++m)
#pragma unroll
                for (int n = 0; n < 2; ++n) acc[a][b][m][n] = (f32x4){0.f, 0.f, 0.f, 0.f};
    bf16x8 At[4][2], B0[2][2], B1[2][2];
    const char* cA = (const char*)g.A + (size_t)tile_row0(g, cur.pm) * rstep; const char* cB = (const char*)g.Bt + (size_t)cur.pn * tstep;
    if constexpr (SP2) {
        PG8_STAGE(PG8_SB(0, 0), cB, voffB); PG8_STAGE(PG8_SB(0, 1), cB + hstep, voffB); PG8_STAGE(PG8_SA(0, 0), cA, voffA); PG8_STAGE(PG8_SA(0, 1), cA + hstep, voffA);
        if (wr == 1) PG8_BAR;
        PG8_WAIT_V(2); PG8_BAR;
        PG8_STAGE(PG8_SB(1, 0), cB + kstep, voffB); PG8_STAGE(PG8_SA(1, 0), cA + kstep, voffA); PG8_STAGE(PG8_SB(1, 1), cB + hstep + kstep, voffB);
        PG8_WAIT_V(6); PG8_BAR;
    } else {
        PG8_STAGE(PG8_SB(0, 0), cB, voffB); PG8_STAGE(PG8_SA(0, 0), cA, voffA); PG8_STAGE(PG8_SB(0, 1), cB + hstep, voffB); PG8_STAGE(PG8_SA(0, 1), cA + hstep, voffA);
        if (wr == 1) PG8_BAR;
        PG8_WAIT_V(4); PG8_BAR;
        PG8_STAGE(PG8_SB(1, 0), cB + kstep, voffB); PG8_STAGE(PG8_SA(1, 0), cA + kstep, voffA); PG8_STAGE(PG8_SB(1, 1), cB + hstep + kstep, voffB);
        PG8_WAIT_V(6); PG8_BAR;
    }
    for (;;) {
        const bool has_next = S.next(ui + 1, nxt);
        const char* nA = has_next ? (const char*)g.A + (size_t)tile_row0(g, nxt.pm) * rstep : cA; const char* nB = has_next ? (const char*)g.Bt + (size_t)nxt.pn * tstep : cB;
        for (int t = 0; t < nt; t += 2) {
            const bool last = (t == nt - 2);
            const char* a1 = cA + (size_t)(t + 1) * kstep;
            const char* a2 = last ? nA : cA + (size_t)(t + 2) * kstep; const char* b2 = last ? nB : cB + (size_t)(t + 2) * kstep;
            const char* a3 = a2 + kstep; const char* b3 = b2 + kstep;
            if constexpr (SP2) {
            PG8_LDB(B0, 0, 0); PG8_LDB(B1, 0, 1); PG8_SCHED; PG8_LDA(At, 0, 0); PG8_STAGE(PG8_SA(1, 1), a1 + hstep, voffA);
            PG8_WAIT_V(8); PG8_WAIT_L(0); PG8_BAR; PG8_MMA(0, 0, At, B0); PG8_MMA(0, 1, At, B1); PG8_BAR; PG8_SCHED;
            PG8_LDA(At, 0, 1); PG8_STAGE(PG8_SB(0, 0), b2, voffB); PG8_STAGE(PG8_SB(0, 1), b2 + hstep, voffB); PG8_STAGE(PG8_SA(0, 0), a2, voffA);
            PG8_WAIT_V(8); PG8_WAIT_L(0); PG8_BAR; PG8_MMA(1, 0, At, B0); PG8_MMA(1, 1, At, B1); PG8_BAR; PG8_SCHED;
            PG8_LDB(B0, 1, 0); PG8_LDB(B1, 1, 1); PG8_SCHED; PG8_LDA(At, 1, 0); PG8_STAGE(PG8_SA(0, 1), a2 + hstep, voffA);
            PG8_WAIT_V(8); PG8_WAIT_L(0); PG8_BAR; PG8_MMA(0, 0, At, B0); PG8_MMA(0, 1, At, B1); PG8_BAR; PG8_SCHED;
            PG8_LDA(At, 1, 1); PG8_STAGE(PG8_SB(1, 0), b3, voffB); PG8_STAGE(PG8_SB(1, 1), b3 + hstep, voffB); PG8_STAGE(PG8_SA(1, 0), a3, voffA);
            PG8_WAIT_V(8); PG8_WAIT_L(0); PG8_BAR; PG8_MMA(1, 0, At, B0); PG8_MMA(1, 1, At, B1); PG8_BAR; PG8_SCHED;
            } else {
            PG8_LDB(B0, 0, 0); PG8_SCHED; PG8_LDA(At, 0, 0); PG8_STAGE(PG8_SA(1, 1), a1 + hstep, voffA);
            PG8_WAIT_L(8); PG8_BAR; PG8_WAIT_L(0); PG8_MMA(0, 0, At, B0); PG8_BAR; PG8_SCHED;
            PG8_LDB(B1, 0, 1); PG8_STAGE(PG8_SB(0, 0), b2, voffB);
            PG8_BAR; PG8_WAIT_L(0); PG8_MMA(0, 1, At, B1); PG8_BAR;
            PG8_LDA(At, 0, 1); PG8_STAGE(PG8_SA(0, 0), a2, voffA);
            PG8_BAR; PG8_WAIT_L(0); PG8_MMA(1, 0, At, B0); PG8_BAR; PG8_SCHED;
            PG8_STAGE(PG8_SB(0, 1), b2 + hstep, voffB);
            PG8_WAIT_V(6); PG8_BAR; PG8_MMA(1, 1, At, B1); PG8_BAR;
            PG8_LDB(B0, 1, 0); PG8_SCHED; PG8_LDA(At, 1, 0); PG8_STAGE(PG8_SA(0, 1), a2 + hstep, voffA);
            PG8_WAIT_L(8); PG8_BAR; PG8_WAIT_L(0); PG8_MMA(0, 0, At, B0); PG8_BAR; PG8_SCHED;
            PG8_LDB(B1, 1, 1); PG8_STAGE(PG8_SB(1, 0), b3, voffB);
            PG8_BAR; PG8_WAIT_L(0); PG8_MMA(0, 1, At, B1); PG8_BAR;
            PG8_LDA(At, 1, 1); PG8_STAGE(PG8_SA(1, 0), a3, voffA);
            PG8_BAR; PG8_WAIT_L(0); PG8_MMA(1, 0, At, B0); PG8_BAR; PG8_SCHED;
            PG8_STAGE(PG8_SB(1, 1), b3 + hstep, voffB);
            PG8_WAIT_V(6); PG8_BAR; PG8_MMA(1, 1, At, B1); PG8_BAR;
            }
        }
        if constexpr (ALIGN_EPI) { if (wr == 0) PG8_BAR; }
        E(acc, cur, tile_row0(g, cur.pm), wid, wr, wc, fr, fq);
        if (!has_next) break;
#pragma unroll
        for (int a = 0; a < 2; ++a)
#pragma unroll
            for (int b = 0; b < 2; ++b)
#pragma unroll
                for (int m = 0; m < 4; ++m)
#pragma unroll
                    for (int n = 0; n < 2; ++n) acc[a][b][m][n] = (f32x4){0.f, 0.f, 0.f, 0.f};
        cur = nxt; cA = nA; cB = nB; ++ui;
        if constexpr (ALIGN_EPI) { if (wr == 1) PG8_BAR; }
    }
    PG8_WAIT_V(0);
    if constexpr (!ALIGN_EPI) { if (wr == 0) PG8_BAR; }
    PG8_BAR;
#undef PG8_SA
#undef PG8_SB
#undef PG8_STAGE
#undef PG8_LDA
#undef PG8_LDB
#undef PG8_MMA
#undef PG8_WAIT_V
#undef PG8_WAIT_L
#undef PG8_BAR
#undef PG8_SCHED
}
}

typedef GAS unsigned gu32;
#define RLX_AGENT __ATOMIC_RELAXED, __HIP_MEMORY_SCOPE_AGENT
#define LDS_WAIT() asm volatile("s_waitcnt lgkmcnt(0)" ::: "memory")
#define VM_WAIT() asm volatile("s_waitcnt vmcnt(0)" ::: "memory")

#define XB_TMO      128
#define XB_XCNT(j)  (256  + 64 * (j))
#define XB_XSUB(j)  (1280 + 64 * (j))
#define XB_XGEN(j)  (2304 + 64 * (j))
#define XB_TOP      3328
#define XB_TOPGEN   3392
#define XCD_BAR_WORDS 3456
#define XB_SPIN_CAP (1u << 18)
__device__ __forceinline__ unsigned xb_ld(unsigned* p)              { return __hip_atomic_load(p, __ATOMIC_RELAXED, __HIP_MEMORY_SCOPE_AGENT); }
__device__ __forceinline__ unsigned xb_add(unsigned* p, unsigned v) { return __hip_atomic_fetch_add(p, v, __ATOMIC_RELAXED, __HIP_MEMORY_SCOPE_AGENT); }
__device__ __forceinline__ unsigned xb_xcc_id() { return (unsigned)__builtin_amdgcn_s_getreg((3 << 11) | 20) & 0xFu; }
#define XB_SPIN(cond, bar) do { unsigned _sp = 0; while (cond) { __builtin_amdgcn_s_sleep(1); \
    if ((++_sp & 255u) == 0u) { if (xb_ld(&(bar)[XB_TMO])) break; if (_sp > XB_SPIN_CAP) { atomicAdd(&(bar)[XB_TMO], 1u); break; } } } } while (0)
struct XcdBarrier { unsigned* bar; unsigned x; volatile LAS unsigned* st; };
__device__ __forceinline__ XcdBarrier xcd_barrier_post(unsigned* bar, volatile LAS unsigned* st) {
    XcdBarrier b; b.bar = bar; b.x = xb_xcc_id(); b.st = st;
    if (threadIdx.x == 0) (void)xb_add(&bar[XB_XCNT(b.x)], 1u);
    return b;
}
__device__ __forceinline__ void xcd_barrier_complete(unsigned* bar, unsigned x, unsigned& nloc, unsigned& nx) {
    const unsigned G = gridDim.x * gridDim.y * gridDim.z;
    unsigned sum, cnt, mine, sp = 0u;
    for (;;) {
        sum = 0u; cnt = 0u; mine = 0u;
#pragma unroll
        for (unsigned j = 0; j < 16; ++j) { const unsigned c = xb_ld(&bar[XB_XCNT(j)]); sum += c; cnt += (c > 0u) ? 1u : 0u; mine = (j == x) ? c : mine; }
        if (sum == G) break;
        __builtin_amdgcn_s_sleep(1);
        if ((++sp & 255u) == 0u) { if (xb_ld(&bar[XB_TMO])) break; if (sp > XB_SPIN_CAP) { atomicAdd(&bar[XB_TMO], 1u); break; } }
    }
    nloc = mine > 0u ? mine : 1u; nx = cnt > 0u ? cnt : 1u;
}
__device__ __forceinline__ void xcd_barrier(const XcdBarrier& b) {
    asm volatile("s_waitcnt vmcnt(0)" ::: "memory");
    __syncthreads();
    if (threadIdx.x == 0) {
        unsigned* bar = b.bar;
        __builtin_amdgcn_s_waitcnt(0);
        unsigned nloc = b.st[0], nx = b.st[1];
        if (nloc == 0u) { xcd_barrier_complete(bar, b.x, nloc, nx); b.st[0] = nloc; b.st[1] = nx; }
        const unsigned old = xb_add(&bar[XB_XSUB(b.x)], 1u);
        const unsigned gen = old / nloc;
        if (old + 1u == (gen + 1u) * nloc) {
            __builtin_amdgcn_fence(__ATOMIC_RELEASE, "agent");
            asm volatile("s_waitcnt vmcnt(0)" ::: "memory");
            const unsigned og = xb_add(&bar[XB_TOP], 1u);
            const unsigned tg = og / nx;
            if (og + 1u == (tg + 1u) * nx) xb_add(&bar[XB_TOPGEN], 1u);
            else XB_SPIN(xb_ld(&bar[XB_TOPGEN]) == tg, bar);
            __builtin_amdgcn_fence(__ATOMIC_ACQUIRE, "agent");
            xb_add(&bar[XB_XGEN(b.x)], 1u);
            asm volatile("s_waitcnt vmcnt(0)" ::: "memory");
        } else {
            XB_SPIN(xb_ld(&bar[XB_XGEN(b.x)]) == gen, bar);
            __builtin_amdgcn_fence(__ATOMIC_ACQUIRE, "agent");
            asm volatile("s_waitcnt vmcnt(0)" ::: "memory");
        }
    }
    __syncthreads();
}

constexpr int NWAVES = 8;
struct Args { const float* in[29]; float* out; unsigned char* ws; int ph_lo, ph_hi; };
struct Frame {
    LAS unsigned char* lds;
    int tid, lane, wave, vcu, G;
    const float* const* in;
    float* out; unsigned char* ws;
};
__device__ __forceinline__ float wave_sum(float v) {
#pragma unroll
    for (int o = 1; o < 64; o <<= 1) v += __shfl_xor(v, o);
    return v;
}
__device__ __forceinline__ float row_rs(const float* SS, int row, int fq) {
    const f32x4* p = (const f32x4*)(SS + (size_t)row * 32 + fq * 8);
    const f32x4 a = p[0], b = p[1];
    float s = (a.x + a.y) + (a.z + a.w) + (b.x + b.y) + (b.z + b.w);
    s += __shfl_xor(s, 16); s += __shfl_xor(s, 32);
    return 1.f / sqrtf(s * (1.f / DM) + EPS);
}
template <int D> __device__ __forceinline__ float dpp_shift(float cur, float prevblk) {
    const int o = __builtin_amdgcn_update_dpp(0, __builtin_bit_cast(int, prevblk), 0x120 + D, 0xf, 0xf, false);
    const int r = __builtin_amdgcn_update_dpp(o, __builtin_bit_cast(int, cur), 0x110 + D, 0xf, 0xf, false);
    return __builtin_bit_cast(float, r);
}

struct EpiGlu {
    static constexpr bool PERM = true;
    const float* xp; const float* xsmp; const float* meta; float* yp; float* xs; bf16* XB; float* SS;
    __device__ __forceinline__ void operator()(const f32x4 (&acc)[2][2][4][2], const pg8::Unit& u, int row0, int wid, int wr, int wc, int fr_, int fq_) const {
        int fr = fr_, fq = fq_; asm volatile("" : "+v"(fr), "+v"(fq));
        const int col = 128 * u.pn + 32 * wc + 8 * fq;
#pragma unroll
        for (int ai = 0; ai < 2; ++ai)
#pragma unroll
            for (int m = 0; m < 4; ++m) {
                const int row = row0 + 128 * ai + 64 * wr + 16 * m + fr;
                const float* xi = xin_ptr(xp, xsmp, meta, row) + col; float* xo = xrow_ptr(yp, xs, row) + col;
                float ss = 0.f; f32x4 v[2];
#pragma unroll
                for (int n = 0; n < 2; ++n) { const f32x4 a = acc[ai][0][m][n], b = acc[ai][1][m][n], x = *(const f32x4*)(xi + 4 * n);
#pragma unroll
                    for (int j = 0; j < 4; ++j) { v[n][j] = x[j] + a[j] * sigmoidf_(b[j]); ss += v[n][j] * v[n][j]; }
                    *(f32x4*)(xo + 4 * n) = v[n]; }
                u32x4 w; w.x = pk2(v[0][0], v[0][1]); w.y = pk2(v[0][2], v[0][3]); w.z = pk2(v[1][0], v[1][1]); w.w = pk2(v[1][2], v[1][3]);
                *(u32x4*)(XB + (size_t)row * DM + col) = w;
                ss += __shfl_xor(ss, 16); ss += __shfl_xor(ss, 32);
                if (fq == 0) SS[(size_t)row * 32 + u.pn * 4 + wc] = ss;
            }
    }
};
struct EpiRes {
    static constexpr bool PERM = true;
    float* yp; float* xs; bf16* XB; float* SS;
    __device__ __forceinline__ void operator()(const f32x4 (&acc)[2][2][4][2], const pg8::Unit& u, int row0, int wid, int wr, int wc, int fr_, int fq_) const {
        int fr = fr_, fq = fq_; asm volatile("" : "+v"(fr), "+v"(fq));
#pragma unroll
        for (int ai = 0; ai < 2; ++ai)
#pragma unroll
            for (int m = 0; m < 4; ++m) {
                const int row = row0 + 128 * ai + 64 * wr + 16 * m + fr;
                float* xr = xrow_ptr(yp, xs, row);
#pragma unroll
                for (int bj = 0; bj < 2; ++bj) {
                    const int col = 256 * u.pn + 128 * bj + 32 * wc + 8 * fq;
                    float ss = 0.f; f32x4 v[2];
#pragma unroll
                    for (int n = 0; n < 2; ++n) { v[n] = *(const f32x4*)(xr + col + 4 * n) + acc[ai][bj][m][n]; *(f32x4*)(xr + col + 4 * n) = v[n];
                        ss += (v[n].x * v[n].x + v[n].y * v[n].y) + (v[n].z * v[n].z + v[n].w * v[n].w); }
                    if (XB) { u32x4 w; w.x = pk2(v[0][0], v[0][1]); w.y = pk2(v[0][2], v[0][3]); w.z = pk2(v[1][0], v[1][1]); w.w = pk2(v[1][2], v[1][3]);
                        *(u32x4*)(XB + (size_t)row * DM + col) = w; }
                    ss += __shfl_xor(ss, 16); ss += __shfl_xor(ss, 32);
                    if (fq == 0) SS[(size_t)row * 32 + u.pn * 8 + wc * 2 + bj] = ss;
                }
            }
    }
};
__device__ __forceinline__ int exch_off(int ai, int wave, int g4, int fr, int fq) { return ((((ai * 8 + wave) * 4 + g4) * 12) + (fr - 13) * 4 + fq) * 16; }
__device__ __forceinline__ void exch_publish(LAS unsigned char* ex, const f32x4 (&acc)[2][2][4][2], const float* SS, int rowb, int wid, int fr, int fq) {
#pragma unroll
    for (int ai = 0; ai < 2; ++ai) { const float rs3 = row_rs(SS, rowb + 128 * ai + 48 + fr, fq);
        if (fr >= 13) {
#pragma unroll
            for (int g4 = 0; g4 < 4; ++g4) *(LAS f32x4*)(ex + exch_off(ai, wid, g4, fr, fq)) = acc[ai][g4 >> 1][3][g4 & 1] * rs3; } }
    asm volatile("s_waitcnt lgkmcnt(0)" ::: "memory");
    __builtin_amdgcn_s_barrier();
    asm volatile("" ::: "memory");
}
__device__ __forceinline__ f32x4 exch_prev(LAS unsigned char* ex, int ai, int wid, int wr, int g4, int fr, int fq) {
    f32x4 p = (f32x4){0.f, 0.f, 0.f, 0.f};
    if (fr >= 13) {
        if (wr == 1) p = *(const LAS f32x4*)(ex + exch_off(ai, wid - 4, g4, fr, fq));
        else if (ai == 1) p = *(const LAS f32x4*)(ex + exch_off(0, wid + 4, g4, fr, fq));
    }
    return p;
}
struct EpiUp {
    static constexpr bool PERM = true;
    bf16* ACT; const float* SS; const float* cw; const float* st; float* pf; float* sf; LAS unsigned char* ex; int nMp;
    __device__ __forceinline__ void operator()(const f32x4 (&acc)[2][2][4][2], const pg8::Unit& u, int row0, int wid, int wr, int wc, int fr_, int fq_) const {
        int fr = fr_, fq = fq_; asm volatile("" : "+v"(fr), "+v"(fq));
        const bool sample = (u.pm >= nMp);
        const int lo = (u.pm == 0 || sample) ? 0 : 2;
        exch_publish(ex, acc, SS, row0 + 64 * wr, wid, fr, fq);
#pragma unroll
        for (int n = 0; n < 2; ++n) {
            const int ch = 128 * u.pn + 32 * wc + 8 * fq + 4 * n;
            const f32x4 w0a = *(const f32x4*)(cw + ch), w1a = *(const f32x4*)(cw + UPN + ch), w2a = *(const f32x4*)(cw + 2 * UPN + ch);
            const f32x4 w0b = *(const f32x4*)(cw + DFF + ch), w1b = *(const f32x4*)(cw + UPN + DFF + ch), w2b = *(const f32x4*)(cw + 2 * UPN + DFF + ch);
#pragma unroll
            for (int ai = 0; ai < 2; ++ai) {
                f32x4 pa = exch_prev(ex, ai, wid, wr, n, fr, fq), pb = exch_prev(ex, ai, wid, wr, 2 + n, fr, fq);
#pragma unroll
                for (int m = 0; m < 4; ++m) {
                    const int R = 128 * ai + 64 * wr + 16 * m + fr, row = row0 + R;
                    const float rsv = row_rs(SS, row, fq); const f32x4 ca = acc[ai][0][m][n] * rsv, cb = acc[ai][1][m][n] * rsv;
                    if (!sample) {
                        const int b = row / TP, pos = row - b * TP;
                        const float m1 = pos >= 1 ? 1.f : 0.f, m2 = pos >= 2 ? 1.f : 0.f;
                        f32x4 o;
#pragma unroll
                        for (int j = 0; j < 4; ++j) {
                            const float s1a = dpp_shift<1>(ca[j], pa[j]) * m1, s2a = dpp_shift<2>(ca[j], pa[j]) * m2;
                            const float s1b = dpp_shift<1>(cb[j], pb[j]) * m1, s2b = dpp_shift<2>(cb[j], pb[j]) * m2;
                            const float ua = w2a[j] * ca[j] + w1a[j] * s1a + w0a[j] * s2a, ub = w2b[j] * cb[j] + w1b[j] * s1b + w0b[j] * s2b;
                            o[j] = siluf_(ua) * ub;
                        }
                        if (R >= lo && row < ROWS_P) {
                            u32x2 w; w.x = pk2(o[0], o[1]); w.y = pk2(o[2], o[3]);
                            *(u32x2*)(ACT + (size_t)row * DFF + ch) = w;
                            if (pos >= TP - 2) { float* d = pf + (size_t)(b * 2 + pos - (TP - 2)) * UPN + ch; *(f32x4*)d = ca; *(f32x4*)(d + DFF) = cb; }
                        }
                    } else if (ai == 0) {
                        const int s = R;
                        const float* s0 = st + (size_t)(s * 2) * UPN + ch; const float* s1 = s0 + UPN;
                        const f32x4 a0 = *(const f32x4*)s0, a1 = *(const f32x4*)s1, b0 = *(const f32x4*)(s0 + DFF), b1 = *(const f32x4*)(s1 + DFF);
                        f32x4 o;
#pragma unroll
                        for (int j = 0; j < 4; ++j) { const float ua = w2a[j] * ca[j] + w1a[j] * a1[j] + w0a[j] * a0[j], ub = w2b[j] * cb[j] + w1b[j] * b1[j] + w0b[j] * b0[j]; o[j] = siluf_(ua) * ub; }
                        u32x2 w; w.x = pk2(o[0], o[1]); w.y = pk2(o[2], o[3]);
                        *(u32x2*)(ACT + (size_t)row * DFF + ch) = w;
                        float* d0 = sf + (size_t)(s * 2) * UPN + ch; float* d1 = d0 + UPN;
                        *(f32x4*)d0 = a1; *(f32x4*)(d0 + DFF) = b1; *(f32x4*)d1 = ca; *(f32x4*)(d1 + DFF) = cb;
                    }
                    pa = ca; pb = cb;
                }
            }
        }
    }
};
struct EpiIn {
    static constexpr bool PERM = true;
    bf16* QKV; bf16* GATE; float* AB; const float* SS; const float* cw; const float* st; float* pg; float* sg; LAS unsigned char* ex; int nMp;
    __device__ __forceinline__ void operator()(const f32x4 (&acc)[2][2][4][2], const pg8::Unit& u, int row0, int wid, int wr, int wc, int fr_, int fq_) const {
        int fr = fr_, fq = fq_; asm volatile("" : "+v"(fr), "+v"(fq));
        const bool sample = (u.pm >= nMp);
        const int lo = (u.pm == 0 || sample) ? 0 : 3;
        exch_publish(ex, acc, SS, row0 + 64 * wr, wid, fr, fq);
        if (u.pn < 12) {
#pragma unroll
            for (int g4 = 0; g4 < 4; ++g4) {
                const int bj = g4 >> 1, n = g4 & 1, col = 256 * u.pn + 128 * bj + 32 * wc + 8 * fq + 4 * n;
                const f32x4 w0 = *(const f32x4*)(cw + col), w1 = *(const f32x4*)(cw + GCONV + col), w2 = *(const f32x4*)(cw + 2 * GCONV + col), w3 = *(const f32x4*)(cw + 3 * GCONV + col);
#pragma unroll
                for (int ai = 0; ai < 2; ++ai) {
                    f32x4 p = exch_prev(ex, ai, wid, wr, g4, fr, fq);
#pragma unroll
                    for (int m = 0; m < 4; ++m) {
                        const int R = 128 * ai + 64 * wr + 16 * m + fr, row = row0 + R;
                        const float rsv = row_rs(SS, row, fq); const f32x4 c = acc[ai][bj][m][n] * rsv;
                        if (!sample) {
                            const int b = row / TP, pos = row - b * TP;
                            const float m1 = pos >= 1 ? 1.f : 0.f, m2 = pos >= 2 ? 1.f : 0.f, m3 = pos >= 3 ? 1.f : 0.f;
                            f32x4 o;
#pragma unroll
                            for (int j = 0; j < 4; ++j) {
                                const float s1 = dpp_shift<1>(c[j], p[j]) * m1, s2 = dpp_shift<2>(c[j], p[j]) * m2, s3 = dpp_shift<3>(c[j], p[j]) * m3;
                                o[j] = siluf_(w3[j] * c[j] + w2[j] * s1 + w1[j] * s2 + w0[j] * s3);
                            }
                            if (R >= lo && row < ROWS_P) {
                                u32x2 w; w.x = pk2(o[0], o[1]); w.y = pk2(o[2], o[3]);
                                *(u32x2*)(QKV + (size_t)row * GCONV + col) = w;
                                if (pos >= TP - 3) *(f32x4*)(pg + (size_t)(b * 3 + pos - (TP - 3)) * GCONV + col) = c;
                            }
                        } else if (ai == 0) {
                            const int s = R;
                            const float* sp = st + (size_t)(s * 3) * GCONV + col;
                            const f32x4 t0 = *(const f32x4*)sp, t1 = *(const f32x4*)(sp + GCONV), t2 = *(const f32x4*)(sp + 2 * GCONV);
                            f32x4 o;
#pragma unroll
                            for (int j = 0; j < 4; ++j) o[j] = siluf_(w3[j] * c[j] + w2[j] * t2[j] + w1[j] * t1[j] + w0[j] * t0[j]);
                            u32x2 w; w.x = pk2(o[0], o[1]); w.y = pk2(o[2], o[3]);
                            *(u32x2*)(QKV + (size_t)row * GCONV + col) = w;
                            float* d = sg + (size_t)(s * 3) * GCONV + col;
                            *(f32x4*)d = t1; *(f32x4*)(d + GCONV) = t2; *(f32x4*)(d + 2 * GCONV) = c;
                        }
                        p = c;
                    }
                }
            }
        } else {
#pragma unroll
            for (int ai = 0; ai < 2; ++ai)
#pragma unroll
                for (int m = 0; m < 4; ++m) {
                    const int R = 128 * ai + 64 * wr + 16 * m + fr, row = row0 + R;
                    const bool valid = sample ? (ai == 0) : (R >= lo && row < ROWS_P);
                    const float rsv = row_rs(SS, row, fq);
                    if (!valid) continue;
                    if (u.pn < 16) {
#pragma unroll
                        for (int bj = 0; bj < 2; ++bj) {
                            const f32x4 c0 = acc[ai][bj][m][0] * rsv, c1 = acc[ai][bj][m][1] * rsv;
                            u32x4 w; w.x = pk2(c0[0], c0[1]); w.y = pk2(c0[2], c0[3]); w.z = pk2(c1[0], c1[1]); w.w = pk2(c1[2], c1[3]);
                            *(u32x4*)(GATE + (size_t)row * DM + 256 * (u.pn - 12) + 128 * bj + 32 * wc + 8 * fq) = w;
                        }
                    } else if (wc == 0 && fq < 2) {
                        *(f32x4*)(AB + (size_t)row * 16 + 8 * fq) = acc[ai][0][m][0] * rsv;
                        *(f32x4*)(AB + (size_t)row * 16 + 8 * fq + 4) = acc[ai][0][m][1] * rsv;
                    }
                }
        }
    }
};

__device__ __forceinline__ void tr_item(const float* W, int ldw, int K, bf16* WT, int n0, int src0, int nvalid, int k0, const float* scale, LAS float* scr, int lane) {
    const int j = lane & 31;
#pragma unroll 8
    for (int i = 0; i < 32; ++i) { const int kk = 2 * i + (lane >> 5);
        float v = (j < nvalid) ? W[(size_t)(k0 + kk) * ldw + src0 + j] : 0.f;
        if (scale) v *= scale[k0 + kk];
        scr[kk * 33 + j] = v; }
    LDS_WAIT(); asm volatile("" ::: "memory");
    const int c = lane & 7;
#pragma unroll
    for (int jj = 0; jj < 4; ++jj) { const int n = (lane >> 3) + 8 * jj; const LAS float* s = scr + (8 * c) * 33 + n;
        u32x4 o; o.x = pk2(s[0 * 33], s[1 * 33]); o.y = pk2(s[2 * 33], s[3 * 33]); o.z = pk2(s[4 * 33], s[5 * 33]); o.w = pk2(s[6 * 33], s[7 * 33]);
        *(u32x4*)(WT + (size_t)(n0 + n) * K + k0 + 8 * c) = o; }
    LDS_WAIT(); asm volatile("" ::: "memory");
}
__device__ __forceinline__ int glu_src(int n0, int half_stride) { const int pn = n0 >> 8, bj = (n0 >> 7) & 1, cc0 = n0 & 127; return bj * half_stride + 128 * pn + cc0; }

__device__ __forceinline__ void p0_s5_group(Frame& F, int g) {
    const float* lam_re = F.in[11]; const float* lam_im = F.in[12]; const float* log_step = F.in[13];
    const float* b_re = F.in[14]; const float* b_im = F.in[15]; const float* c_re = F.in[16]; const float* c_im = F.in[17]; const float* dsk = F.in[18];
    LAS float* LP = (LAS float*)(F.lds);
    LAS float* BB = (LAS float*)(F.lds + 8704);
    LAS float* CC = (LAS float*)(F.lds + 16896);
    LAS float* KT = (LAS float*)(F.lds + 25088);
    const float dl = __expf(log_step[g]);
    for (int idx = F.tid; idx < 17 * 64; idx += 512) { const int n = idx >> 6, p = idx & 63;
        const float lre = lam_re[g * 64 + p], lim = lam_im[g * 64 + p];
        const float mag = expf((float)n * dl * lre); float sn, cs; sincosf((float)n * dl * lim, &sn, &cs);
        LP[idx * 2] = mag * cs; LP[idx * 2 + 1] = mag * sn; }
    for (int idx = F.tid; idx < 16 * 64; idx += 512) { const int c = idx >> 6, p = idx & 63; CC[idx * 2] = c_re[(g * 16 + c) * 64 + p]; CC[idx * 2 + 1] = c_im[(g * 16 + c) * 64 + p]; }
    __syncthreads();
    for (int idx = F.tid; idx < 64 * 16; idx += 512) { const int p = idx >> 4;
        const float lre = lam_re[g * 64 + p], lim = lam_im[g * 64 + p];
        const float nr = LP[(64 + p) * 2] - 1.f, ni = LP[(64 + p) * 2 + 1], den = 1.f / (lre * lre + lim * lim);
        const float qr = (nr * lre + ni * lim) * den, qi = (ni * lre - nr * lim) * den;
        const float br = b_re[(size_t)g * 1024 + idx], bi = b_im[(size_t)g * 1024 + idx];
        BB[idx * 2] = qr * br - qi * bi; BB[idx * 2 + 1] = qr * bi + qi * br; }
    __syncthreads();
    for (int idx = F.tid; idx < 4096; idx += 512) { const int tau = idx >> 8, c = (idx >> 4) & 15, c2 = idx & 15; float s = 0.f;
        for (int p = 0; p < 64; ++p) { const float cr = CC[(c * 64 + p) * 2], ci = CC[(c * 64 + p) * 2 + 1], lr = LP[(tau * 64 + p) * 2], li = LP[(tau * 64 + p) * 2 + 1];
            const float tr = cr * lr - ci * li, ti = cr * li + ci * lr, br = BB[(p * 16 + c2) * 2], bi = BB[(p * 16 + c2) * 2 + 1];
            s += tr * br - ti * bi; }
        KT[idx] = s; }
    __syncthreads();
    float* misc = (float*)(F.ws + WS_MISC);
    for (int idx = F.tid; idx < 64; idx += 512) { misc[(g * 64 + idx) * 2] = LP[(16 * 64 + idx) * 2]; misc[(g * 64 + idx) * 2 + 1] = LP[(16 * 64 + idx) * 2 + 1];
        misc[8192 + (g * 64 + idx) * 2] = LP[(64 + idx) * 2]; misc[8192 + (g * 64 + idx) * 2 + 1] = LP[(64 + idx) * 2 + 1]; }
    for (int idx = F.tid; idx < 2048; idx += 512) misc[32768 + g * 2048 + idx] = BB[idx];
    unsigned* wg = (unsigned*)(F.ws + WS_S5M + (size_t)g * S5M_G);
    for (int idx = F.tid; idx < 128 * 128; idx += 512) { const int pp = idx >> 7, k = 2 * (idx & 127), s = k >> 4, c2 = k & 15, p = pp >> 1;
        const float lr = LP[((15 - s) * 64 + p) * 2], li = LP[((15 - s) * 64 + p) * 2 + 1];
        float v[2];
#pragma unroll
        for (int e = 0; e < 2; ++e) { const float br = BB[(p * 16 + c2 + e) * 2], bi = BB[(p * 16 + c2 + e) * 2 + 1]; v[e] = (pp & 1) ? (lr * bi + li * br) : (lr * br - li * bi); }
        wg[idx] = pk2(v[0], v[1]); }
    unsigned* tv = (unsigned*)(F.ws + WS_S5M + (size_t)g * S5M_G + S5M_WG);
    for (int idx = F.tid; idx < 256 * 192; idx += 512) { const int n = idx / 192, k = 2 * (idx - n * 192), t = n >> 4, c = n & 15;
        float v0, v1;
        if (k < 256) { const int s = k >> 4, c2 = k & 15;
            if (s <= t) { v0 = KT[((t - s) * 16 + c) * 16 + c2]; v1 = KT[((t - s) * 16 + c) * 16 + c2 + 1];
                if (s == t) { const float dd = dsk[g * 16 + c]; if (c2 == c) v0 += dd; if (c2 + 1 == c) v1 += dd; } }
            else { v0 = 0.f; v1 = 0.f; } }
        else { const int p = (k - 256) >> 1; const float cr = CC[(c * 64 + p) * 2], ci = CC[(c * 64 + p) * 2 + 1], lr = LP[((t + 1) * 64 + p) * 2], li = LP[((t + 1) * 64 + p) * 2 + 1];
            v0 = cr * lr - ci * li; v1 = -(cr * li + ci * lr); }
        tv[idx] = pk2(v0, v1); }
    __syncthreads();
}

__device__ __forceinline__ void p0_prologue(Frame& F) {
    if (F.vcu < 64) p0_s5_group(F, F.vcu);
    LAS float* scr = (LAS float*)(F.lds + F.wave * 8704);
    const int gw = F.vcu * NWAVES + F.wave, NGW = F.G * NWAVES;
    { const float* nw = F.in[8]; bf16* U = (bf16*)(F.ws + WS_BIG); float* HS = (float*)(F.ws + WS_HS);
      f32x4 nv[4];
#pragma unroll
      for (int j = 0; j < 4; ++j) nv[j] = *(const f32x4*)(nw + 4 * F.lane + 256 * j);
      for (int row = gw; row < ROWS; row += NGW) {
        const float* xr = xin_ptr(F.in[0], F.in[1], F.in[7], row);
        f32x4 v[4]; float s = 0.f;
#pragma unroll
        for (int j = 0; j < 4; ++j) { v[j] = *(const f32x4*)(xr + 4 * F.lane + 256 * j); s += (v[j].x * v[j].x + v[j].y * v[j].y) + (v[j].z * v[j].z + v[j].w * v[j].w); }
        const float r = 1.f / sqrtf(wave_sum(s) * (1.f / DM) + EPS);
        if (row < ROWS_P) { const int b = row / TP, pos = row - b * TP, chunk = pos >> 4, t = pos & 15;
#pragma unroll
            for (int j = 0; j < 4; ++j) { const int g = (F.lane >> 2) + 16 * j, c = 4 * (F.lane & 3); const f32x4 h = v[j] * r * nv[j];
                u32x2 w; w.x = pk2(h.x, h.y); w.y = pk2(h.z, h.w);
                *(u32x2*)(U + ((size_t)((b * 64 + g) * S5NCHP + chunk) * 256 + t * 16 + c)) = w; } }
        else {
#pragma unroll
            for (int j = 0; j < 4; ++j) *(f32x4*)(HS + (size_t)(row - ROWS_P) * DM + 4 * F.lane + 256 * j) = v[j] * r * nv[j]; }
      } }
    const int I_GLU = 16 * 64, I_UP = 16 * 176, I_DN = 44 * 32, I_IN = 16 * 136, I_O = 16 * 32;
    const int NIT = I_GLU + 2 * I_UP + 2 * I_DN + I_IN + I_O;
    for (int it = gw; it < NIT; it += NGW) {
        int r = it;
        if (r < I_GLU) { const int kb = r / 64, nb = r % 64, n0 = 32 * nb; tr_item(F.in[19], 2048, DM, (bf16*)(F.ws + WS_WGLU), n0, glu_src(n0, 1024), 32, 64 * kb, nullptr, scr, F.lane); continue; } r -= I_GLU;
        if (r < 2 * I_UP) { const int l = r / I_UP; r -= l * I_UP; const int kb = r / 176, nb = r % 176, n0 = 32 * nb;
            tr_item(F.in[26] + (size_t)l * DM * UPN, UPN, DM, (bf16*)(F.ws + (l ? WS_WUP1 : WS_WUP0)), n0, glu_src(n0, DFF), 32, 64 * kb, F.in[9] + l * DM, scr, F.lane); continue; } r -= 2 * I_UP;
        if (r < 2 * I_DN) { const int l = r / I_DN; r -= l * I_DN; const int kb = r / 32, nb = r % 32, n0 = 32 * nb;
            tr_item(F.in[28] + (size_t)l * DFF * DM, DM, DFF, (bf16*)(F.ws + (l ? WS_WDN1 : WS_WDN0)), n0, n0, 32, 64 * kb, nullptr, scr, F.lane); continue; } r -= 2 * I_DN;
        if (r < I_IN) { const int kb = r / 136, nb = r % 136, n0 = 32 * nb; int nv = GIN - n0; nv = nv < 0 ? 0 : (nv > 32 ? 32 : nv);
            tr_item(F.in[20], GIN, DM, (bf16*)(F.ws + WS_WIN), n0, n0, nv, 64 * kb, F.in[8] + DM, scr, F.lane); continue; } r -= I_IN;
        { const int kb = r / 32, nb = r % 32, n0 = 32 * nb; tr_item(F.in[25], DM, DM, (bf16*)(F.ws + WS_WO), n0, n0, 32, 64 * kb, nullptr, scr, F.lane); }
    }
}

#define MFMA16(a, b, c) __builtin_amdgcn_mfma_f32_16x16x32_bf16((a), (b), (c), 0, 0, 0)
constexpr int S5_UST = 528, S5_HL = 68608;
__device__ __forceinline__ void s5_prompt_item(Frame& F, int b, int g) {
    LAS unsigned char* UT = F.lds; LAS unsigned char* HL = F.lds + S5_HL;
    const int fr = F.lane & 15, fq = F.lane >> 4, w = F.wave;
    { const unsigned char* src = F.ws + WS_BIG + (size_t)((b * 64 + g) * S5NCHP) * 512;
      for (int piece = F.tid; piece < S5NCH * 32; piece += 512) { const int r = piece >> 5, c16 = piece & 31;
          *(LAS u32x4*)(UT + r * S5_UST + c16 * 16) = *(const u32x4*)(src + (size_t)r * 512 + c16 * 16); } }
    __syncthreads();
    const unsigned char* wg = F.ws + WS_S5M + (size_t)g * S5M_G; const unsigned char* tv = wg + S5M_WG;
    {
        bf16x8 af[8];
#pragma unroll
        for (int ks = 0; ks < 8; ++ks) af[ks] = *(const bf16x8*)(wg + ((size_t)(16 * w + fr) * 256 + 32 * ks + 8 * fq) * 2);
        for (int jt = 0; jt < 9; ++jt) { const int chunk = 16 * jt + fr, cr = chunk < S5NCH ? chunk : S5NCH - 1;
            f32x4 acc = (f32x4){0.f, 0.f, 0.f, 0.f};
#pragma unroll
            for (int ks = 0; ks < 8; ++ks) acc = MFMA16(af[ks], *(const LAS bf16x8*)(UT + cr * S5_UST + (32 * ks + 8 * fq) * 2), acc);
            if (chunk < S5NCH) *(LAS f32x4*)(HL + chunk * 512 + (16 * w + 4 * fq) * 4) = acc; }
    }
    __syncthreads();
    if (w == 0) {
        const int p = F.lane; const float* misc = (const float*)(F.ws + WS_MISC);
        const float lr = misc[(g * 64 + p) * 2], li = misc[(g * 64 + p) * 2 + 1];
        float hr = 0.f, hi = 0.f;
        for (int c = 0; c < S5NCH; ++c) {
            const f32x2 hv = *(const LAS f32x2*)(HL + c * 512 + 8 * p);
            asm volatile("" ::: "memory");
            *(LAS unsigned*)(HL + c * 512 + (((p >> 2) ^ (c & 15)) * 16) + (p & 3) * 4) = pk2(hr, hi);
            const float nr = lr * hr - li * hi + hv.x, ni = lr * hi + li * hr + hv.y; hr = nr; hi = ni; }
        F.out[O_PS5RE + (size_t)(b * 64 + g) * 64 + p] = hr; F.out[O_PS5IM + (size_t)(b * 64 + g) * 64 + p] = hi;
    }
    __syncthreads();
    {
        bf16x8 af[2][12];
#pragma unroll
        for (int il = 0; il < 2; ++il)
#pragma unroll
            for (int ks = 0; ks < 12; ++ks) af[il][ks] = *(const bf16x8*)(tv + ((size_t)(16 * (2 * w + il) + fr) * 384 + 32 * ks + 8 * fq) * 2);
        bf16* A1 = (bf16*)(F.ws + WS_B2);
        for (int jt = 0; jt < 9; ++jt) { const int chunk = 16 * jt + fr, cr = chunk < S5NCH ? chunk : S5NCH - 1;
            bf16x8 bfr[12];
#pragma unroll
            for (int ks = 0; ks < 8; ++ks) bfr[ks] = *(const LAS bf16x8*)(UT + cr * S5_UST + (32 * ks + 8 * fq) * 2);
#pragma unroll
            for (int ks = 0; ks < 4; ++ks) bfr[8 + ks] = *(const LAS bf16x8*)(HL + cr * 512 + (((4 * ks + fq) ^ (cr & 15)) * 16));
#pragma unroll
            for (int il = 0; il < 2; ++il) { f32x4 acc = (f32x4){0.f, 0.f, 0.f, 0.f};
#pragma unroll
                for (int ks = 0; ks < 12; ++ks) acc = MFMA16(af[il][ks], bfr[ks], acc);
                if (chunk < S5NCH) { u32x2 o; o.x = pk2(gelu_tanh(acc[0]), gelu_tanh(acc[1])); o.y = pk2(gelu_tanh(acc[2]), gelu_tanh(acc[3]));
                    *(u32x2*)(A1 + (size_t)(b * TP + chunk * 16 + 2 * w + il) * DM + 16 * g + 4 * fq) = o; } } }
    }
    __syncthreads();
}
__device__ __forceinline__ void p1_s5(Frame& F) {
    for (int it = F.vcu; it < NB * S5G; it += F.G) s5_prompt_item(F, it >> 6, it & 63);
    const int gw = F.vcu * NWAVES + F.wave, NGW = F.G * NWAVES, p = F.lane;
    const float* misc = (const float*)(F.ws + WS_MISC); const float* HS = (const float*)(F.ws + WS_HS); bf16* A1 = (bf16*)(F.ws + WS_B2);
    const float* c_re = F.in[16]; const float* c_im = F.in[17]; const float* dsk = F.in[18];
    for (int it = gw; it < NS * S5G; it += NGW) { const int s = it >> 6, g = it & 63;
        float u[16];
#pragma unroll
        for (int j = 0; j < 4; ++j) { const f32x4 t = *(const f32x4*)(HS + (size_t)s * DM + 16 * g + 4 * j); u[4 * j] = t.x; u[4 * j + 1] = t.y; u[4 * j + 2] = t.z; u[4 * j + 3] = t.w; }
        const size_t si = (size_t)(s * 64 + g) * 64 + p;
        const float h0r = F.in[2][si], h0i = F.in[3][si], lr = misc[8192 + (g * 64 + p) * 2], li = misc[8192 + (g * 64 + p) * 2 + 1];
        float hr = lr * h0r - li * h0i, hi = lr * h0i + li * h0r;
        const float* bb = misc + 32768 + (size_t)(g * 64 + p) * 32;
#pragma unroll
        for (int j = 0; j < 8; ++j) { const f32x4 t = *(const f32x4*)(bb + 4 * j); hr += t.x * u[2 * j] + t.z * u[2 * j + 1]; hi += t.y * u[2 * j] + t.w * u[2 * j + 1]; }
        F.out[O_SS5RE + si] = hr; F.out[O_SS5IM + si] = hi;
        float mine = 0.f;
#pragma unroll
        for (int c = 0; c < 16; ++c) { const float part = c_re[(g * 16 + c) * 64 + p] * hr - c_im[(g * 16 + c) * 64 + p] * hi; const float t = wave_sum(part); if (p == c) mine = t; }
        if (p < 16) { const float uu = HS[(size_t)s * DM + 16 * g + p]; const float y = mine + dsk[16 * g + p] * uu;
            A1[(size_t)(ROWS_P + s) * DM + 16 * g + p] = (bf16)f2bf(gelu_tanh(y)); }
    }
}

struct Slot { unsigned char* base; int stride; };
__device__ __forceinline__ Slot gdn_slot(unsigned char* ws, int bh, int c, int which) {
    Slot s;
    if (c == 0) { s.base = ws + WS_C0 + (size_t)(bh * 3 + which) * 16384; s.stride = 256; }
    else { const int b = bh >> 3, h = bh & 7; s.base = ws + WS_BIG + ((size_t)(b * TP + NMETA + 64 * (c - 1)) * GCONV + which * 1024 + 128 * h) * 2; s.stride = GCONV * 2; }
    return s;
}
__device__ __forceinline__ int gdn_row(int b, int c, int i) { return c == 0 ? (i >= GNULL ? b * TP + i - GNULL : -1) : b * TP + NMETA + 64 * (c - 1) + i; }
__device__ __forceinline__ float softplusf_(float x) { return x > 20.f ? x : log1pf(__expf(x)); }
__device__ __forceinline__ bf16x8 mk8(u32x2 lo, u32x2 hi) { u32x4 t; t.x = lo.x; t.y = lo.y; t.z = hi.x; t.w = hi.y; return __builtin_bit_cast(bf16x8, t); }
__device__ __forceinline__ float sq8(bf16x8 v) { const u32x4 t = __builtin_bit_cast(u32x4, v); float s = 0.f;
#pragma unroll
    for (int e = 0; e < 4; ++e) { const float a = bflo(t[e]), b = bfhi(t[e]); s += a * a + b * b; } return s; }

__device__ __forceinline__ f32x4 ld4bf(const void* p) { const u32x2 v = *(const u32x2*)p; return (f32x4){bflo(v.x), bfhi(v.x), bflo(v.y), bfhi(v.y)}; }
__device__ __forceinline__ bf16x8 pack2(const f32x4& a, const f32x4& b) { u32x2 lo, hi; lo.x = pk2(a[0], a[1]); lo.y = pk2(a[2], a[3]); hi.x = pk2(b[0], b[1]); hi.y = pk2(b[2], b[3]); return mk8(lo, hi); }
__device__ __forceinline__ float dot4_asm(float a0, float a1, float a2, float a3, const f32x4& v) {
    float t;
    asm("v_mul_f32 %0, %1, %2" : "=v"(t) : "v"(a0), "v"(v.x));
    asm("v_fmac_f32 %0, %1, %2" : "+v"(t) : "v"(a1), "v"(v.y));
    asm("v_fmac_f32 %0, %1, %2" : "+v"(t) : "v"(a2), "v"(v.z));
    asm("v_fmac_f32 %0, %1, %2" : "+v"(t) : "v"(a3), "v"(v.w));
    return t;
}
__device__ __forceinline__ void p6_item(Frame& F, int item, LAS unsigned char* wl) {
    int l_ = F.lane; asm volatile("" : "+v"(l_));
    const int bh = item / GNCH, c = item - bh * GNCH, b = bh >> 3, h = bh & 7, l = l_, fr = l & 15, fq = l >> 4;
    LAS float* LmT = (LAS float*)wl; LAS float* SC = (LAS float*)(wl + 16384);
    LAS unsigned char* TM = wl; LAS unsigned char* AT = wl + 8192;
    const f32x4 z4 = (f32x4){0.f, 0.f, 0.f, 0.f};
    const bf16x8 zf = (bf16x8){0, 0, 0, 0, 0, 0, 0, 0};
    const int rb0 = (c == 0) ? b * TP - GNULL : b * TP + NMETA + 64 * (c - 1);
    const unsigned char* qkvu = F.ws + WS_BIG + ((size_t)rb0 * GCONV + 128 * h) * 2;
    const Slot qs = gdn_slot(F.ws, bh, c, 0), ksl = gdn_slot(F.ws, bh, c, 1), vsl = gdn_slot(F.ws, bh, c, 2);
    unsigned char* wxu = F.ws + WS_WX + (size_t)item * 16384;
    unsigned char* onu = F.ws + WS_B1 + ((size_t)rb0 * DM + 128 * h) * 2;
    const unsigned vo_f = (unsigned)(fr * (GCONV * 2) + fq * 16);
    const unsigned vo_q = (unsigned)(fr * (GCONV * 2) + fq * 8);
    const unsigned vo_t = (unsigned)((fr >> 1) * ksl.stride + (fr & 1) * 128 + fq * 8);
    const unsigned vo_p = (unsigned)(fr * qs.stride + fq * 8);
    const unsigned vo_w = (unsigned)(fr * 256 + fq * 8);
    const unsigned vo_o = (unsigned)(fr * (DM * 2) + fq * 8);
#define P6_RTV(rt) (c > 0 || (rt) == 3)
#pragma unroll
    for (int q = 0; q < 16; ++q) *(LAS f32x4*)(wl + (q * 64 + l) * 16) = z4;
    float gl;
    { const bool rv = (c > 0) || (l >= GNULL); float g = 0.f, be = 0.f;
      if (rv) { const float* ab = (const float*)(F.ws + WS_AB) + (size_t)(rb0 + l) * 16; const float a = ab[h], bq = ab[8 + h];
          g = -__expf(F.in[22][h]) * softplusf_(a + F.in[23][h]); be = sigmoidf_(bq); }
      float gc = g;
#pragma unroll
      for (int o = 1; o < 64; o <<= 1) { const float t = __shfl_up(gc, o); if (l >= o) gc += t; }
      gl = __shfl(gc, 63);
      SC[l] = gc; SC[64 + l] = be; }
    {
        bf16x8 kf[4][4];
#pragma unroll
        for (int rt = 0; rt < 4; ++rt) {
#pragma unroll
            for (int ks = 0; ks < 4; ++ks) kf[rt][ks] = P6_RTV(rt) ? *(const bf16x8*)(qkvu + (size_t)(rt * 16 * GCONV * 2 + 2048 + ks * 64) + vo_f) : zf;
            float sk = 0.f;
#pragma unroll
            for (int ks = 0; ks < 4; ++ks) sk += sq8(kf[rt][ks]);
            sk += __shfl_xor(sk, 16); sk += __shfl_xor(sk, 32);
            if (fq == 0) SC[128 + 16 * rt + fr] = 1.f / sqrtf(sk + 1e-6f); }
#pragma unroll
        for (int it = 0; it < 4; ++it) {
            const f32x4 gci = *(const LAS f32x4*)(SC + 16 * it + 4 * fq), bei = *(const LAS f32x4*)(SC + 64 + 16 * it + 4 * fq), rki = *(const LAS f32x4*)(SC + 128 + 16 * it + 4 * fq);
#pragma unroll
            for (int jt = 0; jt <= it; ++jt) {
                f32x4 dk = z4;
#pragma unroll
                for (int ks = 0; ks < 4; ++ks) dk = MFMA16(kf[it][ks], kf[jt][ks], dk);
                const int j = 16 * jt + fr; const float gcj = SC[j], rkj = SC[128 + j];
                f32x4 lm;
#pragma unroll
                for (int r = 0; r < 4; ++r) { const int i = 16 * it + 4 * fq + r; lm[r] = (j < i) ? bei[r] * rki[r] * __expf(gci[r] - gcj) * rkj * dk[r] : 0.f; }
                *(LAS f32x4*)(LmT + j * 64 + 16 * it + 4 * fq) = lm;
            } }
    }
    __builtin_amdgcn_sched_barrier(0);
    {
        float r[64];
#pragma unroll
        for (int j = 0; j < 64; ++j) r[j] = 0.f;
#pragma unroll
        for (int j = 63; j >= 0; --j) { float acc = (l == j) ? 1.f : 0.f;
#pragma unroll
            for (int kg = ((j + 1) & ~3); kg < 64; kg += 4) { const f32x4 v = *(const LAS f32x4*)(LmT + j * 64 + kg); acc -= dot4_asm(r[kg], r[kg + 1], r[kg + 2], r[kg + 3], v); }
            r[j] = acc; }
#pragma unroll
        for (int c8 = 0; c8 < 8; ++c8) { u32x4 o; o.x = pk2(r[8 * c8], r[8 * c8 + 1]); o.y = pk2(r[8 * c8 + 2], r[8 * c8 + 3]); o.z = pk2(r[8 * c8 + 4], r[8 * c8 + 5]); o.w = pk2(r[8 * c8 + 6], r[8 * c8 + 7]);
            *(LAS u32x4*)(TM + l * 128 + c8 * 16) = o; }
    }
    __builtin_amdgcn_sched_barrier(0);
    bf16x8 sel[2];
#pragma unroll
    for (int hf = 0; hf < 2; ++hf) {
#pragma unroll
        for (int jj = 0; jj < 8; ++jj) sel[hf][jj] = (8 * fq + jj == 16 * hf + fr) ? (short)0x3F80 : (short)0; }
    bf16x8 tmF[4][2], atF[4][2];
    {
#pragma unroll
        for (int q = 0; q < 8; ++q) *(LAS u32x4*)(AT + (q * 64 + l) * 16) = (u32x4){0u, 0u, 0u, 0u};
        bf16x8 kf[4][4];
#pragma unroll
        for (int rt = 0; rt < 4; ++rt)
#pragma unroll
            for (int ks = 0; ks < 4; ++ks) kf[rt][ks] = P6_RTV(rt) ? *(const bf16x8*)(qkvu + (size_t)(rt * 16 * GCONV * 2 + 2048 + ks * 64) + vo_f) : zf;
#pragma unroll
        for (int it = 0; it < 4; ++it) {
            bf16x8 qf[4];
#pragma unroll
            for (int ks = 0; ks < 4; ++ks) qf[ks] = P6_RTV(it) ? *(const bf16x8*)(qkvu + (size_t)(it * 16 * GCONV * 2 + ks * 64) + vo_f) : zf;
            { float sq = 0.f;
#pragma unroll
              for (int ks = 0; ks < 4; ++ks) sq += sq8(qf[ks]);
              sq += __shfl_xor(sq, 16); sq += __shfl_xor(sq, 32);
              if (fq == 0) SC[192 + 16 * it + fr] = 0.08838834764831845f / sqrtf(sq + 1e-6f); }
            const f32x4 gci = *(const LAS f32x4*)(SC + 16 * it + 4 * fq), rqi = *(const LAS f32x4*)(SC + 192 + 16 * it + 4 * fq);
#pragma unroll
            for (int jt = 0; jt <= it; ++jt) {
                f32x4 dq = z4;
#pragma unroll
                for (int ks = 0; ks < 4; ++ks) dq = MFMA16(qf[ks], kf[jt][ks], dq);
                const int j = 16 * jt + fr; const float gcj = SC[j], rkj = SC[128 + j];
                LAS unsigned short* ap = (LAS unsigned short*)(AT + ((16 * it + 4 * fq) * 64 + j) * 2);
#pragma unroll
                for (int r = 0; r < 4; ++r) { const int i = 16 * it + 4 * fq + r; const float aa = (j <= i) ? rqi[r] * __expf(gci[r] - gcj) * rkj * dq[r] : 0.f; ap[64 * r] = (unsigned short)f2bf(aa); }
            } }
        __builtin_amdgcn_sched_barrier(0);
        asm volatile("s_waitcnt vmcnt(0)" ::: "memory");
#pragma unroll
        for (int it = 0; it < 4; ++it)
#pragma unroll
            for (int js = 0; js < 2; ++js) {
                tmF[it][js] = mk8(*(const LAS u32x2*)(TM + (16 * it + fr) * 128 + (32 * js + 4 * fq) * 2), *(const LAS u32x2*)(TM + (16 * it + fr) * 128 + (32 * js + 16 + 4 * fq) * 2));
                atF[it][js] = mk8(*(const LAS u32x2*)(AT + (16 * it + fr) * 128 + (32 * js + 4 * fq) * 2), *(const LAS u32x2*)(AT + (16 * it + fr) * 128 + (32 * js + 16 + 4 * fq) * 2)); }
        float qsc[4];
#pragma unroll
        for (int it2 = 0; it2 < 4; ++it2) qsc[it2] = SC[192 + 16 * it2 + fr] * __expf(SC[16 * it2 + fr]);
#pragma unroll
        for (int ks = 0; ks < 4; ++ks)
#pragma unroll
            for (int hf = 0; hf < 2; ++hf) { const int dt = 2 * ks + hf; u32x2 hh[4];
#pragma unroll
                for (int rt = 0; rt < 4; ++rt) { const f32x4 d = MFMA16(kf[rt][ks], sel[hf], z4);
                    const f32x4 gci = *(const LAS f32x4*)(SC + 16 * rt + 4 * fq), bei = *(const LAS f32x4*)(SC + 64 + 16 * rt + 4 * fq), rki = *(const LAS f32x4*)(SC + 128 + 16 * rt + 4 * fq);
                    f32x4 sw, sd;
#pragma unroll
                    for (int e = 0; e < 4; ++e) { sw[e] = d[e] * bei[e] * rki[e] * __expf(gci[e]); sd[e] = d[e] * rki[e] * __expf(gl - gci[e]); }
                    hh[rt].x = pk2(sw[0], sw[1]); hh[rt].y = pk2(sw[2], sw[3]);
                    u32x2 kd; kd.x = pk2(sd[0], sd[1]); kd.y = pk2(sd[2], sd[3]);
                    *(u32x2*)(ksl.base + (size_t)(8 * dt * ksl.stride + 32 * rt) + vo_t) = kd; }
                const bf16x8 Rw0 = mk8(hh[0], hh[1]), Rw1 = mk8(hh[2], hh[3]);
                f32x4 wD[4];
#pragma unroll
                for (int it = 0; it < 4; ++it) { f32x4 a = MFMA16(tmF[it][0], Rw0, z4); a = MFMA16(tmF[it][1], Rw1, a); f32x4 t = MFMA16(Rw0, tmF[it][0], z4); t = MFMA16(Rw1, tmF[it][1], t);
                    wD[it] = a;
                    u32x2 o; o.x = pk2(t[0], t[1]); o.y = pk2(t[2], t[3]);
                    *(u32x2*)(wxu + (size_t)(it * 4096 + 32 * dt) + vo_w) = o; }
                const bf16x8 wA0 = pack2(wD[0], wD[1]), wA1 = pack2(wD[2], wD[3]);
#pragma unroll
                for (int it2 = 0; it2 < 4; ++it2) { f32x4 a = MFMA16(wA0, atF[it2][0], z4); a = MFMA16(wA1, atF[it2][1], a);
                    u32x2 qv = (u32x2){0u, 0u};
                    if (P6_RTV(it2)) qv = *(const u32x2*)(qkvu + (size_t)(it2 * 16 * GCONV * 2 + 32 * dt) + vo_q);
                    const float sc = qsc[it2];
                    u32x2 o; o.x = pk2(bflo(qv.x) * sc - a[0], bfhi(qv.x) * sc - a[1]); o.y = pk2(bflo(qv.y) * sc - a[2], bfhi(qv.y) * sc - a[3]);
                    *(u32x2*)(qs.base + (size_t)(16 * it2 * qs.stride + 32 * dt) + vo_p) = o; }
                __builtin_amdgcn_sched_barrier(0);
            }
    }
    __builtin_amdgcn_sched_barrier(0);
    {
        bf16x8 vf[4][4];
#pragma unroll
        for (int rt = 0; rt < 4; ++rt)
#pragma unroll
            for (int ks = 0; ks < 4; ++ks) vf[rt][ks] = P6_RTV(rt) ? *(const bf16x8*)(qkvu + (size_t)(rt * 16 * GCONV * 2 + 4096 + ks * 64) + vo_f) : zf;
        asm volatile("s_waitcnt vmcnt(0)" ::: "memory");
        __builtin_amdgcn_sched_barrier(0);
#pragma unroll
        for (int ks = 0; ks < 4; ++ks)
#pragma unroll
            for (int hf = 0; hf < 2; ++hf) { const int dt = 2 * ks + hf; u32x2 hh[4];
#pragma unroll
                for (int rt = 0; rt < 4; ++rt) { const f32x4 d = MFMA16(vf[rt][ks], sel[hf], z4); const f32x4 sb = *(const LAS f32x4*)(SC + 64 + 16 * rt + 4 * fq);
                    hh[rt].x = pk2(d[0] * sb[0], d[1] * sb[1]); hh[rt].y = pk2(d[2] * sb[2], d[3] * sb[3]); }
                const bf16x8 Ru0 = mk8(hh[0], hh[1]), Ru1 = mk8(hh[2], hh[3]);
                f32x4 uD[4];
#pragma unroll
                for (int it = 0; it < 4; ++it) { f32x4 a = MFMA16(tmF[it][0], Ru0, z4); a = MFMA16(tmF[it][1], Ru1, a); uD[it] = a;
                    u32x2 o; o.x = pk2(a[0], a[1]); o.y = pk2(a[2], a[3]);
                    *(u32x2*)(vsl.base + (size_t)(8 * dt * vsl.stride + 32 * it) + vo_t) = o; }
                const bf16x8 uA0 = pack2(uD[0], uD[1]), uA1 = pack2(uD[2], uD[3]);
#pragma unroll
                for (int it2 = 0; it2 < 4; ++it2) { f32x4 a = MFMA16(uA0, atF[it2][0], z4); a = MFMA16(uA1, atF[it2][1], a);
                    if (P6_RTV(it2)) { u32x2 o; o.x = pk2(a[0], a[1]); o.y = pk2(a[2], a[3]); *(u32x2*)(onu + (size_t)(it2 * 16 * DM * 2 + 32 * dt) + vo_o) = o; } }
                __builtin_amdgcn_sched_barrier(0);
            }
    }
#undef P6_RTV
    if (l == 0) ((float*)(F.ws + WS_HS + 768 * 1024))[item] = __expf(gl);
}
__device__ __forceinline__ void p6_gdn_pre(Frame& F) {
    const int gw = F.vcu * NWAVES + F.wave, NGW = F.G * NWAVES;
    LAS unsigned char* wl = F.lds + F.wave * 17408;
    for (int item = gw; item < NB * GH * GNCH; item += NGW) p6_item(F, item, wl);
}

__device__ __forceinline__ void p7_prompt(Frame& F, int bh) {
    const int b = bh >> 3, h = bh & 7, l = F.lane, fr = l & 15, fq = l >> 4, w = F.wave;
    const f32x4 z4 = (f32x4){0.f, 0.f, 0.f, 0.f};
    f32x4 S[8];
#pragma unroll
    for (int mt = 0; mt < 8; ++mt) S[mt] = z4;
    bf16* ON = (bf16*)(F.ws + WS_B1); const bf16* GATE = (const bf16*)(F.ws + WS_B2); const float* EG = (const float*)(F.ws + WS_HS + 768 * 1024); const float* onw = F.in[24];
    const int dv = 16 * w + fr;
    for (int c = 0; c < GNCH; ++c) {
        const int item = bh * GNCH + c;
        const Slot qs = gdn_slot(F.ws, bh, c, 0), ksl = gdn_slot(F.ws, bh, c, 1), vsl = gdn_slot(F.ws, bh, c, 2);
        const unsigned char* wx = F.ws + WS_WX + (size_t)item * 16384; const float eg = EG[item];
        LAS float* O = (LAS float*)(F.lds + (c & 1) * 33792);
        bf16x8 Sb[4];
#pragma unroll
        for (int ks = 0; ks < 4; ++ks) Sb[ks] = pack2(S[2 * ks], S[2 * ks + 1]);
        f32x4 vn[4];
#pragma unroll
        for (int it = 0; it < 4; ++it) { f32x4 a = z4, o = z4;
#pragma unroll
            for (int ks = 0; ks < 4; ++ks) {
                const unsigned char* wp = wx + ((16 * it + fr) * 128 + 32 * ks + 4 * fq) * 2; const unsigned char* qp = qs.base + (size_t)(16 * it + fr) * qs.stride + (32 * ks + 4 * fq) * 2;
                a = MFMA16(mk8(*(const u32x2*)wp, *(const u32x2*)(wp + 32)), Sb[ks], a);
                o = MFMA16(mk8(*(const u32x2*)qp, *(const u32x2*)(qp + 32)), Sb[ks], o); }
            vn[it] = ld4bf(vsl.base + (size_t)(dv >> 1) * vsl.stride + (dv & 1) * 128 + (16 * it + 4 * fq) * 2) - a;
#pragma unroll
            for (int r = 0; r < 4; ++r) O[(16 * it + 4 * fq + r) * 132 + dv] = o[r]; }
        const bf16x8 Vb0 = pack2(vn[0], vn[1]), Vb1 = pack2(vn[2], vn[3]);
#pragma unroll
        for (int mt = 0; mt < 8; ++mt) { const int dk = 16 * mt + fr; const unsigned char* kp = ksl.base + (size_t)(dk >> 1) * ksl.stride + (dk & 1) * 128 + (4 * fq) * 2;
            f32x4 a = S[mt] * eg;
            a = MFMA16(mk8(*(const u32x2*)kp, *(const u32x2*)(kp + 32)), Vb0, a);
            a = MFMA16(mk8(*(const u32x2*)(kp + 64), *(const u32x2*)(kp + 96)), Vb1, a);
            S[mt] = a; }
        __syncthreads();
        {
            const int i = F.tid >> 3, part = F.tid & 7, row = gdn_row(b, c, i);
            float o[16]; float ss = 0.f;
            if (row >= 0) { const u32x4 l0 = *(const u32x4*)(ON + (size_t)row * DM + 128 * h + 16 * part), l1 = *(const u32x4*)(ON + (size_t)row * DM + 128 * h + 16 * part + 8);
#pragma unroll
                for (int e = 0; e < 4; ++e) { o[2 * e] = bflo(l0[e]); o[2 * e + 1] = bfhi(l0[e]); o[8 + 2 * e] = bflo(l1[e]); o[8 + 2 * e + 1] = bfhi(l1[e]); }
#pragma unroll
                for (int e = 0; e < 16; ++e) { o[e] += O[i * 132 + 16 * part + e]; ss += o[e] * o[e]; } }
            ss += __shfl_xor(ss, 1); ss += __shfl_xor(ss, 2); ss += __shfl_xor(ss, 4);
            if (row >= 0) { const float rn = 1.f / sqrtf(ss * (1.f / 128.f) + EPS);
                const u32x4 g0 = *(const u32x4*)(GATE + (size_t)row * DM + 128 * h + 16 * part), g1 = *(const u32x4*)(GATE + (size_t)row * DM + 128 * h + 16 * part + 8);
                float gt[16];
#pragma unroll
                for (int e = 0; e < 4; ++e) { gt[2 * e] = bflo(g0[e]); gt[2 * e + 1] = bfhi(g0[e]); gt[8 + 2 * e] = bflo(g1[e]); gt[8 + 2 * e + 1] = bfhi(g1[e]); }
                float v[16];
#pragma unroll
                for (int e = 0; e < 16; ++e) v[e] = o[e] * rn * onw[16 * part + e] * siluf_(gt[e]);
                u32x4 s0, s1;
#pragma unroll
                for (int e = 0; e < 4; ++e) { s0[e] = pk2(v[2 * e], v[2 * e + 1]); s1[e] = pk2(v[8 + 2 * e], v[8 + 2 * e + 1]); }
                *(u32x4*)(ON + (size_t)row * DM + 128 * h + 16 * part) = s0; *(u32x4*)(ON + (size_t)row * DM + 128 * h + 16 * part + 8) = s1; }
        }
    }
#pragma unroll
    for (int mt = 0; mt < 8; ++mt)
#pragma unroll
        for (int r = 0; r < 4; ++r) F.out[O_PGDN + ((size_t)bh * 128 + 16 * mt + 4 * fq + r) * 128 + dv] = S[mt][r];
    __syncthreads();
}
__device__ __forceinline__ void p7_sample(Frame& F, int sh) {
    const int s = sh >> 3, h = sh & 7, t = F.tid, row = ROWS_P + s;
    LAS float* qkv = (LAS float*)F.lds;
    LAS float* part = (LAS float*)(F.lds + 2048);
    LAS float* red = (LAS float*)(F.lds + 4096);
    const bf16* QKV = (const bf16*)(F.ws + WS_BIG); const float* AB = (const float*)(F.ws + WS_AB);
    if (t < 384) qkv[t] = bflo((unsigned)QKV[(size_t)row * GCONV + (t >> 7) * 1024 + 128 * h + (t & 127)]);
    __syncthreads();
    if (F.wave < 2) { const float a0 = qkv[F.wave * 128 + F.lane], a1 = qkv[F.wave * 128 + 64 + F.lane]; const float ssum = wave_sum(a0 * a0 + a1 * a1); if (F.lane == 0) red[F.wave] = ssum; }
    __syncthreads();
    const float rq = 0.08838834764831845f / sqrtf(red[0] + 1e-6f), rk = 1.f / sqrtf(red[1] + 1e-6f);
    const float a = AB[(size_t)row * 16 + h], bq = AB[(size_t)row * 16 + 8 + h];
    const float eg = __expf(-__expf(F.in[22][h]) * softplusf_(a + F.in[23][h])), be = sigmoidf_(bq);
    const int j = t & 127, qd = t >> 7;
    const float* S0 = F.in[4] + ((size_t)sh * 128 + 32 * qd) * 128 + j; float* S1 = F.out + O_SGDN + ((size_t)sh * 128 + 32 * qd) * 128 + j;
    float s0[32]; float ks = 0.f;
#pragma unroll
    for (int e = 0; e < 32; ++e) { s0[e] = S0[(size_t)e * 128]; ks += qkv[128 + 32 * qd + e] * s0[e]; }
    part[qd * 128 + j] = ks * rk;
    __syncthreads();
    const float kS = part[j] + part[128 + j] + part[256 + j] + part[384 + j];
    const float vnew = be * (qkv[256 + j] - eg * kS);
    __syncthreads();
    float op = 0.f;
#pragma unroll
    for (int e = 0; e < 32; ++e) { const float v1 = eg * s0[e] + qkv[128 + 32 * qd + e] * rk * vnew; S1[(size_t)e * 128] = v1; op += qkv[32 * qd + e] * v1; }
    part[qd * 128 + j] = op * rq;
    __syncthreads();
    const float o = part[j] + part[128 + j] + part[256 + j] + part[384 + j];
    { const float ssum = wave_sum(o * o); if (F.lane == 0) red[2 + F.wave] = ssum; }
    __syncthreads();
    if (t < 128) { const float rn = 1.f / sqrtf((red[2] + red[3]) * (1.f / 128.f) + EPS);
        const float gt = bflo((unsigned)((const bf16*)(F.ws + WS_B2))[(size_t)row * DM + 128 * h + j]);
        ((bf16*)(F.ws + WS_B1))[(size_t)row * DM + 128 * h + j] = (bf16)f2bf(o * rn * F.in[24][j] * siluf_(gt)); }
    __syncthreads();
}
__device__ __forceinline__ void p7_gdn_rec(Frame& F) {
    if (F.vcu < NB * GH) p7_prompt(F, F.vcu);
    const int nsb = F.G - NB * GH;
    if (nsb > 0) { if (F.vcu >= NB * GH) for (int it = F.vcu - NB * GH; it < NS * GH; it += nsb) p7_sample(F, it); }
    else for (int it = F.vcu; it < NS * GH; it += F.G) p7_sample(F, it);
}

__device__ __forceinline__ void p11_final(Frame& F) {
    const int gw = F.vcu * NWAVES + F.wave, NGW = F.G * NWAVES;
    const float* SS = (const float*)(F.ws + WS_SS); const float* nf = F.in[10]; float* xs = (float*)(F.ws + WS_XS);
    f32x4 nv[4];
#pragma unroll
    for (int j = 0; j < 4; ++j) nv[j] = *(const f32x4*)(nf + 4 * F.lane + 256 * j);
    for (int row = gw; row < ROWS; row += NGW) {
        if (row < ROWS_P) { const int b = row / TP, pos = row - b * TP; if (pos < NMETA) continue; }
        const float sl = (F.lane < 32) ? SS[(size_t)row * 32 + F.lane] : 0.f;
        const float rs = 1.f / sqrtf(wave_sum(sl) * (1.f / DM) + EPS);
        const float* x = xrow_ptr(F.out + O_YP, xs, row);
        float* y = (row < ROWS_P) ? (float*)x : F.out + O_YS + (size_t)(row - ROWS_P) * DM;
#pragma unroll
        for (int j = 0; j < 4; ++j) { const f32x4 v = *(const f32x4*)(x + 4 * F.lane + 256 * j); *(f32x4*)(y + 4 * F.lane + 256 * j) = v * rs * nv[j]; }
    }
}

constexpr int NPHASE = 12;
__global__ void __launch_bounds__(NWAVES * 64, 2) hybrid_fwd(Args args) {
    extern __shared__ __attribute__((aligned(16))) unsigned char lds[];
    Frame F;
    F.lds = (LAS unsigned char*)lds;
    F.tid = threadIdx.x; F.lane = F.tid & 63; F.wave = __builtin_amdgcn_readfirstlane(F.tid >> 6);
    F.G = gridDim.x; { const int bx = blockIdx.x; F.vcu = (F.G % 8 == 0) ? (bx % 8) * (F.G / 8) + bx / 8 : bx; }
    F.in = args.in; F.out = args.out; F.ws = args.ws;
    for (int u = F.tid; u < (LDS_BYTES - LDSCTL_OFF) / 4; u += NWAVES * 64) ((LAS unsigned*)(F.lds + LDSCTL_OFF))[u] = 0u;
    __syncthreads();
#if !MK_PER_PHASE
    const XcdBarrier bar = xcd_barrier_post((unsigned*)(F.ws + WS_CTL) + 4096, (volatile LAS unsigned*)(F.lds + LDSCTL_OFF + 32));
#define GRID_BAR() xcd_barrier(bar)
#else
#define GRID_BAR() do {} while (0)
#endif
    const int lo = args.ph_lo, hi = args.ph_hi;
#define IN(k) (lo <= (k) && (k) < hi)
#define BOTH(k) (IN(k) && IN((k) + 1))
    float* yp = F.out + O_YP; float* xs = (float*)(F.ws + WS_XS); float* SS = (float*)(F.ws + WS_SS);
    bf16* B1 = (bf16*)(F.ws + WS_B1); bf16* B2 = (bf16*)(F.ws + WS_B2); bf16* BIG = (bf16*)(F.ws + WS_BIG);
    LAS unsigned char* ex = F.lds + EXCH_OFF;

    if (IN(0)) { p0_prologue(F); if (BOTH(0)) GRID_BAR(); }
    if (IN(1)) { p1_s5(F); if (BOTH(1)) GRID_BAR(); }
    if (IN(2)) {
        pg8::Gemm g{B2, (const bf16*)(F.ws + WS_WGLU), DM, 0, 0}; pg8::StaticOrder S; S.init(65, 8, F.G, (int)blockIdx.x);
        EpiGlu E{F.in[0], F.in[1], F.in[7], yp, xs, B1, SS};
        pg8::gemm_phase<EpiGlu, pg8::StaticOrder, true, true>(F.lds, g, S, E);
        if (BOTH(2)) GRID_BAR(); }
    if (IN(3)) {
        pg8::Gemm g{B1, (const bf16*)(F.ws + WS_WUP0), DM, 2, 65}; pg8::StaticOrder S; S.init(66, 22, F.G, (int)blockIdx.x);
        EpiUp E{BIG, SS, F.in[27], F.in[6], F.out + O_PFCONV, F.out + O_SFCONV, ex, 65};
        pg8::gemm_phase<EpiUp, pg8::StaticOrder, true, true>(F.lds, g, S, E);
        if (BOTH(3)) GRID_BAR(); }
    if (IN(4)) {
        pg8::Gemm g{BIG, (const bf16*)(F.ws + WS_WDN0), DFF, 0, 0}; pg8::StaticOrder S; S.init(65, 4, F.G, (int)blockIdx.x);
        EpiRes E{yp, xs, B1, SS};
        pg8::gemm_phase<EpiRes, pg8::StaticOrder, true, true>(F.lds, g, S, E);
        if (BOTH(4)) GRID_BAR(); }
    if (IN(5)) {
        pg8::Gemm g{B1, (const bf16*)(F.ws + WS_WIN), DM, 3, 66}; pg8::StaticOrder S; S.init(67, 17, F.G, (int)blockIdx.x);
        EpiIn E{BIG, B2, (float*)(F.ws + WS_AB), SS, F.in[21], F.in[5], F.out + O_PGCONV, F.out + O_SGCONV, ex, 66};
        pg8::gemm_phase<EpiIn, pg8::StaticOrder, true, true>(F.lds, g, S, E);
        if (BOTH(5)) GRID_BAR(); }
    if (IN(6)) { p6_gdn_pre(F); if (BOTH(6)) GRID_BAR(); }
    if (IN(7)) { p7_gdn_rec(F); if (BOTH(7)) GRID_BAR(); }
    if (IN(8)) {
        pg8::Gemm g{B1, (const bf16*)(F.ws + WS_WO), DM, 0, 0}; pg8::StaticOrder S; S.init(65, 4, F.G, (int)blockIdx.x);
        EpiRes E{yp, xs, B2, SS};
        pg8::gemm_phase<EpiRes, pg8::StaticOrder, true, true>(F.lds, g, S, E);
        if (BOTH(8)) GRID_BAR(); }
    if (IN(9)) {
        pg8::Gemm g{B2, (const bf16*)(F.ws + WS_WUP1), DM, 2, 65}; pg8::StaticOrder S; S.init(66, 22, F.G, (int)blockIdx.x);
        EpiUp E{BIG, SS, F.in[27] + 3 * UPN, F.in[6] + (size_t)NS * 2 * UPN, F.out + O_PFCONV + (size_t)NB * 2 * UPN, F.out + O_SFCONV + (size_t)NS * 2 * UPN, ex, 65};
        pg8::gemm_phase<EpiUp, pg8::StaticOrder, true, true>(F.lds, g, S, E);
        if (BOTH(9)) GRID_BAR(); }
    if (IN(10)) {
        pg8::Gemm g{BIG, (const bf16*)(F.ws + WS_WDN1), DFF, 0, 0}; pg8::StaticOrder S; S.init(65, 4, F.G, (int)blockIdx.x);
        EpiRes E{yp, xs, nullptr, SS};
        pg8::gemm_phase<EpiRes, pg8::StaticOrder, true, true>(F.lds, g, S, E);
        if (BOTH(10)) GRID_BAR(); }
    if (IN(11)) p11_final(F);
#undef IN
#undef BOTH
}

extern "C" void kernel_launch(void* const* d_in, const int* in_sizes, int n_in, void* d_out, int out_size, void* d_ws, size_t ws_size, hipStream_t stream) {
    static int grid = 0;
    if (grid == 0) {
        if (n_in != 29 || (size_t)out_size != O_END || ws_size < WS_END) { fprintf(stderr, "kernel_launch: unexpected shapes (n_in %d, out %d, ws %zu); nothing launched\n", n_in, out_size, ws_size); grid = -1; return; }
        int dev = 0, cus = 0, per_cu = 0;
        if (hipGetDevice(&dev) != hipSuccess || hipDeviceGetAttribute(&cus, hipDeviceAttributeMultiprocessorCount, dev) != hipSuccess) { grid = -1; return; }
        if (hipFuncSetAttribute((const void*)hybrid_fwd, hipFuncAttributeMaxDynamicSharedMemorySize, LDS_BYTES) != hipSuccess) { fprintf(stderr, "kernel_launch: hipFuncSetAttribute failed\n"); grid = -1; return; }
        if (hipOccupancyMaxActiveBlocksPerMultiprocessor(&per_cu, (const void*)hybrid_fwd, NWAVES * 64, LDS_BYTES) != hipSuccess || per_cu < 1)
            fprintf(stderr, "kernel_launch: note: occupancy query reports %d workgroups per CU\n", per_cu);
        (void)hipGetLastError();
        grid = cus;
    }
    if (grid < 0) return;
    if (hipMemsetAsync((char*)d_ws + WS_CTL, 0, CTL_ZERO_BYTES, stream) != hipSuccess) { fprintf(stderr, "kernel_launch: memset failed\n"); return; }
    Args a{};
    for (int i = 0; i < 29; ++i) a.in[i] = (const float*)d_in[i];
    a.out = (float*)d_out; a.ws = (unsigned char*)d_ws;
#if MK_PER_PHASE
    for (int p = 0; p < NPHASE; ++p) { a.ph_lo = p; a.ph_hi = p + 1; hipLaunchKernelGGL(hybrid_fwd, dim3(grid), dim3(NWAVES * 64), LDS_BYTES, stream, a); }
#else
    a.ph_lo = 0; a.ph_hi = NPHASE;
    hipLaunchKernelGGL(hybrid_fwd, dim3(grid), dim3(NWAVES * 64), LDS_BYTES, stream, a);
#endif
    const hipError_t le = hipPeekAtLastError();
    if (le != hipSuccess) fprintf(stderr, "kernel_launch: launch failed: %s\n", hipGetErrorName(le));
}
```

```cpp
#include <hip/hip_runtime.h>
#include <cstdio>
#include <cstdint>

#ifndef MK_PER_PHASE
#define MK_PER_PHASE 0
#endif

#define GAS __attribute__((address_space(1)))
#define LAS __attribute__((address_space(3)))
typedef unsigned short bf16;
typedef unsigned short bf16_t;
typedef short bf16x8 __attribute__((ext_vector_type(8)));
typedef float f32x4 __attribute__((ext_vector_type(4)));
typedef float f32x2 __attribute__((ext_vector_type(2)));
typedef unsigned u32x4 __attribute__((ext_vector_type(4)));
typedef unsigned u32x2 __attribute__((ext_vector_type(2)));

constexpr int DM = 1024, NB = 8, SEQ = 2048, NMETA = 16, TP = NMETA + SEQ  , NS = 128;
constexpr int ROWS_P = NB * TP  , ROWS = ROWS_P + NS  , ROWS_PAD = 16896;
constexpr int S5G = 64, S5P = 64, S5L = 16, S5NCH = TP / S5L  , S5NCHP = 144;
constexpr int DFF = 2816, UPN = 2 * DFF;
constexpr int GH = 8, GDK = 128, GCONV = 3072, GIN = 4112, GINP = 4352;
constexpr int GNCH = 33, GNULL = 48;
constexpr float EPS = 1e-6f;

constexpr size_t O_YP = 0, O_YS = 16777216, O_PS5RE = 16908288, O_PS5IM = 16941056, O_PGDN = 16973824, O_PGCONV = 18022400, O_PFCONV = 18096128,
                 O_SS5RE = 18276352, O_SS5IM = 18800640, O_SGDN = 19324928, O_SGCONV = 36102144, O_SFCONV = 37281792, O_END = 40165376;

constexpr size_t MiB = 1u << 20;
constexpr size_t WS_CTL = 0, CTL_ZERO_BYTES = 64 * 1024;
constexpr size_t WS_SS = 1 * MiB;
constexpr size_t WS_AB = 3 * MiB + 512 * 1024;
constexpr size_t WS_XS = 5 * MiB;
constexpr size_t WS_MISC = 6 * MiB;
constexpr size_t WS_HS = 7 * MiB;
constexpr size_t WS_C0 = 8 * MiB;
constexpr size_t WS_OL0 = 11 * MiB;
constexpr size_t WS_W1 = 12 * MiB;
constexpr size_t WS_WIN = WS_W1, WS_WO = WS_WIN + (size_t)GINP * DM * 2, WS_WUP1 = WS_WO + (size_t)DM * DM * 2, WS_WDN1 = WS_WUP1 + (size_t)UPN * DM * 2;
constexpr size_t WS_W0 = 40 * MiB;
constexpr size_t WS_WGLU = WS_W0, WS_WUP0 = WS_WGLU + (size_t)2048 * DM * 2, WS_WDN0 = WS_WUP0 + (size_t)UPN * DM * 2, WS_S5M = WS_WDN0 + (size_t)DM * DFF * 2;
constexpr size_t S5M_WG = 128 * 256 * 2, S5M_TV = 256 * 384 * 2, S5M_G = S5M_WG + S5M_TV;
constexpr size_t WS_WX = WS_W0;
constexpr size_t WS_B1 = 77 * MiB;
constexpr size_t WS_B2 = 110 * MiB;
constexpr size_t WS_BIG = 143 * MiB;
constexpr size_t WS_SLAB = 241 * MiB;
constexpr size_t WS_END = 252 * MiB;
static_assert(WS_WDN1 + (size_t)DM * DFF * 2 <= WS_W0 && WS_S5M + 64 * S5M_G <= WS_B1 && WS_WX + (size_t)NB * GH * GNCH * 16384 <= WS_B1, "ws map");
static_assert(WS_B1 + (size_t)ROWS_PAD * DM * 2 <= WS_B2 && WS_B2 + (size_t)ROWS_PAD * DM * 2 <= WS_BIG && WS_BIG + (size_t)ROWS * GCONV * 2 <= WS_END, "ws map");
static_assert(WS_BIG + (size_t)ROWS_PAD * DFF * 2 <= WS_END && WS_BIG + (size_t)NB * S5G * S5NCHP * 512 <= WS_END, "ws map");

constexpr int LDS_BYTES = 147456;
constexpr int LDSCTL_OFF = LDS_BYTES - 512;
constexpr int EXCH_OFF = 131072;

__device__ __forceinline__ unsigned f2bf(float f) { unsigned u = __builtin_bit_cast(unsigned, f); return (u + 0x7fffu + ((u >> 16) & 1u)) >> 16; }
typedef __bf16 bf16x2_t __attribute__((ext_vector_type(2)));
__device__ __forceinline__ unsigned pk2(float lo, float hi) { const f32x2 v = {lo, hi}; const bf16x2_t b = __builtin_convertvector(v, bf16x2_t); return __builtin_bit_cast(unsigned, b); }
__device__ __forceinline__ float bflo(unsigned u) { return __builtin_bit_cast(float, u << 16); }
__device__ __forceinline__ float bfhi(unsigned u) { return __builtin_bit_cast(float, u & 0xffff0000u); }
__device__ __forceinline__ float sigmoidf_(float x) { return __builtin_amdgcn_rcpf(1.f + __expf(-x)); }
__device__ __forceinline__ float siluf_(float x) { return x * __builtin_amdgcn_rcpf(1.f + __expf(-x)); }
__device__ __forceinline__ float gelu_tanh(float x) { const float z = 1.5957691216057308f * (x + 0.044715f * x * x * x); return x * __builtin_amdgcn_rcpf(1.f + __expf(-z)); }

__device__ __forceinline__ float ldv_f32(const float* p) { return __builtin_bit_cast(float, __hip_atomic_load((const unsigned*)p, __ATOMIC_RELAXED, __HIP_MEMORY_SCOPE_AGENT)); }

__device__ __forceinline__ float* xrow_ptr(float* yp, float* xs, int row) {
    if (row >= ROWS_P) return xs + (size_t)(128 + row - ROWS_P) * DM;
    const int b = row / TP, pos = row - b * TP;
    return pos < NMETA ? xs + (size_t)(b * NMETA + pos) * DM : yp + ((size_t)b * SEQ + (pos - NMETA)) * DM;
}
__device__ __forceinline__ const float* xin_ptr(const float* xp, const float* xsmp, const float* meta, int row) {
    if (row >= ROWS_P) return xsmp + (size_t)(row - ROWS_P) * DM;
    const int b = row / TP, pos = row - b * TP;
    return pos < NMETA ? meta + (size_t)pos * DM : xp + ((size_t)b * SEQ + (pos - NMETA)) * DM;
}

namespace pg8 {
#define PG8_LAS __attribute__((address_space(3)))
constexpr int BM = 256, BK = 64, HALF = 128, HTB = HALF * BK * 2  , STAGE_BYTES = 8 * HTB, NXCD = 8, WGM = 8;
__host__ __device__ __forceinline__ int lds_byte(int r, int c) { const int st = (r >> 4) * 2 + (c >> 5), rr = r & 15, cc = c & 31, ob = rr * 64 + cc * 2; return st * 1024 + (ob ^ (((ob >> 9) & 1) << 5)); }
__host__ __device__ __forceinline__ void stage_rc(int b, int& R, int& C) { const int st = b / 1024, sb = b % 1024, swz = sb ^ (((sb >> 9) & 1) << 5); R = (st >> 1) * 16 + swz / 64; C = (st & 1) * 32 + (swz % 64) / 2; }
__host__ __device__ __forceinline__ int perm32(int rho) { const int n = rho >> 4, i = rho & 15; return 8 * (i >> 2) + 4 * n + (i & 3); }

struct Unit { int pm, pn, kt0, nkt, sub; };
struct Gemm { const bf16_t* A; const bf16_t* Bt; int K, halo, nMp; };
__device__ __forceinline__ int tile_row0(const Gemm& g, int pm) { return g.halo == 0 ? 256 * pm : (pm >= g.nMp ? ROWS_P : (256 - g.halo) * pm); }

struct StaticOrder {
    int nM, nN, nwg, G, c, nkt, nsub, nsplit, skt;
    __host__ __device__ __forceinline__ void init(int nM_, int nN_, int G_, int c_, int nkt_, int nsplit_ = 0, int skt_ = 0) { nM = nM_; nN = nN_; nwg = nM * nN; G = G_; c = c_; nkt = nkt_; nsplit = nsplit_; skt = skt_; nsub = nsplit_ * nN_; }
    __host__ __device__ __forceinline__ bool next(int i, Unit& u) const {
        const long L = (long)i * G + c; if (L >= nwg + nsub) return false;
        const bool is_sub = L >= nwg; const int s = is_sub ? (int)L - nwg : 0, nsp = nsplit > 0 ? nsplit : 1;
        int wgid = is_sub ? 0 : (int)L; { const int q = nwg / NXCD, r = nwg % NXCD, xcd = wgid % NXCD, off = wgid / NXCD; wgid = (xcd < r ? xcd * (q + 1) : r * (q + 1) + (xcd - r) * q) + off; }
        const int nig = WGM * nN, gid = wgid / nig, fm = gid * WGM, gsz = (nM - fm) < WGM ? (nM - fm) : WGM;
        const int pm_m = fm + ((wgid % nig) % gsz), pn_m = (wgid % nig) / gsz;
        u.pm = is_sub ? nM : pm_m; u.pn = is_sub ? s / nsp : pn_m; u.kt0 = is_sub ? skt * (s % nsp) : 0; u.nkt = is_sub ? skt : nkt; u.sub = is_sub ? s : -1;
        return true;
    }
};

template <class Epi, class Sched, bool ALIGN_EPI = false, bool SP2 = false>
__device__ __forceinline__ void gemm_phase(PG8_LAS unsigned char* lds, const Gemm g, const Sched& S, const Epi& E) {
    const int tid = threadIdx.x, wid = __builtin_amdgcn_readfirstlane(tid >> 6), lane = tid & 63, wr = wid >> 2, wc = wid & 3, fr = lane & 15, fq = lane >> 4;
    const int K = g.K;
    unsigned voffA[2], voffB[2];
#pragma unroll
    for (int i = 0; i < 2; ++i) { int R, C; stage_rc(tid * 16 + i * 8192, R, C); const int Rb = Epi::PERM ? ((R & ~31) + perm32(R & 31)) : R;
        voffA[i] = (unsigned)(R * K + C) * 2u; voffB[i] = (unsigned)(Rb * K + C) * 2u; }
    const size_t kstep = (size_t)(BK * 2);
    const size_t hstep = (size_t)HALF * K * 2;
    const size_t tstep = 2 * hstep;
    const size_t rstep = (size_t)K * 2;
    const unsigned ldsw = (unsigned)wid * 1024u;
    const int aoff = lds_byte(wr * 64 + fr, fq * 8), boff = lds_byte(wc * 32 + fr, fq * 8);
#define PG8_SA(b, h) (((b) * 2 + (h)) * HTB)
#define PG8_SB(b, h) ((4 + (b) * 2 + (h)) * HTB)
#define PG8_STAGE(bufoff, gbase, voff) do { _Pragma("unroll") for (int _i = 0; _i < 2; ++_i) \
        __builtin_amdgcn_global_load_lds((const unsigned*)((const char*)(gbase) + (voff)[_i]), (PG8_LAS unsigned*)(lds + (bufoff) + ldsw + _i * 8192), 16, 0, 0); } while (0)
#define PG8_LDA(dst, b, h) do { _Pragma("unroll") for (int m = 0; m < 4; ++m) _Pragma("unroll") for (int k = 0; k < 2; ++k) dst[m][k] = *(const PG8_LAS bf16x8*)(lds + PG8_SA(b, h) + aoff + m * 2048 + k * 1024); } while (0)
#define PG8_LDB(dst, b, h) do { _Pragma("unroll") for (int n = 0; n < 2; ++n) _Pragma("unroll") for (int k = 0; k < 2; ++k) dst[n][k] = *(const PG8_LAS bf16x8*)(lds + PG8_SB(b, h) + boff + n * 2048 + k * 1024); } while (0)
#define PG8_MMA(ai, bj, At, Bt) do { __builtin_amdgcn_s_setprio(1); _Pragma("unroll") for (int m = 0; m < 4; ++m) _Pragma("unroll") for (int n = 0; n < 2; ++n) _Pragma("unroll") for (int k = 0; k < 2; ++k) \
        acc[ai][bj][m][n] = __builtin_amdgcn_mfma_f32_16x16x32_bf16(Bt[n][k], At[m][k], acc[ai][bj][m][n], 0, 0, 0); __builtin_amdgcn_s_setprio(0); } while (0)
#define PG8_WAIT_V(n) asm volatile("s_waitcnt vmcnt(" #n ")" ::: "memory")
#define PG8_WAIT_L(n) asm volatile("s_waitcnt lgkmcnt(" #n ")" ::: "memory")
#define PG8_BAR __builtin_amdgcn_s_barrier()
#define PG8_SCHED __builtin_amdgcn_sched_barrier(0)
    Unit cur, nxt; int ui = 0;
    if (!S.next(0, cur)) return;
    f32x4 acc[2][2][4][2];
#pragma unroll
    for (int a = 0; a < 2; ++a)
#pragma unroll
        for (int b = 0; b < 2; ++b)
#pragma unroll
            for (int m = 0; m < 4; ++m)
#pragma unroll
                for (int n = 0; n < 2; ++n) acc[a][b][m][n] = (f32x4){0.f, 0.f, 0.f, 0.f};
    bf16x8 At[4][2], B0[2][2], B1[2][2];
    const char* cA = (const char*)g.A + (size_t)tile_row0(g, cur.pm) * rstep + (size_t)cur.kt0 * kstep; const char* cB = (const char*)g.Bt + (size_t)cur.pn * tstep + (size_t)cur.kt0 * kstep;
    if constexpr (SP2) {
        PG8_STAGE(PG8_SB(0, 0), cB, voffB); PG8_STAGE(PG8_SB(0, 1), cB + hstep, voffB); PG8_STAGE(PG8_SA(0, 0), cA, voffA); PG8_STAGE(PG8_SA(0, 1), cA + hstep, voffA);
        if (wr == 1) PG8_BAR;
        PG8_WAIT_V(2); PG8_BAR;
        PG8_STAGE(PG8_SB(1, 0), cB + kstep, voffB); PG8_STAGE(PG8_SA(1, 0), cA + kstep, voffA); PG8_STAGE(PG8_SB(1, 1), cB + hstep + kstep, voffB);
        PG8_WAIT_V(6); PG8_BAR;
    } else {
        PG8_STAGE(PG8_SB(0, 0), cB, voffB); PG8_STAGE(PG8_SA(0, 0), cA, voffA); PG8_STAGE(PG8_SB(0, 1), cB + hstep, voffB); PG8_STAGE(PG8_SA(0, 1), cA + hstep, voffA);
        if (wr == 1) PG8_BAR;
        PG8_WAIT_V(4); PG8_BAR;
        PG8_STAGE(PG8_SB(1, 0), cB + kstep, voffB); PG8_STAGE(PG8_SA(1, 0), cA + kstep, voffA); PG8_STAGE(PG8_SB(1, 1), cB + hstep + kstep, voffB);
        PG8_WAIT_V(6); PG8_BAR;
    }
    for (;;) {
        const bool has_next = S.next(ui + 1, nxt);
        const char* nA = has_next ? (const char*)g.A + (size_t)tile_row0(g, nxt.pm) * rstep + (size_t)nxt.kt0 * kstep : cA; const char* nB = has_next ? (const char*)g.Bt + (size_t)nxt.pn * tstep + (size_t)nxt.kt0 * kstep : cB;
        const int nt = cur.nkt;
        for (int t = 0; t < nt; t += 2) {
            const bool last = (t == nt - 2);
            const char* a1 = cA + (size_t)(t + 1) * kstep;
            const char* a2 = last ? nA : cA + (size_t)(t + 2) * kstep; const char* b2 = last ? nB : cB + (size_t)(t + 2) * kstep;
            const char* a3 = a2 + kstep; const char* b3 = b2 + kstep;
            if constexpr (SP2) {
            PG8_LDB(B0, 0, 0); PG8_LDB(B1, 0, 1); PG8_SCHED; PG8_LDA(At, 0, 0); PG8_STAGE(PG8_SA(1, 1), a1 + hstep, voffA);
            PG8_WAIT_V(8); PG8_WAIT_L(0); PG8_BAR; PG8_MMA(0, 0, At, B0); PG8_MMA(0, 1, At, B1); PG8_BAR; PG8_SCHED;
            PG8_LDA(At, 0, 1); PG8_STAGE(PG8_SB(0, 0), b2, voffB); PG8_STAGE(PG8_SB(0, 1), b2 + hstep, voffB); PG8_STAGE(PG8_SA(0, 0), a2, voffA);
            PG8_WAIT_V(8); PG8_WAIT_L(0); PG8_BAR; PG8_MMA(1, 0, At, B0); PG8_MMA(1, 1, At, B1); PG8_BAR; PG8_SCHED;
            PG8_LDB(B0, 1, 0); PG8_LDB(B1, 1, 1); PG8_SCHED; PG8_LDA(At, 1, 0); PG8_STAGE(PG8_SA(0, 1), a2 + hstep, voffA);
            PG8_WAIT_V(8); PG8_WAIT_L(0); PG8_BAR; PG8_MMA(0, 0, At, B0); PG8_MMA(0, 1, At, B1); PG8_BAR; PG8_SCHED;
            PG8_LDA(At, 1, 1); PG8_STAGE(PG8_SB(1, 0), b3, voffB); PG8_STAGE(PG8_SB(1, 1), b3 + hstep, voffB); PG8_STAGE(PG8_SA(1, 0), a3, voffA);
            PG8_WAIT_V(8); PG8_WAIT_L(0); PG8_BAR; PG8_MMA(1, 0, At, B0); PG8_MMA(1, 1, At, B1); PG8_BAR; PG8_SCHED;
            } else {
            PG8_LDB(B0, 0, 0); PG8_SCHED; PG8_LDA(At, 0, 0); PG8_STAGE(PG8_SA(1, 1), a1 + hstep, voffA);
            PG8_WAIT_L(8); PG8_BAR; PG8_WAIT_L(0); PG8_MMA(0, 0, At, B0); PG8_BAR; PG8_SCHED;
            PG8_LDB(B1, 0, 1); PG8_STAGE(PG8_SB(0, 0), b2, voffB);
            PG8_BAR; PG8_WAIT_L(0); PG8_MMA(0, 1, At, B1); PG8_BAR;
            PG8_LDA(At, 0, 1); PG8_STAGE(PG8_SA(0, 0), a2, voffA);
            PG8_BAR; PG8_WAIT_L(0); PG8_MMA(1, 0, At, B0); PG8_BAR; PG8_SCHED;
            PG8_STAGE(PG8_SB(0, 1), b2 + hstep, voffB);
            PG8_WAIT_V(6); PG8_BAR; PG8_MMA(1, 1, At, B1); PG8_BAR;
            PG8_LDB(B0, 1, 0); PG8_SCHED; PG8_LDA(At, 1, 0); PG8_STAGE(PG8_SA(0, 1), a2 + hstep, voffA);
            PG8_WAIT_L(8); PG8_BAR; PG8_WAIT_L(0); PG8_MMA(0, 0, At, B0); PG8_BAR; PG8_SCHED;
            PG8_LDB(B1, 1, 1); PG8_STAGE(PG8_SB(1, 0), b3, voffB);
            PG8_BAR; PG8_WAIT_L(0); PG8_MMA(0, 1, At, B1); PG8_BAR;
            PG8_LDA(At, 1, 1); PG8_STAGE(PG8_SA(1, 0), a3, voffA);
            PG8_BAR; PG8_WAIT_L(0); PG8_MMA(1, 0, At, B0); PG8_BAR; PG8_SCHED;
            PG8_STAGE(PG8_SB(1, 1), b3 + hstep, voffB);
            PG8_WAIT_V(6); PG8_BAR; PG8_MMA(1, 1, At, B1); PG8_BAR;
            }
        }
        if constexpr (ALIGN_EPI) { if (wr == 0) PG8_BAR; }
        E(acc, cur, tile_row0(g, cur.pm), wid, wr, wc, fr, fq);
        if (!has_next) break;
#pragma unroll
        for (int a = 0; a < 2; ++a)
#pragma unroll
            for (int b = 0; b < 2; ++b)
#pragma unroll
                for (int m = 0; m < 4; ++m)
#pragma unroll
                    for (int n = 0; n < 2; ++n) acc[a][b][m][n] = (f32x4){0.f, 0.f, 0.f, 0.f};
        cur = nxt; cA = nA; cB = nB; ++ui;
        if constexpr (ALIGN_EPI) { if (wr == 1) PG8_BAR; }
    }
    PG8_WAIT_V(0);
    if constexpr (!ALIGN_EPI) { if (wr == 0) PG8_BAR; }
    PG8_BAR;
#undef PG8_SA
#undef PG8_SB
#undef PG8_STAGE
#undef PG8_LDA
#undef PG8_LDB
#undef PG8_MMA
#undef PG8_WAIT_V
#undef PG8_WAIT_L
#undef PG8_BAR
#undef PG8_SCHED
}
}

typedef GAS unsigned gu32;
#define RLX_AGENT __ATOMIC_RELAXED, __HIP_MEMORY_SCOPE_AGENT
#define LDS_WAIT() asm volatile("s_waitcnt lgkmcnt(0)" ::: "memory")
#define VM_WAIT() asm volatile("s_waitcnt vmcnt(0)" ::: "memory")

#define XB_TMO      128
#define XB_XCNT(j)  (256  + 64 * (j))
#define XB_XSUB(j)  (1280 + 64 * (j))
#define XB_XGEN(j)  (2304 + 64 * (j))
#define XB_TOP      3328
#define XB_TOPGEN   3392
#define XCD_BAR_WORDS 3456
#define XB_SPIN_CAP (1u << 18)
__device__ __forceinline__ unsigned xb_ld(unsigned* p)              { return __hip_atomic_load(p, __ATOMIC_RELAXED, __HIP_MEMORY_SCOPE_AGENT); }
__device__ __forceinline__ unsigned xb_add(unsigned* p, unsigned v) { return __hip_atomic_fetch_add(p, v, __ATOMIC_RELAXED, __HIP_MEMORY_SCOPE_AGENT); }
__device__ __forceinline__ unsigned xb_xcc_id() { return (unsigned)__builtin_amdgcn_s_getreg((3 << 11) | 20) & 0xFu; }
#define XB_SPIN(cond, bar) do { unsigned _sp = 0; while (cond) { __builtin_amdgcn_s_sleep(1); \
    if ((++_sp & 255u) == 0u) { if (xb_ld(&(bar)[XB_TMO])) break; if (_sp > XB_SPIN_CAP) { atomicAdd(&(bar)[XB_TMO], 1u); break; } } } } while (0)
struct XcdBarrier { unsigned* bar; unsigned x; volatile LAS unsigned* st; };
__device__ __forceinline__ XcdBarrier xcd_barrier_post(unsigned* bar, volatile LAS unsigned* st) {
    XcdBarrier b; b.bar = bar; b.x = xb_xcc_id(); b.st = st;
    if (threadIdx.x == 0) (void)xb_add(&bar[XB_XCNT(b.x)], 1u);
    return b;
}
__device__ __forceinline__ void xcd_barrier_complete(unsigned* bar, unsigned x, unsigned& nloc, unsigned& nx) {
    const unsigned G = gridDim.x * gridDim.y * gridDim.z;
    unsigned sum, cnt, mine, sp = 0u;
    for (;;) {
        sum = 0u; cnt = 0u; mine = 0u;
#pragma unroll
        for (unsigned j = 0; j < 16; ++j) { const unsigned c = xb_ld(&bar[XB_XCNT(j)]); sum += c; cnt += (c > 0u) ? 1u : 0u; mine = (j == x) ? c : mine; }
        if (sum == G) break;
        __builtin_amdgcn_s_sleep(1);
        if ((++sp & 255u) == 0u) { if (xb_ld(&bar[XB_TMO])) break; if (sp > XB_SPIN_CAP) { atomicAdd(&bar[XB_TMO], 1u); break; } }
    }
    nloc = mine > 0u ? mine : 1u; nx = cnt > 0u ? cnt : 1u;
}
__device__ __forceinline__ void xcd_barrier(const XcdBarrier& b) {
    asm volatile("s_waitcnt vmcnt(0)" ::: "memory");
    __syncthreads();
    if (threadIdx.x == 0) {
        unsigned* bar = b.bar;
        __builtin_amdgcn_s_waitcnt(0);
        unsigned nloc = b.st[0], nx = b.st[1];
        if (nloc == 0u) { xcd_barrier_complete(bar, b.x, nloc, nx); b.st[0] = nloc; b.st[1] = nx; }
        const unsigned old = xb_add(&bar[XB_XSUB(b.x)], 1u);
        const unsigned gen = old / nloc;
        if (old + 1u == (gen + 1u) * nloc) {
            __builtin_amdgcn_fence(__ATOMIC_RELEASE, "agent");
            asm volatile("s_waitcnt vmcnt(0)" ::: "memory");
            const unsigned og = xb_add(&bar[XB_TOP], 1u);
            const unsigned tg = og / nx;
            if (og + 1u == (tg + 1u) * nx) xb_add(&bar[XB_TOPGEN], 1u);
            else XB_SPIN(xb_ld(&bar[XB_TOPGEN]) == tg, bar);
            __builtin_amdgcn_fence(__ATOMIC_ACQUIRE, "agent");
            xb_add(&bar[XB_XGEN(b.x)], 1u);
            asm volatile("s_waitcnt vmcnt(0)" ::: "memory");
        } else {
            XB_SPIN(xb_ld(&bar[XB_XGEN(b.x)]) == gen, bar);
            __builtin_amdgcn_fence(__ATOMIC_ACQUIRE, "agent");
            asm volatile("s_waitcnt vmcnt(0)" ::: "memory");
        }
    }
    __syncthreads();
}

constexpr int NWAVES = 8;
struct Args { const float* in[29]; float* out; unsigned char* ws; int ph_lo, ph_hi; };
struct Frame {
    LAS unsigned char* lds;
    int tid, lane, wave, vcu, G;
    const float* const* in;
    float* out; unsigned char* ws;
};
__device__ __forceinline__ float wave_sum(float v) {
#pragma unroll
    for (int o = 1; o < 64; o <<= 1) v += __shfl_xor(v, o);
    return v;
}
__device__ __forceinline__ float row_rs(const float* SS, int row, int fq) {
    const f32x4* p = (const f32x4*)((const char*)SS + (unsigned)(row * 128 + fq * 32));
    const f32x4 a = p[0], b = p[1];
    float s = (a.x + a.y) + (a.z + a.w) + (b.x + b.y) + (b.z + b.w);
    s += __shfl_xor(s, 16); s += __shfl_xor(s, 32);
    return __builtin_amdgcn_rsqf(s * (1.f / DM) + EPS);
}
template <int D> __device__ __forceinline__ float dpp_shift(float cur, float prevblk) {
    const int o = __builtin_amdgcn_update_dpp(0, __builtin_bit_cast(int, prevblk), 0x120 + D, 0xf, 0xf, false);
    const int r = __builtin_amdgcn_update_dpp(o, __builtin_bit_cast(int, cur), 0x110 + D, 0xf, 0xf, false);
    return __builtin_bit_cast(float, r);
}

struct EpiNull {
    static constexpr bool PERM = true;
    __device__ __forceinline__ void operator()(const f32x4 (&acc)[2][2][4][2], const pg8::Unit& u, int row0, int wid, int wr, int wc, int fr, int fq) const {
#pragma unroll
        for (int ai = 0; ai < 2; ++ai)
#pragma unroll
            for (int bj = 0; bj < 2; ++bj)
#pragma unroll
                for (int m = 0; m < 4; ++m)
#pragma unroll
                    for (int n = 0; n < 2; ++n) asm volatile("" :: "v"(acc[ai][bj][m][n]));
    }
};
__device__ __forceinline__ float* yrow_ptr(float* out, int row) {
    if (row >= ROWS_P) return out + O_YS + (size_t)(row - ROWS_P) * DM;
    const int b = row / TP, pos = row - b * TP;
    return pos < NMETA ? nullptr : out + O_YP + ((size_t)b * SEQ + (pos - NMETA)) * DM;
}
struct EpiGlu {
    static constexpr bool PERM = true;
    const float* xp; const float* xsmp; const float* meta; bf16* XB; float* SS; float* slab;
    __device__ __forceinline__ void operator()(const f32x4 (&acc)[2][2][4][2], const pg8::Unit& u, int row0, int wid, int wr, int wc, int fr_, int fq_) const {
        int t_ = (int)threadIdx.x; asm volatile("" : "+v"(t_)); const int fr = t_ & 15, fq = (t_ >> 4) & 3;
        if (u.sub >= 0) {
            float* sl = slab + (size_t)u.sub * 65536;
#pragma unroll
            for (int ai = 0; ai < 2; ++ai)
#pragma unroll
                for (int m = 0; m < 4; ++m)
#pragma unroll
                    for (int bj = 0; bj < 2; ++bj)
#pragma unroll
                        for (int n = 0; n < 2; ++n) *(f32x4*)(sl + (size_t)(128 * ai + 64 * wr + 16 * m + fr) * 256 + 128 * bj + 32 * wc + 8 * fq + 4 * n) = acc[ai][bj][m][n];
            return;
        }
        const int col = 128 * u.pn + 32 * wc + 8 * fq;
#pragma unroll
        for (int ai = 0; ai < 2; ++ai)
#pragma unroll
            for (int m = 0; m < 4; ++m) {
                const int row = row0 + 128 * ai + 64 * wr + 16 * m + fr;
                const float* xi = xin_ptr(xp, xsmp, meta, row) + col;
                float ss = 0.f; f32x4 v[2];
#pragma unroll
                for (int n = 0; n < 2; ++n) { const f32x4 a = acc[ai][0][m][n], b = acc[ai][1][m][n], x = *(const f32x4*)(xi + 4 * n);
#pragma unroll
                    for (int j = 0; j < 4; ++j) { v[n][j] = x[j] + a[j] * sigmoidf_(b[j]); ss += v[n][j] * v[n][j]; } }
                u32x4 w; w.x = pk2(v[0][0], v[0][1]); w.y = pk2(v[0][2], v[0][3]); w.z = pk2(v[1][0], v[1][1]); w.w = pk2(v[1][2], v[1][3]);
                *(u32x4*)(XB + (size_t)row * DM + col) = w;
                ss += __shfl_xor(ss, 16); ss += __shfl_xor(ss, 32);
                if (fq == 0) SS[(size_t)row * 32 + u.pn * 4 + wc] = ss;
            }
    }
};
template <bool FINAL> struct EpiRes {
    static constexpr bool PERM = true;
    bf16* XB; float* out; float* SS; float* slab;
    __device__ __forceinline__ void operator()(const f32x4 (&acc)[2][2][4][2], const pg8::Unit& u, int row0, int wid, int wr, int wc, int fr_, int fq_) const {
        int t_ = (int)threadIdx.x; asm volatile("" : "+v"(t_)); const int fr = t_ & 15, fq = (t_ >> 4) & 3;
        if (u.sub >= 0) {
            float* sl = slab + (size_t)u.sub * 65536;
#pragma unroll
            for (int ai = 0; ai < 2; ++ai)
#pragma unroll
                for (int m = 0; m < 4; ++m)
#pragma unroll
                    for (int bj = 0; bj < 2; ++bj)
#pragma unroll
                        for (int n = 0; n < 2; ++n) *(f32x4*)(sl + (size_t)(128 * ai + 64 * wr + 16 * m + fr) * 256 + 128 * bj + 32 * wc + 8 * fq + 4 * n) = acc[ai][bj][m][n];
            return;
        }
        u32x4 xv[2][4][2];
#pragma unroll
        for (int ai = 0; ai < 2; ++ai)
#pragma unroll
            for (int m = 0; m < 4; ++m)
#pragma unroll
                for (int bj = 0; bj < 2; ++bj) xv[ai][m][bj] = *(const u32x4*)(XB + (size_t)(row0 + 128 * ai + 64 * wr + 16 * m + fr) * DM + 256 * u.pn + 128 * bj + 32 * wc + 8 * fq);
#pragma unroll
        for (int ai = 0; ai < 2; ++ai)
#pragma unroll
            for (int m = 0; m < 4; ++m) {
                const int row = row0 + 128 * ai + 64 * wr + 16 * m + fr;
                float* yr = FINAL ? yrow_ptr(out, row) : nullptr;
#pragma unroll
                for (int bj = 0; bj < 2; ++bj) {
                    const int col = 256 * u.pn + 128 * bj + 32 * wc + 8 * fq;
                    const u32x4 x = xv[ai][m][bj];
                    f32x4 v[2]; v[0] = (f32x4){bflo(x.x), bfhi(x.x), bflo(x.y), bfhi(x.y)} + acc[ai][bj][m][0]; v[1] = (f32x4){bflo(x.z), bfhi(x.z), bflo(x.w), bfhi(x.w)} + acc[ai][bj][m][1];
                    float ss = (v[0].x * v[0].x + v[0].y * v[0].y) + (v[0].z * v[0].z + v[0].w * v[0].w) + (v[1].x * v[1].x + v[1].y * v[1].y) + (v[1].z * v[1].z + v[1].w * v[1].w);
                    if (FINAL) { if (yr) { *(f32x4*)(yr + col) = v[0]; *(f32x4*)(yr + col + 4) = v[1]; } }
                    else { u32x4 w; w.x = pk2(v[0][0], v[0][1]); w.y = pk2(v[0][2], v[0][3]); w.z = pk2(v[1][0], v[1][1]); w.w = pk2(v[1][2], v[1][3]);
                        *(u32x4*)(XB + (size_t)row * DM + col) = w; }
                    ss += __shfl_xor(ss, 16); ss += __shfl_xor(ss, 32);
                    if (fq == 0) SS[(size_t)row * 32 + u.pn * 8 + wc * 2 + bj] = ss;
                }
            }
    }
};
template <bool FINAL> __device__ __forceinline__ void res_fixup(Frame& F, bf16* XB, float* SS, const float* slab, int nsplit) {
    for (int r = F.vcu; r < 256; r += F.G) {
        const int row = 64 * 256 + r;
        const int col = 2 * F.tid, pn = col >> 8, cc = col & 255;
        const unsigned xb = *(const unsigned*)(XB + (size_t)row * DM + col);
        f32x2 v = (f32x2){bflo(xb), bfhi(xb)};
        for (int s = 0; s < nsplit; ++s) v += *(const f32x2*)(slab + ((size_t)(pn * nsplit + s) * 256 + r) * 256 + cc);
        if (FINAL) { float* yr = yrow_ptr(F.out, row); if (yr) *(f32x2*)(yr + col) = v; }
        else *(unsigned*)(XB + (size_t)row * DM + col) = pk2(v.x, v.y);
        float ss = v.x * v.x + v.y * v.y;
        ss += __shfl_xor(ss, 1); ss += __shfl_xor(ss, 2); ss += __shfl_xor(ss, 4); ss += __shfl_xor(ss, 8);
        if ((F.tid & 15) == 0) { const int g32 = col >> 5; SS[(size_t)row * 32 + (g32 >> 3) * 8 + (g32 & 3) * 2 + ((g32 >> 2) & 1)] = ss; }
    }
}
__device__ __forceinline__ void glu_fixup(Frame& F, bf16* XB, float* SS, const float* slab, int nsplit) {
    for (int r = F.vcu; r < 256; r += F.G) {
        const int row = 64 * 256 + r, ch = 2 * F.tid, pn = ch >> 7, cc = ch & 127;
        f32x2 a = (f32x2){0.f, 0.f}, g = a;
        for (int s = 0; s < nsplit; ++s) { const float* sl = slab + ((size_t)(pn * nsplit + s) * 256 + r) * 256; a += *(const f32x2*)(sl + cc); g += *(const f32x2*)(sl + 128 + cc); }
        const f32x2 x = *(const f32x2*)(xin_ptr(F.in[0], F.in[1], F.in[7], row) + ch);
        const f32x2 v = (f32x2){x.x + a.x * sigmoidf_(g.x), x.y + a.y * sigmoidf_(g.y)};
        *(unsigned*)(XB + (size_t)row * DM + ch) = pk2(v.x, v.y);
        float ss = v.x * v.x + v.y * v.y;
        ss += __shfl_xor(ss, 1); ss += __shfl_xor(ss, 2); ss += __shfl_xor(ss, 4); ss += __shfl_xor(ss, 8);
        if ((F.tid & 15) == 0) SS[(size_t)row * 32 + (ch >> 5)] = ss;
    }
}
__device__ __forceinline__ int exch_off(int ai, int wave, int g4, int fr, int fq) { return ((((ai * 8 + wave) * 4 + g4) * 12) + (fr - 13) * 4 + fq) * 16; }
__device__ __forceinline__ void exch_publish(LAS unsigned char* ex, const f32x4 (&acc)[2][2][4][2], const float (&rs)[2][4], int wid, int fr, int fq) {
    if (fr >= 13) {
#pragma unroll
        for (int ai = 0; ai < 2; ++ai)
#pragma unroll
            for (int g4 = 0; g4 < 4; ++g4) *(LAS f32x4*)(ex + exch_off(ai, wid, g4, fr, fq)) = acc[ai][g4 >> 1][3][g4 & 1] * rs[ai][3];
    }
    asm volatile("s_waitcnt lgkmcnt(0)" ::: "memory");
    __builtin_amdgcn_s_barrier();
    asm volatile("" ::: "memory");
}
__device__ __forceinline__ f32x4 exch_prev(LAS unsigned char* ex, int ai, int wid, int wr, int g4, int fr, int fq) {
    f32x4 p = (f32x4){0.f, 0.f, 0.f, 0.f};
    if (fr >= 13) {
        if (wr == 1) p = *(const LAS f32x4*)(ex + exch_off(ai, wid - 4, g4, fr, fq));
        else if (ai == 1) p = *(const LAS f32x4*)(ex + exch_off(0, wid + 4, g4, fr, fq));
    }
    return p;
}
struct EpiUp {
    static constexpr bool PERM = true;
    bf16* ACT; const float* SS; const float* cw; const float* st; float* pf; float* sf; LAS unsigned char* ex; int nMp;
    __device__ __forceinline__ void operator()(const f32x4 (&acc)[2][2][4][2], const pg8::Unit& u, int row0, int wid, int wr, int wc, int fr_, int fq_) const {
        int t_ = (int)threadIdx.x; asm volatile("" : "+v"(t_)); const int fr = t_ & 15, fq = (t_ >> 4) & 3;
        const bool sample = (u.pm >= nMp);
        const int lo = (u.pm == 0 || sample) ? 0 : 2;
        float rs[2][4];
#pragma unroll
        for (int ai = 0; ai < 2; ++ai)
#pragma unroll
            for (int m = 0; m < 4; ++m) rs[ai][m] = row_rs(SS, row0 + 128 * ai + 64 * wr + 16 * m + fr, fq);
        exch_publish(ex, acc, rs, wid, fr, fq);
        if (!sample) {
#pragma unroll
            for (int n = 0; n < 2; ++n) {
                const int ch = 128 * u.pn + 32 * wc + 8 * fq + 4 * n;
                const f32x4 w0a = *(const f32x4*)(cw + ch), w1a = *(const f32x4*)(cw + UPN + ch), w2a = *(const f32x4*)(cw + 2 * UPN + ch);
                const f32x4 w0b = *(const f32x4*)(cw + DFF + ch), w1b = *(const f32x4*)(cw + UPN + DFF + ch), w2b = *(const f32x4*)(cw + 2 * UPN + DFF + ch);
                asm volatile("" :: "v"(w0a), "v"(w1a), "v"(w2a), "v"(w0b), "v"(w1b), "v"(w2b));
#pragma unroll
                for (int ai = 0; ai < 2; ++ai) {
                    f32x4 pa = exch_prev(ex, ai, wid, wr, n, fr, fq), pb = exch_prev(ex, ai, wid, wr, 2 + n, fr, fq);
#pragma unroll
                    for (int m = 0; m < 4; ++m) {
                        const int R = 128 * ai + 64 * wr + 16 * m + fr, row = row0 + R;
                        const float rsv = rs[ai][m]; const f32x4 ca = acc[ai][0][m][n] * rsv, cb = acc[ai][1][m][n] * rsv;
                        const int b = row / TP, pos = row - b * TP;
                        const float m1 = pos >= 1 ? 1.f : 0.f, m2 = pos >= 2 ? 1.f : 0.f;
                        f32x4 o;
#pragma unroll
                        for (int j = 0; j < 4; ++j) {
                            const float s1a = dpp_shift<1>(ca[j], pa[j]) * m1, s2a = dpp_shift<2>(ca[j], pa[j]) * m2;
                            const float s1b = dpp_shift<1>(cb[j], pb[j]) * m1, s2b = dpp_shift<2>(cb[j], pb[j]) * m2;
                            const float ua = w2a[j] * ca[j] + w1a[j] * s1a + w0a[j] * s2a, ub = w2b[j] * cb[j] + w1b[j] * s1b + w0b[j] * s2b;
                            o[j] = siluf_(ua) * ub;
                        }
                        if (R >= lo && row < ROWS_P) {
                            u32x2 w; w.x = pk2(o[0], o[1]); w.y = pk2(o[2], o[3]);
                            *(u32x2*)(ACT + (size_t)row * DFF + ch) = w;
                            if (pos >= TP - 2) { float* d = pf + (size_t)(b * 2 + pos - (TP - 2)) * UPN + ch; *(f32x4*)d = ca; *(f32x4*)(d + DFF) = cb; }
                        }
                        pa = ca; pb = cb;
                    }
                }
            }
        } else {
#pragma unroll
            for (int n = 0; n < 2; ++n) {
                const int ch = 128 * u.pn + 32 * wc + 8 * fq + 4 * n;
                const f32x4 w0a = *(const f32x4*)(cw + ch), w1a = *(const f32x4*)(cw + UPN + ch), w2a = *(const f32x4*)(cw + 2 * UPN + ch);
                const f32x4 w0b = *(const f32x4*)(cw + DFF + ch), w1b = *(const f32x4*)(cw + UPN + DFF + ch), w2b = *(const f32x4*)(cw + 2 * UPN + DFF + ch);
#pragma unroll
                for (int m = 0; m < 4; ++m) {
                    const int s = 64 * wr + 16 * m + fr, row = row0 + s;
                    const float rsv = rs[0][m]; const f32x4 ca = acc[0][0][m][n] * rsv, cb = acc[0][1][m][n] * rsv;
                    const float* s0 = st + (size_t)(s * 2) * UPN + ch; const float* s1 = s0 + UPN;
                    const f32x4 a0 = *(const f32x4*)s0, a1 = *(const f32x4*)s1, b0 = *(const f32x4*)(s0 + DFF), b1 = *(const f32x4*)(s1 + DFF);
                    f32x4 o;
#pragma unroll
                    for (int j = 0; j < 4; ++j) { const float ua = w2a[j] * ca[j] + w1a[j] * a1[j] + w0a[j] * a0[j], ub = w2b[j] * cb[j] + w1b[j] * b1[j] + w0b[j] * b0[j]; o[j] = siluf_(ua) * ub; }
                    u32x2 w; w.x = pk2(o[0], o[1]); w.y = pk2(o[2], o[3]);
                    *(u32x2*)(ACT + (size_t)row * DFF + ch) = w;
                    float* d0 = sf + (size_t)(s * 2) * UPN + ch; float* d1 = d0 + UPN;
                    *(f32x4*)d0 = a1; *(f32x4*)(d0 + DFF) = b1; *(f32x4*)d1 = ca; *(f32x4*)(d1 + DFF) = cb;
                }
            }
        }
    }
};
struct EpiIn {
    static constexpr bool PERM = true;
    bf16* QKV; bf16* GATE; float* AB; const float* SS; const float* cw; const float* st; float* pg; float* sg; LAS unsigned char* ex; int nMp;
    __device__ __forceinline__ void operator()(const f32x4 (&acc)[2][2][4][2], const pg8::Unit& u, int row0, int wid, int wr, int wc, int fr_, int fq_) const {
        int t_ = (int)threadIdx.x; asm volatile("" : "+v"(t_)); const int fr = t_ & 15, fq = (t_ >> 4) & 3;
        const bool sample = (u.pm >= nMp);
        const int lo = (u.pm == 0 || sample) ? 0 : 3;
        float rs[2][4];
#pragma unroll
        for (int ai = 0; ai < 2; ++ai)
#pragma unroll
            for (int m = 0; m < 4; ++m) rs[ai][m] = row_rs(SS, row0 + 128 * ai + 64 * wr + 16 * m + fr, fq);
        exch_publish(ex, acc, rs, wid, fr, fq);
        if (u.pn < 12 && !sample) {
#pragma unroll
            for (int g4 = 0; g4 < 4; ++g4) {
                const int bj = g4 >> 1, n = g4 & 1, col = 256 * u.pn + 128 * bj + 32 * wc + 8 * fq + 4 * n;
                const f32x4 w0 = *(const f32x4*)(cw + col), w1 = *(const f32x4*)(cw + GCONV + col), w2 = *(const f32x4*)(cw + 2 * GCONV + col), w3 = *(const f32x4*)(cw + 3 * GCONV + col);
                asm volatile("" :: "v"(w0), "v"(w1), "v"(w2), "v"(w3));
#pragma unroll
                for (int ai = 0; ai < 2; ++ai) {
                    f32x4 p = exch_prev(ex, ai, wid, wr, g4, fr, fq);
#pragma unroll
                    for (int m = 0; m < 4; ++m) {
                        const int R = 128 * ai + 64 * wr + 16 * m + fr, row = row0 + R;
                        const float rsv = rs[ai][m]; const f32x4 c = acc[ai][bj][m][n] * rsv;
                        const int b = row / TP, pos = row - b * TP;
                        const float m1 = pos >= 1 ? 1.f : 0.f, m2 = pos >= 2 ? 1.f : 0.f, m3 = pos >= 3 ? 1.f : 0.f;
                        f32x4 o;
#pragma unroll
                        for (int j = 0; j < 4; ++j) {
                            const float s1 = dpp_shift<1>(c[j], p[j]) * m1, s2 = dpp_shift<2>(c[j], p[j]) * m2, s3 = dpp_shift<3>(c[j], p[j]) * m3;
                            o[j] = siluf_(w3[j] * c[j] + w2[j] * s1 + w1[j] * s2 + w0[j] * s3);
                        }
                        if (R >= lo && row < ROWS_P) {
                            u32x2 w; w.x = pk2(o[0], o[1]); w.y = pk2(o[2], o[3]);
                            *(u32x2*)(QKV + (size_t)row * GCONV + col) = w;
                            if (pos >= TP - 3) *(f32x4*)(pg + (size_t)(b * 3 + pos - (TP - 3)) * GCONV + col) = c;
                        }
                        p = c;
                    }
                }
            }
        } else if (u.pn < 12) {
#pragma unroll
            for (int g4 = 0; g4 < 4; ++g4) {
                const int bj = g4 >> 1, n = g4 & 1, col = 256 * u.pn + 128 * bj + 32 * wc + 8 * fq + 4 * n;
                const f32x4 w0 = *(const f32x4*)(cw + col), w1 = *(const f32x4*)(cw + GCONV + col), w2 = *(const f32x4*)(cw + 2 * GCONV + col), w3 = *(const f32x4*)(cw + 3 * GCONV + col);
#pragma unroll
                for (int m = 0; m < 4; ++m) {
                    const int s = 64 * wr + 16 * m + fr, row = row0 + s;
                    const float rsv = rs[0][m]; const f32x4 c = acc[0][bj][m][n] * rsv;
                    const float* sp = st + (size_t)(s * 3) * GCONV + col;
                    const f32x4 t0 = *(const f32x4*)sp, t1 = *(const f32x4*)(sp + GCONV), t2 = *(const f32x4*)(sp + 2 * GCONV);
                    f32x4 o;
#pragma unroll
                    for (int j = 0; j < 4; ++j) o[j] = siluf_(w3[j] * c[j] + w2[j] * t2[j] + w1[j] * t1[j] + w0[j] * t0[j]);
                    u32x2 w; w.x = pk2(o[0], o[1]); w.y = pk2(o[2], o[3]);
                    *(u32x2*)(QKV + (size_t)row * GCONV + col) = w;
                    float* d = sg + (size_t)(s * 3) * GCONV + col;
                    *(f32x4*)d = t1; *(f32x4*)(d + GCONV) = t2; *(f32x4*)(d + 2 * GCONV) = c;
                }
            }
        } else {
#pragma unroll
            for (int ai = 0; ai < 2; ++ai)
#pragma unroll
                for (int m = 0; m < 4; ++m) {
                    const int R = 128 * ai + 64 * wr + 16 * m + fr, row = row0 + R;
                    const bool valid = sample ? (ai == 0) : (R >= lo && row < ROWS_P);
                    const float rsv = rs[ai][m];
                    if (!valid) continue;
                    if (u.pn < 16) {
#pragma unroll
                        for (int bj = 0; bj < 2; ++bj) {
                            const f32x4 c0 = acc[ai][bj][m][0] * rsv, c1 = acc[ai][bj][m][1] * rsv;
                            u32x4 w; w.x = pk2(c0[0], c0[1]); w.y = pk2(c0[2], c0[3]); w.z = pk2(c1[0], c1[1]); w.w = pk2(c1[2], c1[3]);
                            *(u32x4*)(GATE + (size_t)row * DM + 256 * (u.pn - 12) + 128 * bj + 32 * wc + 8 * fq) = w;
                        }
                    } else if (wc == 0 && fq < 2) {
                        *(f32x4*)(AB + (size_t)row * 16 + 8 * fq) = acc[ai][0][m][0] * rsv;
                        *(f32x4*)(AB + (size_t)row * 16 + 8 * fq + 4) = acc[ai][0][m][1] * rsv;
                    }
                }
        }
    }
};
#ifdef SEG_ID
#define SEGT(i) do { __builtin_amdgcn_sched_barrier(0); if (F.vcu == SEG_BLOCK && F.tid == 0) { const unsigned long long t_ = __builtin_amdgcn_s_memrealtime(); volatile LAS unsigned long long* a_ = (volatile LAS unsigned long long*)(F.lds + LDSCTL_OFF + 64); \
    if ((i) == SEG_ID) a_[1] = t_; if ((i) == SEG_ID + 1) a_[0] += t_ - a_[1]; } __builtin_amdgcn_sched_barrier(0); } while (0)
#else
#define SEGT(i) do {} while (0)
#endif

__device__ __forceinline__ void tr_item(const float* W, int ldw, int K, bf16* WT, int n0, int src0, int nvalid, int k0, const float* scale, LAS float* scr, int lane) {
    const int j = lane & 31;
    float tv[32];
    const int jc = (j < nvalid) ? j : 0; const float jm = (j < nvalid) ? 1.f : 0.f;
#pragma unroll
    for (int i = 0; i < 32; ++i) { const int kk = 2 * i + (lane >> 5); tv[i] = W[(size_t)(k0 + kk) * ldw + src0 + jc]; }
    if (scale) {
        float sc[32];
#pragma unroll
        for (int i = 0; i < 32; ++i) sc[i] = scale[k0 + 2 * i + (lane >> 5)];
#pragma unroll
        for (int i = 0; i < 32; ++i) tv[i] *= sc[i];
    }
#pragma unroll
    for (int i = 0; i < 32; ++i) { const int kk = 2 * i + (lane >> 5); scr[kk * 33 + j] = tv[i] * jm; }
    LDS_WAIT(); asm volatile("" ::: "memory");
    const int c = lane & 7;
#pragma unroll
    for (int jj = 0; jj < 4; ++jj) { const int n = (lane >> 3) + 8 * jj; const LAS float* s = scr + (8 * c) * 33 + n;
        u32x4 o; o.x = pk2(s[0 * 33], s[1 * 33]); o.y = pk2(s[2 * 33], s[3 * 33]); o.z = pk2(s[4 * 33], s[5 * 33]); o.w = pk2(s[6 * 33], s[7 * 33]);
        *(u32x4*)(WT + (size_t)(n0 + n) * K + k0 + 8 * c) = o; }
    LDS_WAIT(); asm volatile("" ::: "memory");
}
__device__ __forceinline__ int glu_src(int n0, int half_stride) { const int pn = n0 >> 8, bj = (n0 >> 7) & 1, cc0 = n0 & 127; return bj * half_stride + 128 * pn + cc0; }

__device__ __forceinline__ void p0_s5_group(Frame& F, int g, int qtr) {
    const float* lam_re = F.in[11]; const float* lam_im = F.in[12]; const float* log_step = F.in[13];
    const float* b_re = F.in[14]; const float* b_im = F.in[15]; const float* c_re = F.in[16]; const float* c_im = F.in[17]; const float* dsk = F.in[18];
    LAS float* LP = (LAS float*)(F.lds);
    LAS float* BB = (LAS float*)(F.lds + 8704);
    LAS float* CC = (LAS float*)(F.lds + 16896);
    LAS float* KT = (LAS float*)(F.lds + 25088);
    const float dl = __expf(log_step[g]);
    for (int idx = F.tid; idx < 17 * 64; idx += 512) { const int n = idx >> 6, p = idx & 63;
        const float lre = lam_re[g * 64 + p], lim = lam_im[g * 64 + p];
        const float mag = expf((float)n * dl * lre); float sn, cs; sincosf((float)n * dl * lim, &sn, &cs);
        LP[idx * 2] = mag * cs; LP[idx * 2 + 1] = mag * sn; }
    for (int idx = F.tid; idx < 16 * 64; idx += 512) { const int c = idx >> 6, p = idx & 63; CC[idx * 2] = c_re[(g * 16 + c) * 64 + p]; CC[idx * 2 + 1] = c_im[(g * 16 + c) * 64 + p]; }
    __syncthreads();
    for (int idx = F.tid; idx < 64 * 16; idx += 512) { const int p = idx >> 4;
        const float lre = lam_re[g * 64 + p], lim = lam_im[g * 64 + p];
        const float nr = LP[(64 + p) * 2] - 1.f, ni = LP[(64 + p) * 2 + 1], den = 1.f / (lre * lre + lim * lim);
        const float qr = (nr * lre + ni * lim) * den, qi = (ni * lre - nr * lim) * den;
        const float br = b_re[(size_t)g * 1024 + idx], bi = b_im[(size_t)g * 1024 + idx];
        BB[idx * 2] = qr * br - qi * bi; BB[idx * 2 + 1] = qr * bi + qi * br; }
    __syncthreads();
    for (int idx = F.tid; idx < 1024; idx += 512) { const int tau = idx >> 6, c = 4 * qtr + ((idx >> 4) & 3), c2 = idx & 15; float s = 0.f;
        for (int p = 0; p < 64; ++p) { const float cr = CC[(c * 64 + p) * 2], ci = CC[(c * 64 + p) * 2 + 1], lr = LP[(tau * 64 + p) * 2], li = LP[(tau * 64 + p) * 2 + 1];
            const float tr = cr * lr - ci * li, ti = cr * li + ci * lr, br = BB[(p * 16 + c2) * 2], bi = BB[(p * 16 + c2) * 2 + 1];
            s += tr * br - ti * bi; }
        KT[(tau * 16 + c) * 16 + c2] = s; }
    __syncthreads();
    float* misc = (float*)(F.ws + WS_MISC);
    if (qtr == 0) for (int idx = F.tid; idx < 64; idx += 512) { misc[(g * 64 + idx) * 2] = LP[(16 * 64 + idx) * 2]; misc[(g * 64 + idx) * 2 + 1] = LP[(16 * 64 + idx) * 2 + 1];
        misc[8192 + (g * 64 + idx) * 2] = LP[(64 + idx) * 2]; misc[8192 + (g * 64 + idx) * 2 + 1] = LP[(64 + idx) * 2 + 1]; }
    if (qtr == 0) for (int idx = F.tid; idx < 2048; idx += 512) misc[32768 + g * 2048 + idx] = BB[idx];
    unsigned* wg = (unsigned*)(F.ws + WS_S5M + (size_t)g * S5M_G);
    for (int idx = qtr * 4096 + F.tid; idx < (qtr + 1) * 4096; idx += 512) { const int pp = idx >> 7, k = 2 * (idx & 127), s = k >> 4, c2 = k & 15, p = pp >> 1;
        const float lr = LP[((15 - s) * 64 + p) * 2], li = LP[((15 - s) * 64 + p) * 2 + 1];
        float v[2];
#pragma unroll
        for (int e = 0; e < 2; ++e) { const float br = BB[(p * 16 + c2 + e) * 2], bi = BB[(p * 16 + c2 + e) * 2 + 1]; v[e] = (pp & 1) ? (lr * bi + li * br) : (lr * br - li * bi); }
        wg[idx] = pk2(v[0], v[1]); }
    unsigned* tv = (unsigned*)(F.ws + WS_S5M + (size_t)g * S5M_G + S5M_WG);
    for (int idx = F.tid; idx < 12288; idx += 512) { const int nl = idx / 192, k = 2 * (idx - nl * 192), t = nl >> 2, c = 4 * qtr + (nl & 3), n = 16 * t + c;
        float v0, v1;
        if (k < 256) { const int s = k >> 4, c2 = k & 15;
            if (s <= t) { v0 = KT[((t - s) * 16 + c) * 16 + c2]; v1 = KT[((t - s) * 16 + c) * 16 + c2 + 1];
                if (s == t) { const float dd = dsk[g * 16 + c]; if (c2 == c) v0 += dd; if (c2 + 1 == c) v1 += dd; } }
            else { v0 = 0.f; v1 = 0.f; } }
        else { const int p = (k - 256) >> 1; const float cr = CC[(c * 64 + p) * 2], ci = CC[(c * 64 + p) * 2 + 1], lr = LP[((t + 1) * 64 + p) * 2], li = LP[((t + 1) * 64 + p) * 2 + 1];
            v0 = cr * lr - ci * li; v1 = -(cr * li + ci * lr); }
        tv[n * 192 + (k >> 1)] = pk2(v0, v1); }
    __syncthreads();
}

__device__ __forceinline__ void p0_weights(Frame& F, int set, int gw, int NGW) {
    LAS float* scr = (LAS float*)(F.lds + F.wave * 8704);
    const int I_GLU = 16 * 64, I_UP = 16 * 176, I_DN = 44 * 32, I_IN = 16 * 136, I_O = 16 * 32;
    if (set == 0) {
        const int NIT = I_GLU + I_UP + I_DN + I_IN;
        for (int it = gw; it < NIT; it += NGW) {
            int r = it;
            if (r < I_GLU) { const int kb = r / 64, nb = r % 64, n0 = 32 * nb; tr_item(F.in[19], 2048, DM, (bf16*)(F.ws + WS_WGLU), n0, glu_src(n0, 1024), 32, 64 * kb, nullptr, scr, F.lane); continue; } r -= I_GLU;
            if (r < I_UP) { const int kb = r / 176, nb = r % 176, n0 = 32 * nb; tr_item(F.in[26], UPN, DM, (bf16*)(F.ws + WS_WUP0), n0, glu_src(n0, DFF), 32, 64 * kb, F.in[9], scr, F.lane); continue; } r -= I_UP;
            if (r < I_DN) { const int kb = r / 32, nb = r % 32, n0 = 32 * nb; tr_item(F.in[28], DM, DFF, (bf16*)(F.ws + WS_WDN0), n0, n0, 32, 64 * kb, nullptr, scr, F.lane); continue; } r -= I_DN;
            { const int kb = r / 136, nb = r % 136, n0 = 32 * nb; int nv = GIN - n0; nv = nv < 0 ? 0 : (nv > 32 ? 32 : nv);
              tr_item(F.in[20], GIN, DM, (bf16*)(F.ws + WS_WIN), n0, n0, nv, 64 * kb, F.in[8] + DM, scr, F.lane); }
        }
    } else {
        const int NIT = I_O + I_UP + I_DN;
        for (int it = gw; it < NIT; it += NGW) {
            int r = it;
            if (r < I_O) { const int kb = r / 32, nb = r % 32, n0 = 32 * nb; tr_item(F.in[25], DM, DM, (bf16*)(F.ws + WS_WO), n0, n0, 32, 64 * kb, nullptr, scr, F.lane); continue; } r -= I_O;
            if (r < I_UP) { const int kb = r / 176, nb = r % 176, n0 = 32 * nb; tr_item(F.in[26] + (size_t)DM * UPN, UPN, DM, (bf16*)(F.ws + WS_WUP1), n0, glu_src(n0, DFF), 32, 64 * kb, F.in[9] + DM, scr, F.lane); continue; } r -= I_UP;
            { const int kb = r / 32, nb = r % 32, n0 = 32 * nb; tr_item(F.in[28] + (size_t)DFF * DM, DM, DFF, (bf16*)(F.ws + WS_WDN1), n0, n0, 32, 64 * kb, nullptr, scr, F.lane); }
        }
    }
}

__device__ __forceinline__ void p0_prologue(Frame& F) {
    SEGT(0);
    if (F.G == 256) p0_s5_group(F, F.vcu >> 2, F.vcu & 3);
    else for (int u = F.vcu; u < 256; u += F.G) p0_s5_group(F, u >> 2, u & 3);
    SEGT(1);
    const int gw = F.vcu * NWAVES + F.wave, NGW = F.G * NWAVES;
    { const float* nw = F.in[8]; bf16* U = (bf16*)(F.ws + WS_BIG); float* HS = (float*)(F.ws + WS_HS);
      f32x4 nv[4];
#pragma unroll
      for (int j = 0; j < 4; ++j) nv[j] = *(const f32x4*)(nw + 4 * F.lane + 256 * j);
      f32x4 vnx[4];
      if (gw < ROWS) { const float* xr = xin_ptr(F.in[0], F.in[1], F.in[7], gw);
#pragma unroll
        for (int j = 0; j < 4; ++j) vnx[j] = *(const f32x4*)(xr + 4 * F.lane + 256 * j); }
      for (int row = gw; row < ROWS; row += NGW) {
        f32x4 v[4]; float s = 0.f;
#pragma unroll
        for (int j = 0; j < 4; ++j) v[j] = vnx[j];
        if (row + NGW < ROWS) { const float* xr = xin_ptr(F.in[0], F.in[1], F.in[7], row + NGW);
#pragma unroll
            for (int j = 0; j < 4; ++j) vnx[j] = *(const f32x4*)(xr + 4 * F.lane + 256 * j); }
#pragma unroll
        for (int j = 0; j < 4; ++j) s += (v[j].x * v[j].x + v[j].y * v[j].y) + (v[j].z * v[j].z + v[j].w * v[j].w);
        const float r = 1.f / sqrtf(wave_sum(s) * (1.f / DM) + EPS);
        if (row < ROWS_P) {
#pragma unroll
            for (int j = 0; j < 4; ++j) { const f32x4 h = v[j] * r * nv[j];
                u32x2 w; w.x = pk2(h.x, h.y); w.y = pk2(h.z, h.w);
                *(u32x2*)(U + (size_t)row * DM + 4 * F.lane + 256 * j) = w; } }
        else {
#pragma unroll
            for (int j = 0; j < 4; ++j) *(f32x4*)(HS + (size_t)(row - ROWS_P) * DM + 4 * F.lane + 256 * j) = v[j] * r * nv[j]; }
      } }
    SEGT(2);
    p0_weights(F, 0, gw, NGW);
    SEGT(3);
}

#define MFMA16(a, b, c) __builtin_amdgcn_mfma_f32_16x16x32_bf16((a), (b), (c), 0, 0, 0)
constexpr int S5_UST = 528, S5_HL = 68608;
__device__ __forceinline__ void s5_prompt_item(Frame& F, int b, int g) {
    SEGT(10);
    LAS unsigned char* UT = F.lds; LAS unsigned char* HL = F.lds + S5_HL;
    const int fr = F.lane & 15, fq = F.lane >> 4, w = F.wave;
    { const unsigned char* src = F.ws + WS_BIG + ((size_t)(b * TP) * DM + 16 * g) * 2;
      for (int piece = F.tid; piece < TP * 2; piece += 512) { const int r = piece >> 1, hf = piece & 1;
          *(LAS u32x4*)(UT + (r >> 4) * S5_UST + (r & 15) * 32 + hf * 16) = *(const u32x4*)(src + (size_t)r * (DM * 2) + hf * 16); } }
    __syncthreads();
    SEGT(11);
    const unsigned char* wg = F.ws + WS_S5M + (size_t)g * S5M_G; const unsigned char* tv = wg + S5M_WG;
    {
        bf16x8 af[8];
#pragma unroll
        for (int ks = 0; ks < 8; ++ks) af[ks] = *(const bf16x8*)(wg + ((size_t)(16 * w + fr) * 256 + 32 * ks + 8 * fq) * 2);
        for (int jt = 0; jt < 9; ++jt) { const int chunk = 16 * jt + fr, cr = chunk < S5NCH ? chunk : S5NCH - 1;
            f32x4 acc = (f32x4){0.f, 0.f, 0.f, 0.f};
#pragma unroll
            for (int ks = 0; ks < 8; ++ks) acc = MFMA16(af[ks], *(const LAS bf16x8*)(UT + cr * S5_UST + (32 * ks + 8 * fq) * 2), acc);
            if (chunk < S5NCH) *(LAS f32x4*)(HL + chunk * 512 + (16 * w + 4 * fq) * 4) = acc; }
    }
    __syncthreads();
    SEGT(12);
    {
        const int p = F.lane, c0 = 16 * w, nc = (w == 7) ? 17 : 16; const float* misc = (const float*)(F.ws + WS_MISC);
        const float lr = misc[(g * 64 + p) * 2], li = misc[(g * 64 + p) * 2 + 1];
        f32x2 hv[17];
#pragma unroll
        for (int e = 0; e < 17; ++e) { const int c = (e < nc) ? c0 + e : c0; hv[e] = *(const LAS f32x2*)(HL + c * 512 + 8 * p); }
        f32x2 loc[17]; float tr = 0.f, ti = 0.f, pr = 1.f, pi = 0.f;
#pragma unroll
        for (int e = 0; e < 17; ++e) { loc[e] = (f32x2){tr, ti};
            if (e < nc) { const float nr = lr * tr - li * ti + hv[e].x, ni = lr * ti + li * tr + hv[e].y; tr = nr; ti = ni;
                const float qr = lr * pr - li * pi, qi = lr * pi + li * pr; pr = qr; pi = qi; } }
        LAS float* XT = (LAS float*)(HL + S5NCH * 512);
        *(LAS f32x4*)(XT + (w * 64 + p) * 4) = (f32x4){tr, ti, pr, pi};
        __syncthreads();
        float cr = 0.f, ci = 0.f;
        for (int v = 0; v < w; ++v) { const f32x4 x = *(const LAS f32x4*)(XT + (v * 64 + p) * 4);
            const float nr = x.z * cr - x.w * ci + x.x, ni = x.z * ci + x.w * cr + x.y; cr = nr; ci = ni; }
        float wr_ = 1.f, wi_ = 0.f;
#pragma unroll
        for (int e = 0; e < 17; ++e) {
            if (e < nc) { const int c = c0 + e; const float sr = loc[e].x + wr_ * cr - wi_ * ci, si = loc[e].y + wr_ * ci + wi_ * cr;
                *(LAS unsigned*)(HL + c * 512 + (((p >> 2) ^ (c & 15)) * 16) + (p & 3) * 4) = pk2(sr, si);
                const float qr = lr * wr_ - li * wi_, qi = lr * wi_ + li * wr_; wr_ = qr; wi_ = qi; } }
        if (w == 7) { const float fr_ = tr + wr_ * cr - wi_ * ci, fi_ = ti + wr_ * ci + wi_ * cr;
            F.out[O_PS5RE + (size_t)(b * 64 + g) * 64 + p] = fr_; F.out[O_PS5IM + (size_t)(b * 64 + g) * 64 + p] = fi_; }
    }
    __syncthreads();
    SEGT(13);
    {
        bf16x8 af[2][12];
#pragma unroll
        for (int il = 0; il < 2; ++il)
#pragma unroll
            for (int ks = 0; ks < 12; ++ks) af[il][ks] = *(const bf16x8*)(tv + ((size_t)(16 * (2 * w + il) + fr) * 384 + 32 * ks + 8 * fq) * 2);
        bf16* A1 = (bf16*)(F.ws + WS_B2);
#pragma unroll 3
        for (int jt = 0; jt < 9; ++jt) { const int chunk = 16 * jt + fr, cr = chunk < S5NCH ? chunk : S5NCH - 1;
            bf16x8 bfr[12];
#pragma unroll
            for (int ks = 0; ks < 8; ++ks) bfr[ks] = *(const LAS bf16x8*)(UT + cr * S5_UST + (32 * ks + 8 * fq) * 2);
#pragma unroll
            for (int ks = 0; ks < 4; ++ks) bfr[8 + ks] = *(const LAS bf16x8*)(HL + cr * 512 + (((4 * ks + fq) ^ (cr & 15)) * 16));
#pragma unroll
            for (int il = 0; il < 2; ++il) { f32x4 acc = (f32x4){0.f, 0.f, 0.f, 0.f};
#pragma unroll
                for (int ks = 0; ks < 12; ++ks) acc = MFMA16(af[il][ks], bfr[ks], acc);
                if (chunk < S5NCH) { u32x2 o; o.x = pk2(gelu_tanh(acc[0]), gelu_tanh(acc[1])); o.y = pk2(gelu_tanh(acc[2]), gelu_tanh(acc[3]));
                    *(u32x2*)(A1 + (size_t)(b * TP + chunk * 16 + 2 * w + il) * DM + 16 * g + 4 * fq) = o; } } }
    }
    __syncthreads();
    SEGT(14);
}
__device__ __forceinline__ void p1_s5(Frame& F) {
    for (int it = F.vcu; it < NB * S5G; it += F.G) s5_prompt_item(F, it >> 6, it & 63);
    SEGT(15);
    const int gw = F.vcu * NWAVES + F.wave, NGW = F.G * NWAVES, p = F.lane;
    const float* misc = (const float*)(F.ws + WS_MISC); const float* HS = (const float*)(F.ws + WS_HS); bf16* A1 = (bf16*)(F.ws + WS_B2);
    const float* c_re = F.in[16]; const float* c_im = F.in[17]; const float* dsk = F.in[18];
    for (int it = gw; it < NS * S5G; it += NGW) { const int s = it >> 6, g = it & 63;
        float u[16];
#pragma unroll
        for (int j = 0; j < 16; ++j) u[j] = ldv_f32(HS + (size_t)s * DM + 16 * g + j);
        const size_t si = (size_t)(s * 64 + g) * 64 + p;
        const float h0r = F.in[2][si], h0i = F.in[3][si], lr = misc[8192 + (g * 64 + p) * 2], li = misc[8192 + (g * 64 + p) * 2 + 1];
        float hr = lr * h0r - li * h0i, hi = lr * h0i + li * h0r;
        const float* bb = misc + 32768 + (size_t)(g * 64 + p) * 32;
#pragma unroll
        for (int j = 0; j < 8; ++j) { const f32x4 t = *(const f32x4*)(bb + 4 * j); hr += t.x * u[2 * j] + t.z * u[2 * j + 1]; hi += t.y * u[2 * j] + t.w * u[2 * j + 1]; }
        F.out[O_SS5RE + si] = hr; F.out[O_SS5IM + si] = hi;
        LAS float* hb = (LAS float*)(F.lds + F.wave * 512);
        *(LAS f32x2*)(hb + 2 * p) = (f32x2){hr, hi};
        { const int c = p & 15, pq = p >> 4; const float* cr = c_re + (size_t)(g * 16 + c) * 64 + 16 * pq; const float* ci = c_im + (size_t)(g * 16 + c) * 64 + 16 * pq;
          float acc = 0.f;
#pragma unroll
          for (int j = 0; j < 4; ++j) { const f32x4 a = *(const f32x4*)(cr + 4 * j), b = *(const f32x4*)(ci + 4 * j);
              const f32x4 h0 = *(const LAS f32x4*)(hb + 2 * (16 * pq + 4 * j)), h1 = *(const LAS f32x4*)(hb + 2 * (16 * pq + 4 * j) + 4);
              acc += a.x * h0.x - b.x * h0.y + a.y * h0.z - b.y * h0.w + a.z * h1.x - b.z * h1.y + a.w * h1.z - b.w * h1.w; }
          acc += __shfl_xor(acc, 16); acc += __shfl_xor(acc, 32);
          if (p < 16) { const float y = acc + dsk[16 * g + p] * HS[(size_t)s * DM + 16 * g + p];
              A1[(size_t)(ROWS_P + s) * DM + 16 * g + p] = (bf16)f2bf(gelu_tanh(y)); } }
    }
    SEGT(16);
}

struct Slot { unsigned char* base; int stride; };
__device__ __forceinline__ Slot gdn_slot(unsigned char* ws, int bh, int c, int which) {
    Slot s;
    if (c == 0) { s.base = ws + WS_C0 + (size_t)((bh & 7) * 3 + which) * 16384; s.stride = 256; }
    else { const int b = bh >> 3, h = bh & 7; s.base = ws + WS_BIG + ((size_t)(b * TP + NMETA + 64 * (c - 1)) * GCONV + which * 1024 + 128 * h) * 2; s.stride = GCONV * 2; }
    return s;
}
__device__ __forceinline__ int gdn_row(int b, int c, int i) { return c == 0 ? (i >= GNULL ? b * TP + i - GNULL : -1) : b * TP + NMETA + 64 * (c - 1) + i; }
__device__ __forceinline__ float softplusf_(float x) { return x > 20.f ? x : log1pf(__expf(x)); }
__device__ __forceinline__ bf16x8 mk8(u32x2 lo, u32x2 hi) { u32x4 t; t.x = lo.x; t.y = lo.y; t.z = hi.x; t.w = hi.y; return __builtin_bit_cast(bf16x8, t); }
__device__ __forceinline__ float sq8(bf16x8 v) { const u32x4 t = __builtin_bit_cast(u32x4, v); float s = 0.f;
#pragma unroll
    for (int e = 0; e < 4; ++e) { const float a = bflo(t[e]), b = bfhi(t[e]); s += a * a + b * b; } return s; }

__device__ __forceinline__ f32x4 ld4bf(const void* p) { const u32x2 v = *(const u32x2*)p; return (f32x4){bflo(v.x), bfhi(v.x), bflo(v.y), bfhi(v.y)}; }
__device__ __forceinline__ bf16x8 pack2(const f32x4& a, const f32x4& b) { u32x2 lo, hi; lo.x = pk2(a[0], a[1]); lo.y = pk2(a[2], a[3]); hi.x = pk2(b[0], b[1]); hi.y = pk2(b[2], b[3]); return mk8(lo, hi); }
__device__ __forceinline__ float dot4_asm(float a0, float a1, float a2, float a3, const f32x4& v) {
    float t;
    asm("v_mul_f32 %0, %1, %2" : "=v"(t) : "v"(a0), "v"(v.x));
    asm("v_fmac_f32 %0, %1, %2" : "+v"(t) : "v"(a1), "v"(v.y));
    asm("v_fmac_f32 %0, %1, %2" : "+v"(t) : "v"(a2), "v"(v.z));
    asm("v_fmac_f32 %0, %1, %2" : "+v"(t) : "v"(a3), "v"(v.w));
    return t;
}
#ifdef P6_SEG
#define P6S(i) do { if (!C0) { __builtin_amdgcn_sched_barrier(0); const unsigned long long t_ = __builtin_amdgcn_s_memrealtime(); \
    if ((i) == P6_SEG) p6_t0 = t_; if ((i) == P6_SEG + 1) { if (blockIdx.x == 3 && F.wave == 0 && l == 0) *(volatile LAS unsigned long long*)(F.lds + LDSCTL_OFF + 64) += t_ - p6_t0; } __builtin_amdgcn_sched_barrier(0); } } while (0)
#else
#define P6S(i) do {} while (0)
#endif
template <bool C0> __device__ __forceinline__ void p6_item(Frame& F, int bh, int c, LAS unsigned char* wl) {
    constexpr int R0 = C0 ? 3 : 0;
    const int item = bh * GNCH + c;
    unsigned long long p6_t0 = 0;
    int l_ = F.lane; asm volatile("" : "+v"(l_));
    const int b = bh >> 3, h = bh & 7, l = l_, fr = l & 15, fq = l >> 4;
    LAS float* LmT = (LAS float*)wl; LAS float* SC = (LAS float*)(wl + 16384);
    LAS unsigned char* TM = wl; LAS unsigned char* AT = wl + 8192;
    const f32x4 z4 = (f32x4){0.f, 0.f, 0.f, 0.f};
    const bf16x8 zf = (bf16x8){0, 0, 0, 0, 0, 0, 0, 0};
    const int rb0 = C0 ? b * TP - GNULL : b * TP + NMETA + 64 * (c - 1);
    const unsigned char* qkvu = F.ws + WS_BIG + ((size_t)rb0 * GCONV + 128 * h) * 2;
    const Slot qs = gdn_slot(F.ws, bh, c, 0), ksl = gdn_slot(F.ws, bh, c, 1), vsl = gdn_slot(F.ws, bh, c, 2);
    unsigned char* wxu = F.ws + WS_WX + (size_t)item * 16384;
    constexpr int ONS = C0 ? 256 : DM * 2;
    unsigned char* onu = C0 ? F.ws + WS_OL0 + (size_t)h * 16384 : (unsigned char*)(F.out + O_YP) + ((size_t)rb0 * DM + 128 * h) * 2;
    const unsigned vo_f = (unsigned)(fr * (GCONV * 2) + fq * 16);
    const unsigned vo_q = (unsigned)(fr * (GCONV * 2) + fq * 8);
    const unsigned vo_u = (unsigned)((fr >> 1) * ksl.stride + (fr & 1) * 128 + fq * 8);
    const unsigned vo_t = (unsigned)((fr >> 1) * ksl.stride + (fr & 1) * 128 + fq * 16);
    const unsigned vo_p = (unsigned)(fr * qs.stride + fq * 16);
    const unsigned vo_w = (unsigned)(fr * 256 + fq * 16);
    const unsigned vo_o = (unsigned)(fr * ONS + fq * 8);
#define P6_RTV(rt) (!C0 || (rt) == 3)
    if (C0) {
        const u32x4 z = (u32x4){0u, 0u, 0u, 0u};
#pragma unroll 4
        for (int q = 0; q < 16; ++q) { *(u32x4*)(qs.base + (q * 64 + l) * 16) = z; *(u32x4*)(ksl.base + (q * 64 + l) * 16) = z; *(u32x4*)(vsl.base + (q * 64 + l) * 16) = z; *(u32x4*)(wxu + (q * 64 + l) * 16) = z; }
    }
#pragma unroll
    for (int q = 0; q < 16; ++q) *(LAS f32x4*)(wl + (q * 64 + l) * 16) = z4;
    P6S(0);
    float gl;
    { const bool rv = !C0 || (l >= GNULL); float g = 0.f, be = 0.f;
      if (rv) { const float* ab = (const float*)(F.ws + WS_AB) + (size_t)(rb0 + l) * 16; const float a = ab[h], bq = ab[8 + h];
          g = -__expf(F.in[22][h]) * softplusf_(a + F.in[23][h]); be = sigmoidf_(bq); }
      float gc = g;
#pragma unroll
      for (int o = 1; o < 64; o <<= 1) { const float t = __shfl_up(gc, o); if (l >= o) gc += t; }
      gl = __shfl(gc, 63);
      SC[l] = gc; SC[64 + l] = be; }
    {
        bf16x8 kf[4][4];
#pragma unroll
        for (int rt = 0; rt < R0; ++rt) { if (fq == 0) SC[128 + 16 * rt + fr] = 1000.f; }
#pragma unroll
        for (int rt = R0; rt < 4; ++rt) {
#pragma unroll
            for (int ks = 0; ks < 4; ++ks) kf[rt][ks] = *(const bf16x8*)(qkvu + (size_t)(rt * 16 * GCONV * 2 + 2048 + ks * 64) + vo_f);
            float sk = 0.f;
#pragma unroll
            for (int ks = 0; ks < 4; ++ks) sk += sq8(kf[rt][ks]);
            sk += __shfl_xor(sk, 16); sk += __shfl_xor(sk, 32);
            if (fq == 0) SC[128 + 16 * rt + fr] = 1.f / sqrtf(sk + 1e-6f); }
#pragma unroll
        for (int it = R0; it < 4; ++it) {
            const f32x4 gci = *(const LAS f32x4*)(SC + 16 * it + 4 * fq), bei = *(const LAS f32x4*)(SC + 64 + 16 * it + 4 * fq), rki = *(const LAS f32x4*)(SC + 128 + 16 * it + 4 * fq);
#pragma unroll
            for (int jt = R0; jt <= it; ++jt) {
                f32x4 dk = z4;
#pragma unroll
                for (int ks = 0; ks < 4; ++ks) dk = MFMA16(kf[it][ks], kf[jt][ks], dk);
                const int j = 16 * jt + fr; const float gcj = SC[j], rkj = SC[128 + j];
                f32x4 lm;
#pragma unroll
                for (int r = 0; r < 4; ++r) { const int i = 16 * it + 4 * fq + r; lm[r] = (j < i) ? bei[r] * rki[r] * __expf(gci[r] - gcj) * rkj * dk[r] : 0.f; }
                *(LAS f32x4*)(LmT + j * 64 + 16 * it + 4 * fq) = lm;
            } }
    }
    P6S(1);
    __builtin_amdgcn_sched_barrier(0);
    {
        f32x2 r2[32];
#pragma unroll
        for (int j = 0; j < 32; ++j) r2[j] = (f32x2){0.f, 0.f};
#pragma unroll
        for (int j = 16 * R0 - 1; j >= 0; --j) r2[j >> 1][j & 1] = (l == j) ? 1.f : 0.f;
#pragma unroll
        for (int j = 63; j >= 16 * R0; --j) { f32x2 acc = (f32x2){(l == j) ? 1.f : 0.f, 0.f};
#pragma unroll
            for (int kg = ((j + 1) & ~3); kg < 64; kg += 4) { const f32x4 v = *(const LAS f32x4*)(LmT + j * 64 + kg);
                acc -= r2[kg >> 1] * (f32x2){v.x, v.y}; acc -= r2[(kg >> 1) + 1] * (f32x2){v.z, v.w}; }
            r2[j >> 1][j & 1] = acc.x + acc.y; }
        float r[64];
#pragma unroll
        for (int j = 0; j < 64; ++j) r[j] = r2[j >> 1][j & 1];
#pragma unroll
        for (int c8 = 0; c8 < 8; ++c8) { u32x4 o; o.x = pk2(r[8 * c8], r[8 * c8 + 1]); o.y = pk2(r[8 * c8 + 2], r[8 * c8 + 3]); o.z = pk2(r[8 * c8 + 4], r[8 * c8 + 5]); o.w = pk2(r[8 * c8 + 6], r[8 * c8 + 7]);
            *(LAS u32x4*)(TM + l * 128 + c8 * 16) = o; }
    }
    __builtin_amdgcn_sched_barrier(0);
    P6S(2);
    bf16x8 sel[2];
#pragma unroll
    for (int hf = 0; hf < 2; ++hf) {
#pragma unroll
        for (int jj = 0; jj < 8; ++jj) sel[hf][jj] = (8 * fq + jj == 16 * hf + fr) ? (short)0x3F80 : (short)0; }
    bf16x8 tmF[4][2], atF[4][2];
    {
#pragma unroll
        for (int q = 0; q < 8; ++q) *(LAS u32x4*)(AT + (q * 64 + l) * 16) = (u32x4){0u, 0u, 0u, 0u};
        bf16x8 kf[4][4];
#pragma unroll
        for (int rt = R0; rt < 4; ++rt)
#pragma unroll
            for (int ks = 0; ks < 4; ++ks) kf[rt][ks] = *(const bf16x8*)(qkvu + (size_t)(rt * 16 * GCONV * 2 + 2048 + ks * 64) + vo_f);
#pragma unroll
        for (int it = R0; it < 4; ++it) {
            bf16x8 qf[4];
#pragma unroll
            for (int ks = 0; ks < 4; ++ks) qf[ks] = *(const bf16x8*)(qkvu + (size_t)(it * 16 * GCONV * 2 + ks * 64) + vo_f);
            { float sq = 0.f;
#pragma unroll
              for (int ks = 0; ks < 4; ++ks) sq += sq8(qf[ks]);
              sq += __shfl_xor(sq, 16); sq += __shfl_xor(sq, 32);
              if (fq == 0) SC[192 + 16 * it + fr] = 0.08838834764831845f / sqrtf(sq + 1e-6f); }
            const f32x4 gci = *(const LAS f32x4*)(SC + 16 * it + 4 * fq), rqi = *(const LAS f32x4*)(SC + 192 + 16 * it + 4 * fq);
#pragma unroll
            for (int jt = R0; jt <= it; ++jt) {
                f32x4 dq = z4;
#pragma unroll
                for (int ks = 0; ks < 4; ++ks) dq = MFMA16(qf[ks], kf[jt][ks], dq);
                const int j = 16 * jt + fr; const float gcj = SC[j], rkj = SC[128 + j];
                LAS unsigned short* ap = (LAS unsigned short*)(AT + ((16 * it + 4 * fq) * 64 + j) * 2);
#pragma unroll
                for (int r = 0; r < 4; ++r) { const int i = 16 * it + 4 * fq + r; const float aa = (j <= i) ? rqi[r] * __expf(gci[r] - gcj) * rkj * dq[r] : 0.f; ap[64 * r] = (unsigned short)f2bf(aa); }
            } }
        __builtin_amdgcn_sched_barrier(0);
        asm volatile("s_waitcnt vmcnt(0)" ::: "memory");
#pragma unroll
        for (int it = R0; it < 4; ++it)
#pragma unroll
            for (int js = 0; js < 2; ++js) {
                tmF[it][js] = mk8(*(const LAS u32x2*)(TM + (16 * it + fr) * 128 + (32 * js + 4 * fq) * 2), *(const LAS u32x2*)(TM + (16 * it + fr) * 128 + (32 * js + 16 + 4 * fq) * 2));
                atF[it][js] = mk8(*(const LAS u32x2*)(AT + (16 * it + fr) * 128 + (32 * js + 4 * fq) * 2), *(const LAS u32x2*)(AT + (16 * it + fr) * 128 + (32 * js + 16 + 4 * fq) * 2)); }
        P6S(3);
        bf16x8 wA[8][2];
        float qsc[4];
#pragma unroll
        for (int it2 = R0; it2 < 4; ++it2) qsc[it2] = SC[192 + 16 * it2 + fr] * __expf(SC[16 * it2 + fr]);
#pragma unroll
        for (int ks = 0; ks < 4; ++ks)
#pragma unroll
            for (int hf = 0; hf < 2; ++hf) { const int dt = 2 * ks + hf; u32x2 hh[4];
#pragma unroll
                for (int rt = 0; rt < R0; ++rt) hh[rt] = (u32x2){0u, 0u};
#pragma unroll
                for (int rt = R0; rt < 4; ++rt) { const f32x4 d = MFMA16(kf[rt][ks], sel[hf], z4);
                    const f32x4 gci = *(const LAS f32x4*)(SC + 16 * rt + 4 * fq), bei = *(const LAS f32x4*)(SC + 64 + 16 * rt + 4 * fq), rki = *(const LAS f32x4*)(SC + 128 + 16 * rt + 4 * fq);
                    f32x4 sw, sd;
#pragma unroll
                    for (int e = 0; e < 4; ++e) { sw[e] = d[e] * bei[e] * rki[e] * __expf(gci[e]); sd[e] = d[e] * rki[e] * __expf(gl - gci[e]); }
                    hh[rt].x = pk2(sw[0], sw[1]); hh[rt].y = pk2(sw[2], sw[3]);
                    u32x2 kd; kd.x = pk2(sd[0], sd[1]); kd.y = pk2(sd[2], sd[3]);
                    *(u32x2*)(ksl.base + (size_t)(8 * dt * ksl.stride + 64 * (rt >> 1) + 8 * (rt & 1)) + vo_t) = kd; }
                const bf16x8 Rw0 = mk8(hh[0], hh[1]), Rw1 = mk8(hh[2], hh[3]);
                f32x4 wD[4];
#pragma unroll
                for (int it = 0; it < R0; ++it) wD[it] = z4;
#pragma unroll
                for (int it = R0; it < 4; ++it) { f32x4 a = MFMA16(tmF[it][0], Rw0, z4); a = MFMA16(tmF[it][1], Rw1, a); f32x4 t = MFMA16(Rw0, tmF[it][0], z4); t = MFMA16(Rw1, tmF[it][1], t);
                    wD[it] = a;
                    u32x2 o; o.x = pk2(t[0], t[1]); o.y = pk2(t[2], t[3]);
                    *(u32x2*)(wxu + (size_t)(it * 4096 + 64 * (dt >> 1) + 8 * (dt & 1)) + vo_w) = o; }
                wA[dt][0] = pack2(wD[0], wD[1]); wA[dt][1] = pack2(wD[2], wD[3]);
                __builtin_amdgcn_sched_barrier(0);
            }
        u32x2 qv[8][4];
#pragma unroll
        for (int dt = 0; dt < 8; ++dt)
#pragma unroll
            for (int it2 = R0; it2 < 4; ++it2) qv[dt][it2] = *(const u32x2*)(qkvu + (size_t)(it2 * 16 * GCONV * 2 + 32 * dt) + vo_q);
#pragma unroll
        for (int dt = 0; dt < 8; ++dt)
#pragma unroll
            for (int it2 = R0; it2 < 4; ++it2) { f32x4 a = MFMA16(wA[dt][0], atF[it2][0], z4); a = MFMA16(wA[dt][1], atF[it2][1], a);
                const float sc = qsc[it2]; const u32x2 q2 = qv[dt][it2];
                u32x2 o; o.x = pk2(bflo(q2.x) * sc - a[0], bfhi(q2.x) * sc - a[1]); o.y = pk2(bflo(q2.y) * sc - a[2], bfhi(q2.y) * sc - a[3]);
                *(u32x2*)(qs.base + (size_t)(16 * it2 * qs.stride + 64 * (dt >> 1) + 8 * (dt & 1)) + vo_p) = o; }
    }
    __builtin_amdgcn_sched_barrier(0);
    P6S(4);
    {
        bf16x8 vf[4][4];
#pragma unroll
        for (int rt = R0; rt < 4; ++rt)
#pragma unroll
            for (int ks = 0; ks < 4; ++ks) vf[rt][ks] = *(const bf16x8*)(qkvu + (size_t)(rt * 16 * GCONV * 2 + 4096 + ks * 64) + vo_f);
        asm volatile("s_waitcnt vmcnt(0)" ::: "memory");
        __builtin_amdgcn_sched_barrier(0);
#pragma unroll
        for (int ks = 0; ks < 4; ++ks)
#pragma unroll
            for (int hf = 0; hf < 2; ++hf) { const int dt = 2 * ks + hf; u32x2 hh[4];
#pragma unroll
                for (int rt = 0; rt < R0; ++rt) hh[rt] = (u32x2){0u, 0u};
#pragma unroll
                for (int rt = R0; rt < 4; ++rt) { const f32x4 d = MFMA16(vf[rt][ks], sel[hf], z4); const f32x4 sb = *(const LAS f32x4*)(SC + 64 + 16 * rt + 4 * fq);
                    hh[rt].x = pk2(d[0] * sb[0], d[1] * sb[1]); hh[rt].y = pk2(d[2] * sb[2], d[3] * sb[3]); }
                const bf16x8 Ru0 = mk8(hh[0], hh[1]), Ru1 = mk8(hh[2], hh[3]);
                f32x4 uD[4];
#pragma unroll
                for (int it = 0; it < R0; ++it) uD[it] = z4;
#pragma unroll
                for (int it = R0; it < 4; ++it) { f32x4 a = MFMA16(tmF[it][0], Ru0, z4); a = MFMA16(tmF[it][1], Ru1, a); uD[it] = a;
                    u32x2 o; o.x = pk2(a[0], a[1]); o.y = pk2(a[2], a[3]);
                    *(u32x2*)(vsl.base + (size_t)(8 * dt * vsl.stride + 32 * it) + vo_u) = o; }
                const bf16x8 uA0 = pack2(uD[0], uD[1]), uA1 = pack2(uD[2], uD[3]);
#pragma unroll
                for (int it2 = R0; it2 < 4; ++it2) { f32x4 a = MFMA16(uA0, atF[it2][0], z4); a = MFMA16(uA1, atF[it2][1], a);
                    u32x2 o; o.x = pk2(a[0], a[1]); o.y = pk2(a[2], a[3]); *(u32x2*)(onu + (size_t)(it2 * 16 * ONS + 32 * dt) + vo_o) = o; }
                __builtin_amdgcn_sched_barrier(0);
            }
    }
    P6S(5);
#undef P6_RTV
    if (l == 0) ((float*)(F.ws + WS_HS + 768 * 1024))[item] = __expf(gl);
}
__device__ __forceinline__ void p6_gdn_pre(Frame& F) {
    const int gw = F.vcu * NWAVES + F.wave, NGW = F.G * NWAVES;
    LAS unsigned char* wl = F.lds + F.wave * 17408;
    if (F.wave == 0) for (int h = F.vcu; h < GH; h += F.G) p6_item<true>(F, h, 0, wl);
    for (int m = gw; m < NB * GH * (GNCH - 1); m += NGW) p6_item<false>(F, m >> 5, 1 + (m & 31), wl);
}

__device__ __forceinline__ bf16x8 p7_ld16(const LAS unsigned char* tb, int r, int ch) { return *(const LAS bf16x8*)(tb + r * 256 + ((ch ^ (r & 15)) << 4)); }
__device__ __forceinline__ void p7_stage(Frame& F, int bh, int c, LAS unsigned char* stg) {
    const Slot qs = gdn_slot(F.ws, bh, c, 0), ksl = gdn_slot(F.ws, bh, c, 1);
    const unsigned char* wx = F.ws + WS_WX + (size_t)((c == 0 ? (bh & 7) : bh) * GNCH + c) * 16384;
    const int w = F.wave, L = F.lane;
#pragma unroll
    for (int i = 0; i < 6; ++i) {
        const int t = i >> 1, p = (i & 1) * 8 + w, r = 4 * p + (L >> 4), c16 = (L & 15) ^ (r & 15);
        const unsigned char* src = (t == 0) ? wx + (size_t)r * 256 : (t == 1 ? qs.base + (size_t)r * qs.stride : ksl.base + (size_t)r * ksl.stride);
        __builtin_amdgcn_global_load_lds((const unsigned*)(src + c16 * 16), (LAS unsigned*)(stg + (i * 8 + w) * 1024), 16, 0, 0);
    }
}
#ifdef P7_SEG
#define P7S(i) do { if (MODE == 0) { __builtin_amdgcn_sched_barrier(0); const unsigned long long t_ = __builtin_amdgcn_s_memrealtime(); \
    if ((i) == P7_SEG) pr7_t0 = t_; if ((i) == P7_SEG + 1) pr7_acc += t_ - pr7_t0; __builtin_amdgcn_sched_barrier(0); } } while (0)
#else
#define P7S(i) do {} while (0)
#endif
template <int MODE> __device__ __forceinline__ void p7_prompt_t(Frame& F, int bh) {
    const int b = bh >> 3, h = bh & 7, l = F.lane, fr = l & 15, fq = l >> 4, w = F.wave;
    unsigned long long pr7_t0 = 0, pr7_acc = 0;
    const f32x4 z4 = (f32x4){0.f, 0.f, 0.f, 0.f};
    f32x4 S[8];
#pragma unroll
    for (int mt = 0; mt < 8; ++mt) S[mt] = z4;
    bf16* ON = (bf16*)(F.out + O_YP); const bf16* GATE = (const bf16*)(F.ws + WS_B2); const float* EG = (const float*)(F.ws + WS_HS + 768 * 1024); const float* onw = F.in[24];
    const int dv = 16 * w + fr;
    LAS unsigned short* Obase = (LAS unsigned short*)(F.lds + 98304);
    const int ni = F.tid >> 3, part = F.tid & 7;
    float onv[16];
#pragma unroll
    for (int e = 0; e < 16; ++e) onv[e] = onw[16 * part + e];
    u32x2 uT[4]; u32x4 ol0, ol1, gt0, gt1; float eg; int nrow;
#define P7_FETCH(cc, UT, OL0, OL1, GT0, GT1, EGV, NROW) do { \
        if (MODE != 2) p7_stage(F, bh, (cc), F.lds + ((cc) & 1) * 49152); \
        const Slot vsl_ = gdn_slot(F.ws, bh, (cc), 2); \
        _Pragma("unroll") for (int it = 0; it < 4; ++it) UT[it] = *(const u32x2*)(vsl_.base + (size_t)(dv >> 1) * vsl_.stride + (dv & 1) * 128 + (16 * it + 4 * fq) * 2); \
        NROW = gdn_row(b, (cc), ni); const size_t o_ = (size_t)(NROW >= 0 ? NROW : 0) * DM + 128 * h + 16 * part; \
        const bf16* olp_ = ((cc) == 0) ? (const bf16*)(F.ws + WS_OL0) + (size_t)(h * 64 + ni) * 128 + 16 * part : ON + o_; \
        OL0 = *(const u32x4*)(olp_); OL1 = *(const u32x4*)(olp_ + 8); GT0 = *(const u32x4*)(GATE + o_); GT1 = *(const u32x4*)(GATE + o_ + 8); \
        EGV = ldv_f32(EG + ((cc) == 0 ? h : bh) * GNCH + (cc)); } while (0)
    P7_FETCH(0, uT, ol0, ol1, gt0, gt1, eg, nrow);
    asm volatile("s_waitcnt vmcnt(0)" ::: "memory");
    __syncthreads();
    for (int c = 0; c < GNCH; ++c) {
        P7S(0);
        LAS unsigned short* O = Obase + (c & 1) * (64 * 136);
        const LAS unsigned char* T0 = F.lds + (c & 1) * 49152; const LAS unsigned char* T1 = T0 + 16384; const LAS unsigned char* T2 = T0 + 32768;
        u32x2 uTn[4]; u32x4 ol0n, ol1n, gt0n, gt1n; float egn; int nrown;
        { const int cn = (c + 1 < GNCH) ? c + 1 : c;
          if (c + 1 < GNCH) { P7_FETCH(cn, uTn, ol0n, ol1n, gt0n, gt1n, egn, nrown); }
          else {
#pragma unroll
              for (int it = 0; it < 4; ++it) uTn[it] = uT[it];
              ol0n = ol0; ol1n = ol1; gt0n = gt0; gt1n = gt1; egn = eg; nrown = nrow; } }
        P7S(1);
        if (MODE != 3) {
        bf16x8 Sb[4];
#pragma unroll
        for (int ks = 0; ks < 4; ++ks) Sb[ks] = pack2(S[2 * ks], S[2 * ks + 1]);
        f32x4 vn[4];
#pragma unroll
        for (int it = 0; it < 4; ++it) { f32x4 a = z4, o = z4; const int r = 16 * it + fr;
#pragma unroll
            for (int ks = 0; ks < 4; ++ks) { a = MFMA16(p7_ld16(T0, r, 4 * ks + fq), Sb[ks], a); o = MFMA16(p7_ld16(T1, r, 4 * ks + fq), Sb[ks], o); }
            vn[it] = (f32x4){bflo(uT[it].x), bfhi(uT[it].x), bflo(uT[it].y), bfhi(uT[it].y)} - a;
#pragma unroll
            for (int rr = 0; rr < 4; ++rr) O[(16 * it + 4 * fq + rr) * 136 + dv] = (unsigned short)(pk2(o[rr], 0.f) & 0xffffu); }
        const bf16x8 Vb0 = pack2(vn[0], vn[1]), Vb1 = pack2(vn[2], vn[3]);
#pragma unroll
        for (int mt = 0; mt < 8; ++mt) { const int r = 8 * mt + (fr >> 1), ch = 8 * (fr & 1) + fq;
            f32x4 a = S[mt] * eg;
            a = MFMA16(p7_ld16(T2, r, ch), Vb0, a);
            a = MFMA16(p7_ld16(T2, r, ch + 4), Vb1, a);
            S[mt] = a; }
        }
        P7S(2);
        asm volatile("s_waitcnt vmcnt(0) lgkmcnt(0)" ::: "memory");
        __syncthreads();
        P7S(3);
        {
            float o[16]; float ss = 0.f;
#pragma unroll
            for (int e = 0; e < 4; ++e) { o[2 * e] = bflo(ol0[e]); o[2 * e + 1] = bfhi(ol0[e]); o[8 + 2 * e] = bflo(ol1[e]); o[8 + 2 * e + 1] = bfhi(ol1[e]); }
            { const u32x4 q0 = *(const LAS u32x4*)(O + ni * 136 + 16 * part), q1 = *(const LAS u32x4*)(O + ni * 136 + 16 * part + 8);
#pragma unroll
              for (int e = 0; e < 4; ++e) { o[2 * e] += bflo(q0[e]); o[2 * e + 1] += bfhi(q0[e]); o[8 + 2 * e] += bflo(q1[e]); o[8 + 2 * e + 1] += bfhi(q1[e]); } }
#pragma unroll
            for (int e = 0; e < 16; ++e) ss += o[e] * o[e];
            ss += __shfl_xor(ss, 1); ss += __shfl_xor(ss, 2); ss += __shfl_xor(ss, 4);
            if (nrow >= 0) { const float rn = 1.f / sqrtf(ss * (1.f / 128.f) + EPS);
                float gt[16];
#pragma unroll
                for (int e = 0; e < 4; ++e) { gt[2 * e] = bflo(gt0[e]); gt[2 * e + 1] = bfhi(gt0[e]); gt[8 + 2 * e] = bflo(gt1[e]); gt[8 + 2 * e + 1] = bfhi(gt1[e]); }
                float v[16];
#pragma unroll
                for (int e = 0; e < 16; ++e) v[e] = o[e] * rn * onv[e] * siluf_(gt[e]);
                u32x4 s0, s1;
#pragma unroll
                for (int e = 0; e < 4; ++e) { s0[e] = pk2(v[2 * e], v[2 * e + 1]); s1[e] = pk2(v[8 + 2 * e], v[8 + 2 * e + 1]); }
                const size_t oo = (size_t)nrow * DM + 128 * h + 16 * part;
                if (MODE == 0) { *(u32x4*)(ON + oo) = s0; *(u32x4*)(ON + oo + 8) = s1; } else { asm volatile("" :: "v"(s0), "v"(s1)); } }
        }
        P7S(4);
#pragma unroll
        for (int it = 0; it < 4; ++it) uT[it] = uTn[it];
        ol0 = ol0n; ol1 = ol1n; gt0 = gt0n; gt1 = gt1n; eg = egn; nrow = nrown;
        P7S(5);
        P7S(6);
    }
#undef P7_FETCH
#pragma unroll
    for (int mt = 0; mt < 8; ++mt)
#pragma unroll
        for (int r = 0; r < 4; ++r) { if (MODE == 0) F.out[O_PGDN + ((size_t)bh * 128 + 16 * mt + 4 * fq + r) * 128 + dv] = S[mt][r]; else asm volatile("" :: "v"(S[mt][r])); }
    __syncthreads();
#ifdef P7_SEG
    if (MODE == 0 && blockIdx.x == 0 && F.tid == 0) *(volatile LAS unsigned long long*)(F.lds + LDSCTL_OFF + 64) = pr7_acc;
#endif
}
__device__ __forceinline__ void p7_prompt(Frame& F, int bh) {
#ifdef P7_DRY
    p7_prompt_t<P7_DRY>(F, bh);
#endif
    p7_prompt_t<0>(F, bh);
}
__device__ __forceinline__ void p7_sample(Frame& F, int sh) {
    const int s = sh >> 3, h = sh & 7, t = F.tid, row = ROWS_P + s;
    LAS float* qkv = (LAS float*)F.lds;
    LAS float* part = (LAS float*)(F.lds + 2048);
    LAS float* red = (LAS float*)(F.lds + 4096);
    const bf16* QKV = (const bf16*)(F.ws + WS_BIG); const float* AB = (const float*)(F.ws + WS_AB);
    if (t < 384) qkv[t] = bflo((unsigned)QKV[(size_t)row * GCONV + (t >> 7) * 1024 + 128 * h + (t & 127)]);
    __syncthreads();
    if (F.wave < 2) { const float a0 = qkv[F.wave * 128 + F.lane], a1 = qkv[F.wave * 128 + 64 + F.lane]; const float ssum = wave_sum(a0 * a0 + a1 * a1); if (F.lane == 0) red[F.wave] = ssum; }
    __syncthreads();
    const float rq = 0.08838834764831845f / sqrtf(red[0] + 1e-6f), rk = 1.f / sqrtf(red[1] + 1e-6f);
    const float a = ldv_f32(AB + (size_t)row * 16 + h), bq = ldv_f32(AB + (size_t)row * 16 + 8 + h);
    const float eg = __expf(-__expf(F.in[22][h]) * softplusf_(a + F.in[23][h])), be = sigmoidf_(bq);
    const int j = t & 127, qd = t >> 7;
    const float* S0 = F.in[4] + ((size_t)sh * 128 + 32 * qd) * 128 + j; float* S1 = F.out + O_SGDN + ((size_t)sh * 128 + 32 * qd) * 128 + j;
    float s0[32]; float ks = 0.f;
#pragma unroll
    for (int e = 0; e < 32; ++e) { s0[e] = S0[(size_t)e * 128]; ks += qkv[128 + 32 * qd + e] * s0[e]; }
    part[qd * 128 + j] = ks * rk;
    __syncthreads();
    const float kS = part[j] + part[128 + j] + part[256 + j] + part[384 + j];
    const float vnew = be * (qkv[256 + j] - eg * kS);
    __syncthreads();
    float op = 0.f;
#pragma unroll
    for (int e = 0; e < 32; ++e) { const float v1 = eg * s0[e] + qkv[128 + 32 * qd + e] * rk * vnew; S1[(size_t)e * 128] = v1; op += qkv[32 * qd + e] * v1; }
    part[qd * 128 + j] = op * rq;
    __syncthreads();
    const float o = part[j] + part[128 + j] + part[256 + j] + part[384 + j];
    { const float ssum = wave_sum(o * o); if (F.lane == 0) red[2 + F.wave] = ssum; }
    __syncthreads();
    if (t < 128) { const float rn = 1.f / sqrtf((red[2] + red[3]) * (1.f / 128.f) + EPS);
        const float gt = bflo((unsigned)((const bf16*)(F.ws + WS_B2))[(size_t)row * DM + 128 * h + j]);
        ((bf16*)(F.out + O_YP))[(size_t)row * DM + 128 * h + j] = (bf16)f2bf(o * rn * F.in[24][j] * siluf_(gt)); }
    __syncthreads();
}
__device__ __forceinline__ void p7_gdn_rec(Frame& F) {
    const int bx = (int)blockIdx.x;
    if (bx < NB * GH) p7_prompt(F, bx);
    const int nsb = F.G - NB * GH;
    if (nsb > 0) { if (bx >= NB * GH) { for (int it = bx - NB * GH; it < NS * GH; it += nsb) p7_sample(F, it);
            p0_weights(F, 1, (bx - NB * GH) * NWAVES + F.wave, nsb * NWAVES);
#ifdef DUP_W1
            p0_weights(F, 1, (bx - NB * GH) * NWAVES + F.wave, nsb * NWAVES);
#endif
            } }
    else { for (int it = bx; it < NS * GH; it += F.G) p7_sample(F, it); p0_weights(F, 1, bx * NWAVES + F.wave, F.G * NWAVES); }
}

__device__ __forceinline__ void p11_final(Frame& F, const bf16* XB, const float* slab, int nsplit) {
    int t_ = (int)threadIdx.x; asm volatile("" : "+v"(t_)); const int lane = t_ & 63;
    const int gw = F.vcu * NWAVES + F.wave, NGW = F.G * NWAVES;
    const float* SS = (const float*)(F.ws + WS_SS); const float* nf = F.in[10];
    f32x4 nv[4];
#pragma unroll
    for (int j = 0; j < 4; ++j) nv[j] = *(const f32x4*)(nf + 4 * lane + 256 * j);
    for (int row = gw; row < ROWS; row += NGW) {
        float* y = yrow_ptr(F.out, row); if (!y) continue;
        f32x4 v[4]; float ss = 0.f;
#pragma unroll
        for (int j = 0; j < 4; ++j) { const u32x2 xb = *(const u32x2*)(XB + (size_t)row * DM + 4 * lane + 256 * j); v[j] = (f32x4){bflo(xb.x), bfhi(xb.x), bflo(xb.y), bfhi(xb.y)}; }
        float rs;
        if (row < 64 * 256) {
            const float sl = (lane < 32) ? SS[(size_t)row * 32 + lane] : 0.f;
            rs = 1.f / sqrtf(wave_sum(sl) * (1.f / DM) + EPS);
        } else {
            const int r = row - 64 * 256;
#pragma unroll
            for (int j = 0; j < 4; ++j) {
                for (int s = 0; s < nsplit; ++s) v[j] += *(const f32x4*)(slab + ((size_t)(j * nsplit + s) * 256 + r) * 256 + 4 * lane);
                ss += (v[j].x * v[j].x + v[j].y * v[j].y) + (v[j].z * v[j].z + v[j].w * v[j].w); }
            rs = 1.f / sqrtf(wave_sum(ss) * (1.f / DM) + EPS);
        }
#pragma unroll
        for (int j = 0; j < 4; ++j) *(f32x4*)(y + 4 * lane + 256 * j) = v[j] * rs * nv[j];
    }
}

constexpr int NPHASE = 12;
__global__ void __launch_bounds__(NWAVES * 64, 2) hybrid_fwd(Args args) {
    extern __shared__ __attribute__((aligned(16))) unsigned char lds[];
    Frame F;
    F.lds = (LAS unsigned char*)lds;
    F.tid = threadIdx.x; F.lane = F.tid & 63; F.wave = __builtin_amdgcn_readfirstlane(F.tid >> 6);
    F.G = gridDim.x; { const int bx = blockIdx.x; F.vcu = (F.G % 8 == 0) ? (bx % 8) * (F.G / 8) + bx / 8 : bx; }
    F.in = args.in; F.out = args.out; F.ws = args.ws;
    for (int u = F.tid; u < (LDS_BYTES - LDSCTL_OFF) / 4; u += NWAVES * 64) ((LAS unsigned*)(F.lds + LDSCTL_OFF))[u] = 0u;
    __syncthreads();
#if !MK_PER_PHASE
    const XcdBarrier bar = xcd_barrier_post((unsigned*)(F.ws + WS_CTL) + 4096, (volatile LAS unsigned*)(F.lds + LDSCTL_OFF + 32));
#define GRID_BAR() xcd_barrier(bar)
#else
#define GRID_BAR() do {} while (0)
#endif
    const int lo = args.ph_lo, hi = args.ph_hi;
#ifdef PROBE_PHASE
    unsigned long long pr_t0 = 0, pr_t1 = 0;
#define PROBE_BEGIN(k) do { if ((k) == PROBE_PHASE) pr_t0 = __builtin_amdgcn_s_memrealtime(); } while (0)
#ifdef PROBE_PRE
#define PROBE_PRE_END(k) do { if ((k) == PROBE_PHASE) pr_t1 = __builtin_amdgcn_s_memrealtime(); } while (0)
#define PROBE_END(k) do {} while (0)
#else
#define PROBE_PRE_END(k) do {} while (0)
#define PROBE_END(k) do { if ((k) == PROBE_PHASE) pr_t1 = __builtin_amdgcn_s_memrealtime(); } while (0)
#endif
#ifndef PROBE_BLOCK
#define PROBE_BLOCK 0
#endif
#else
#define PROBE_PRE_END(k) do {} while (0)
#define PROBE_BEGIN(k) do {} while (0)
#define PROBE_END(k) do {} while (0)
#endif
#define IN(k) (lo <= (k) && (k) < hi)
#define BOTH(k) (IN(k) && IN((k) + 1))
    float* SS = (float*)(F.ws + WS_SS); bf16* ONB = (bf16*)(F.out + O_YP);
    bf16* B1 = (bf16*)(F.ws + WS_B1); bf16* B2 = (bf16*)(F.ws + WS_B2); bf16* BIG = (bf16*)(F.ws + WS_BIG);
    LAS unsigned char* ex = F.lds + EXCH_OFF; float* slab = (float*)(F.ws + WS_SLAB);

    PROBE_BEGIN(0); if (IN(0)) { p0_prologue(F); PROBE_PRE_END(0); if (BOTH(0)) GRID_BAR(); } PROBE_END(0);
    PROBE_BEGIN(1); if (IN(1)) { p1_s5(F); PROBE_PRE_END(1); if (BOTH(1)) GRID_BAR(); } PROBE_END(1);
    PROBE_BEGIN(2); if (IN(2)) {
        pg8::Gemm g{B2, (const bf16*)(F.ws + WS_WGLU), DM, 0, 0}; pg8::StaticOrder S; S.init(64, 8, F.G, (int)blockIdx.x, DM / 64, 4, 4);
        EpiGlu E{F.in[0], F.in[1], F.in[7], B1, SS, slab};
        pg8::gemm_phase<EpiGlu, pg8::StaticOrder, true, true>(F.lds, g, S, E);
        GRID_BAR(); glu_fixup(F, B1, SS, slab, 4);
        PROBE_PRE_END(2); if (BOTH(2)) GRID_BAR(); } PROBE_END(2);
    PROBE_BEGIN(3); if (IN(3)) {
#ifdef DRY_P3
        { pg8::Gemm g{B1, (const bf16*)(F.ws + WS_WUP0), DM, 2, 65}; pg8::StaticOrder S; S.init(66, 22, F.G, (int)blockIdx.x, DM / 64);
          EpiNull E{}; pg8::gemm_phase<EpiNull, pg8::StaticOrder, true, true>(F.lds, g, S, E); GRID_BAR(); }
#endif
        pg8::Gemm g{B1, (const bf16*)(F.ws + WS_WUP0), DM, 2, 65}; pg8::StaticOrder S; S.init(66, 22, F.G, (int)blockIdx.x, DM / 64);
        EpiUp E{BIG, SS, F.in[27], F.in[6], F.out + O_PFCONV, F.out + O_SFCONV, ex, 65};
        pg8::gemm_phase<EpiUp, pg8::StaticOrder, true, true>(F.lds, g, S, E);
        PROBE_PRE_END(3); if (BOTH(3)) GRID_BAR(); } PROBE_END(3);
    PROBE_BEGIN(4); if (IN(4)) {
        pg8::Gemm g{BIG, (const bf16*)(F.ws + WS_WDN0), DFF, 0, 0}; pg8::StaticOrder S; S.init(64, 4, F.G, (int)blockIdx.x, DFF / 64, 11, 4);
        EpiRes<false> E{B1, F.out, SS, slab};
        pg8::gemm_phase<EpiRes<false>, pg8::StaticOrder, true, true>(F.lds, g, S, E);
        GRID_BAR(); res_fixup<false>(F, B1, SS, slab, 11);
        PROBE_PRE_END(4); if (BOTH(4)) GRID_BAR(); } PROBE_END(4);
    PROBE_BEGIN(5); if (IN(5)) {
        pg8::Gemm g{B1, (const bf16*)(F.ws + WS_WIN), DM, 3, 66}; pg8::StaticOrder S; S.init(67, 17, F.G, (int)blockIdx.x, DM / 64);
        EpiIn E{BIG, B2, (float*)(F.ws + WS_AB), SS, F.in[21], F.in[5], F.out + O_PGCONV, F.out + O_SGCONV, ex, 66};
        pg8::gemm_phase<EpiIn, pg8::StaticOrder, true, true>(F.lds, g, S, E);
        PROBE_PRE_END(5); if (BOTH(5)) GRID_BAR(); } PROBE_END(5);
    PROBE_BEGIN(6); if (IN(6)) { p6_gdn_pre(F); PROBE_PRE_END(6); if (BOTH(6)) GRID_BAR(); } PROBE_END(6);
    PROBE_BEGIN(7); if (IN(7)) { p7_gdn_rec(F); PROBE_PRE_END(7); if (BOTH(7)) GRID_BAR(); } PROBE_END(7);
    PROBE_BEGIN(8); if (IN(8)) {
        pg8::Gemm g{ONB, (const bf16*)(F.ws + WS_WO), DM, 0, 0}; pg8::StaticOrder S; S.init(64, 4, F.G, (int)blockIdx.x, DM / 64, 4, 4);
        EpiRes<false> E{B1, F.out, SS, slab};
        pg8::gemm_phase<EpiRes<false>, pg8::StaticOrder, true, true>(F.lds, g, S, E);
        GRID_BAR(); res_fixup<false>(F, B1, SS, slab, 4);
        PROBE_PRE_END(8); if (BOTH(8)) GRID_BAR(); } PROBE_END(8);
    PROBE_BEGIN(9); if (IN(9)) {
        pg8::Gemm g{B1, (const bf16*)(F.ws + WS_WUP1), DM, 2, 65}; pg8::StaticOrder S; S.init(66, 22, F.G, (int)blockIdx.x, DM / 64);
        EpiUp E{BIG, SS, F.in[27] + 3 * UPN, F.in[6] + (size_t)NS * 2 * UPN, F.out + O_PFCONV + (size_t)NB * 2 * UPN, F.out + O_SFCONV + (size_t)NS * 2 * UPN, ex, 65};
        pg8::gemm_phase<EpiUp, pg8::StaticOrder, true, true>(F.lds, g, S, E);
        PROBE_PRE_END(9); if (BOTH(9)) GRID_BAR(); } PROBE_END(9);
    PROBE_BEGIN(10); if (IN(10)) {
        pg8::Gemm g{BIG, (const bf16*)(F.ws + WS_WDN1), DFF, 0, 0}; pg8::StaticOrder S; S.init(64, 4, F.G, (int)blockIdx.x, DFF / 64, 11, 4);
        EpiRes<false> E{B1, F.out, SS, slab};
        pg8::gemm_phase<EpiRes<false>, pg8::StaticOrder, true, true>(F.lds, g, S, E);
        PROBE_PRE_END(10); if (BOTH(10)) GRID_BAR(); } PROBE_END(10);
    PROBE_BEGIN(11); if (IN(11)) p11_final(F, B1, slab, 11); PROBE_END(11);
#ifdef SEG_ID
    __syncthreads();
    if (F.vcu == SEG_BLOCK) { const unsigned long long tend = __builtin_amdgcn_s_memrealtime(), wait = *(volatile LAS unsigned long long*)(F.lds + LDSCTL_OFF + 64) * SEG_AMP; while (__builtin_amdgcn_s_memrealtime() - tend < wait) __builtin_amdgcn_s_sleep(8); }
#endif
#ifdef P6_SEG
    __syncthreads();
    if (blockIdx.x == 3) { const unsigned long long tend = __builtin_amdgcn_s_memrealtime(), wait = *(volatile LAS unsigned long long*)(F.lds + LDSCTL_OFF + 64) * P6_AMP; while (__builtin_amdgcn_s_memrealtime() - tend < wait) __builtin_amdgcn_s_sleep(8); }
#endif
#ifdef P7_SEG
    __syncthreads();
    if (blockIdx.x == 0) { const unsigned long long tend = __builtin_amdgcn_s_memrealtime(), wait = *(volatile LAS unsigned long long*)(F.lds + LDSCTL_OFF + 64) * P7_AMP; while (__builtin_amdgcn_s_memrealtime() - tend < wait) __builtin_amdgcn_s_sleep(8); }
#endif
#ifdef PROBE_PHASE
    if (F.vcu == PROBE_BLOCK) { const unsigned long long tend = __builtin_amdgcn_s_memrealtime(), wait = (pr_t1 - pr_t0) * PROBE_AMP; while (__builtin_amdgcn_s_memrealtime() - tend < wait) __builtin_amdgcn_s_sleep(8); }
#endif
#undef IN
#undef BOTH
}

extern "C" void kernel_launch(void* const* d_in, const int* in_sizes, int n_in, void* d_out, int out_size, void* d_ws, size_t ws_size, hipStream_t stream) {
    static int grid = 0;
    if (grid == 0) {
        if (n_in != 29 || (size_t)out_size != O_END || ws_size < WS_END) { fprintf(stderr, "kernel_launch: unexpected shapes (n_in %d, out %d, ws %zu); nothing launched\n", n_in, out_size, ws_size); grid = -1; return; }
        int dev = 0, cus = 0, per_cu = 0;
        if (hipGetDevice(&dev) != hipSuccess || hipDeviceGetAttribute(&cus, hipDeviceAttributeMultiprocessorCount, dev) != hipSuccess) { grid = -1; return; }
        if (hipFuncSetAttribute((const void*)hybrid_fwd, hipFuncAttributeMaxDynamicSharedMemorySize, LDS_BYTES) != hipSuccess) { fprintf(stderr, "kernel_launch: hipFuncSetAttribute failed\n"); grid = -1; return; }
        if (hipOccupancyMaxActiveBlocksPerMultiprocessor(&per_cu, (const void*)hybrid_fwd, NWAVES * 64, LDS_BYTES) != hipSuccess || per_cu < 1)
            fprintf(stderr, "kernel_launch: note: occupancy query reports %d workgroups per CU\n", per_cu);
        (void)hipGetLastError();
        grid = cus;
    }
    if (grid < 0) return;
    if (hipMemsetAsync((char*)d_ws + WS_CTL, 0, CTL_ZERO_BYTES, stream) != hipSuccess) { fprintf(stderr, "kernel_launch: memset failed\n"); return; }
    Args a{};
    for (int i = 0; i < 29; ++i) a.in[i] = (const float*)d_in[i];
    a.out = (float*)d_out; a.ws = (unsigned char*)d_ws;
#if MK_PER_PHASE
    for (int p = 0; p < NPHASE; ++p) { a.ph_lo = p; a.ph_hi = p + 1; hipLaunchKernelGGL(hybrid_fwd, dim3(grid), dim3(NWAVES * 64), LDS_BYTES, stream, a); }
#else
    a.ph_lo = 0; a.ph_hi = NPHASE;
    hipLaunchKernelGGL(hybrid_fwd, dim3(grid), dim3(NWAVES * 64), LDS_BYTES, stream, a);
#endif
    const hipError_t le = hipPeekAtLastError();
    if (le != hipSuccess) fprintf(stderr, "kernel_launch: launch failed: %s\n", hipGetErrorName(le));
}
```

```cpp
#include <hip/hip_runtime.h>
#include <cstdio>
#include <cstdint>

#ifndef MK_PER_PHASE
#define MK_PER_PHASE 0
#endif

#define GAS __attribute__((address_space(1)))
#define LAS __attribute__((address_space(3)))
typedef unsigned short bf16;
typedef unsigned short bf16_t;
typedef short bf16x8 __attribute__((ext_vector_type(8)));
typedef float f32x4 __attribute__((ext_vector_type(4)));
typedef float f32x2 __attribute__((ext_vector_type(2)));
typedef unsigned u32x4 __attribute__((ext_vector_type(4)));
typedef unsigned u32x2 __attribute__((ext_vector_type(2)));

constexpr int DM = 1024, NB = 8, SEQ = 2048, NMETA = 16, TP = NMETA + SEQ  , NS = 128;
constexpr int ROWS_P = NB * TP  , ROWS = ROWS_P + NS  , ROWS_PAD = 16896;
constexpr int S5G = 64, S5P = 64, S5L = 16, S5NCH = TP / S5L  , S5NCHP = 144;
constexpr int DFF = 2816, UPN = 2 * DFF;
constexpr int GH = 8, GDK = 128, GCONV = 3072, GIN = 4112, GINP = 4352;
constexpr int GNCH = 33, GNULL = 48;
constexpr float EPS = 1e-6f;

constexpr size_t O_YP = 0, O_YS = 16777216, O_PS5RE = 16908288, O_PS5IM = 16941056, O_PGDN = 16973824, O_PGCONV = 18022400, O_PFCONV = 18096128,
                 O_SS5RE = 18276352, O_SS5IM = 18800640, O_SGDN = 19324928, O_SGCONV = 36102144, O_SFCONV = 37281792, O_END = 40165376;

constexpr size_t MiB = 1u << 20;
constexpr size_t WS_CTL = 0, CTL_ZERO_BYTES = 64 * 1024;
constexpr size_t WS_SS = 1 * MiB;
constexpr size_t WS_AB = 3 * MiB + 512 * 1024;
constexpr size_t WS_XS = 5 * MiB;
constexpr size_t WS_MISC = 6 * MiB;
constexpr size_t WS_HS = 7 * MiB;
constexpr size_t WS_C0 = 8 * MiB;
constexpr size_t WS_OL0 = 11 * MiB;
constexpr size_t WS_W1 = 12 * MiB;
constexpr size_t WS_WIN = WS_W1, WS_WO = WS_WIN + (size_t)GINP * DM * 2, WS_WUP1 = WS_WO + (size_t)DM * DM * 2, WS_WDN1 = WS_WUP1 + (size_t)UPN * DM * 2;
constexpr size_t WS_W0 = 40 * MiB;
constexpr size_t WS_WGLU = WS_W0, WS_WUP0 = WS_WGLU + (size_t)2048 * DM * 2, WS_WDN0 = WS_WUP0 + (size_t)UPN * DM * 2, WS_S5M = WS_WDN0 + (size_t)DM * DFF * 2;
constexpr size_t S5M_WG = 128 * 256 * 2, S5M_TV = 256 * 384 * 2, S5M_G = S5M_WG + S5M_TV;
constexpr size_t WS_WX = WS_W0;
constexpr size_t WS_B1 = 77 * MiB;
constexpr size_t WS_B2 = 110 * MiB;
constexpr size_t WS_BIG = 143 * MiB;
constexpr size_t WS_SLAB = 241 * MiB;
constexpr size_t WS_END = 252 * MiB;
static_assert(WS_WDN1 + (size_t)DM * DFF * 2 <= WS_W0 && WS_S5M + 64 * S5M_G <= WS_B1 && WS_WX + (size_t)NB * GH * GNCH * 16384 <= WS_B1, "ws map");
static_assert(WS_B1 + (size_t)ROWS_PAD * DM * 2 <= WS_B2 && WS_B2 + (size_t)ROWS_PAD * DM * 2 <= WS_BIG && WS_BIG + (size_t)ROWS * GCONV * 2 <= WS_END, "ws map");
static_assert(WS_BIG + (size_t)ROWS_PAD * DFF * 2 <= WS_END && WS_BIG + (size_t)NB * S5G * S5NCHP * 512 <= WS_END, "ws map");

constexpr int LDS_BYTES = 147456;
constexpr int LDSCTL_OFF = LDS_BYTES - 512;
constexpr int EXCH_OFF = 131072;

__device__ __forceinline__ unsigned f2bf(float f) { unsigned u = __builtin_bit_cast(unsigned, f); return (u + 0x7fffu + ((u >> 16) & 1u)) >> 16; }
typedef __bf16 bf16x2_t __attribute__((ext_vector_type(2)));
__device__ __forceinline__ unsigned pk2(float lo, float hi) { const f32x2 v = {lo, hi}; const bf16x2_t b = __builtin_convertvector(v, bf16x2_t); return __builtin_bit_cast(unsigned, b); }
__device__ __forceinline__ float bflo(unsigned u) { return __builtin_bit_cast(float, u << 16); }
__device__ __forceinline__ float bfhi(unsigned u) { return __builtin_bit_cast(float, u & 0xffff0000u); }
__device__ __forceinline__ float sigmoidf_(float x) { return __builtin_amdgcn_rcpf(1.f + __expf(-x)); }
__device__ __forceinline__ float siluf_(float x) { return x * __builtin_amdgcn_rcpf(1.f + __expf(-x)); }
__device__ __forceinline__ float gelu_tanh(float x) { const float z = 1.5957691216057308f * (x + 0.044715f * x * x * x); return x * __builtin_amdgcn_rcpf(1.f + __expf(-z)); }

__device__ __forceinline__ float ldv_f32(const float* p) { return __builtin_bit_cast(float, __hip_atomic_load((const unsigned*)p, __ATOMIC_RELAXED, __HIP_MEMORY_SCOPE_AGENT)); }

__device__ __forceinline__ float* xrow_ptr(float* yp, float* xs, int row) {
    if (row >= ROWS_P) return xs + (size_t)(128 + row - ROWS_P) * DM;
    const int b = row / TP, pos = row - b * TP;
    return pos < NMETA ? xs + (size_t)(b * NMETA + pos) * DM : yp + ((size_t)b * SEQ + (pos - NMETA)) * DM;
}
__device__ __forceinline__ const float* xin_ptr(const float* xp, const float* xsmp, const float* meta, int row) {
    if (row >= ROWS_P) return xsmp + (size_t)(row - ROWS_P) * DM;
    const int b = row / TP, pos = row - b * TP;
    return pos < NMETA ? meta + (size_t)pos * DM : xp + ((size_t)b * SEQ + (pos - NMETA)) * DM;
}

namespace pg8 {
#define PG8_LAS __attribute__((address_space(3)))
constexpr int BM = 256, BK = 64, HALF = 128, HTB = HALF * BK * 2  , STAGE_BYTES = 8 * HTB, NXCD = 8, WGM = 8;
__host__ __device__ __forceinline__ int lds_byte(int r, int c) { const int st = (r >> 4) * 2 + (c >> 5), rr = r & 15, cc = c & 31, ob = rr * 64 + cc * 2; return st * 1024 + (ob ^ (((ob >> 9) & 1) << 5)); }
__host__ __device__ __forceinline__ void stage_rc(int b, int& R, int& C) { const int st = b / 1024, sb = b % 1024, swz = sb ^ (((sb >> 9) & 1) << 5); R = (st >> 1) * 16 + swz / 64; C = (st & 1) * 32 + (swz % 64) / 2; }
__host__ __device__ __forceinline__ int perm32(int rho) { const int n = rho >> 4, i = rho & 15; return 8 * (i >> 2) + 4 * n + (i & 3); }

struct Unit { int pm, pn, kt0, nkt, sub; };
struct Gemm { const bf16_t* A; const bf16_t* Bt; int K, halo, nMp; };
__device__ __forceinline__ int tile_row0(const Gemm& g, int pm) { return g.halo == 0 ? 256 * pm : (pm >= g.nMp ? ROWS_P : (256 - g.halo) * pm); }

struct StaticOrder {
    int nM, nN, nwg, G, c, nkt, nsub, nsplit, skt;
    __host__ __device__ __forceinline__ void init(int nM_, int nN_, int G_, int c_, int nkt_, int nsplit_ = 0, int skt_ = 0) { nM = nM_; nN = nN_; nwg = nM * nN; G = G_; c = c_; nkt = nkt_; nsplit = nsplit_; skt = skt_; nsub = nsplit_ * nN_; }
    __host__ __device__ __forceinline__ bool next(int i, Unit& u) const {
        const long L = (long)i * G + c; if (L >= nwg + nsub) return false;
        const bool is_sub = L >= nwg; const int s = is_sub ? (int)L - nwg : 0, nsp = nsplit > 0 ? nsplit : 1;
        int wgid = is_sub ? 0 : (int)L; { const int q = nwg / NXCD, r = nwg % NXCD, xcd = wgid % NXCD, off = wgid / NXCD; wgid = (xcd < r ? xcd * (q + 1) : r * (q + 1) + (xcd - r) * q) + off; }
        const int nig = WGM * nN, gid = wgid / nig, fm = gid * WGM, gsz = (nM - fm) < WGM ? (nM - fm) : WGM;
        const int pm_m = fm + ((wgid % nig) % gsz), pn_m = (wgid % nig) / gsz;
        u.pm = is_sub ? nM : pm_m; u.pn = is_sub ? s / nsp : pn_m; u.kt0 = is_sub ? skt * (s % nsp) : 0; u.nkt = is_sub ? skt : nkt; u.sub = is_sub ? s : -1;
        return true;
    }
};

template <class Epi, class Sched, bool ALIGN_EPI = false, bool SP2 = false>
__device__ __forceinline__ void gemm_phase(PG8_LAS unsigned char* lds, const Gemm g, const Sched& S, const Epi& E) {
    const int tid = threadIdx.x, wid = __builtin_amdgcn_readfirstlane(tid >> 6), lane = tid & 63, wr = wid >> 2, wc = wid & 3, fr = lane & 15, fq = lane >> 4;
    const int K = g.K;
    unsigned voffA[2], voffB[2];
#pragma unroll
    for (int i = 0; i < 2; ++i) { int R, C; stage_rc(tid * 16 + i * 8192, R, C); const int Rb = Epi::PERM ? ((R & ~31) + perm32(R & 31)) : R;
        voffA[i] = (unsigned)(R * K + C) * 2u; voffB[i] = (unsigned)(Rb * K + C) * 2u; }
    const size_t kstep = (size_t)(BK * 2);
    const size_t hstep = (size_t)HALF * K * 2;
    const size_t tstep = 2 * hstep;
    const size_t rstep = (size_t)K * 2;
    const unsigned ldsw = (unsigned)wid * 1024u;
    const int aoff = lds_byte(wr * 64 + fr, fq * 8), boff = lds_byte(wc * 32 + fr, fq * 8);
#define PG8_SA(b, h) (((b) * 2 + (h)) * HTB)
#define PG8_SB(b, h) ((4 + (b) * 2 + (h)) * HTB)
#define PG8_STAGE(bufoff, gbase, voff) do { _Pragma("unroll") for (int _i = 0; _i < 2; ++_i) \
        __builtin_amdgcn_global_load_lds((const unsigned*)((const char*)(gbase) + (voff)[_i]), (PG8_LAS unsigned*)(lds + (bufoff) + ldsw + _i * 8192), 16, 0, 0); } while (0)
#define PG8_LDA(dst, b, h) do { _Pragma("unroll") for (int m = 0; m < 4; ++m) _Pragma("unroll") for (int k = 0; k < 2; ++k) dst[m][k] = *(const PG8_LAS bf16x8*)(lds + PG8_SA(b, h) + aoff + m * 2048 + k * 1024); } while (0)
#define PG8_LDB(dst, b, h) do { _Pragma("unroll") for (int n = 0; n < 2; ++n) _Pragma("unroll") for (int k = 0; k < 2; ++k) dst[n][k] = *(const PG8_LAS bf16x8*)(lds + PG8_SB(b, h) + boff + n * 2048 + k * 1024); } while (0)
#define PG8_MMA(ai, bj, At, Bt) do { __builtin_amdgcn_s_setprio(1); _Pragma("unroll") for (int m = 0; m < 4; ++m) _Pragma("unroll") for (int n = 0; n < 2; ++n) _Pragma("unroll") for (int k = 0; k < 2; ++k) \
        acc[ai][bj][m][n] = __builtin_amdgcn_mfma_f32_16x16x32_bf16(Bt[n][k], At[m][k], acc[ai][bj][m][n], 0, 0, 0); __builtin_amdgcn_s_setprio(0); } while (0)
#define PG8_WAIT_V(n) asm volatile("s_waitcnt vmcnt(" #n ")" ::: "memory")
#define PG8_WAIT_L(n) asm volatile("s_waitcnt lgkmcnt(" #n ")" ::: "memory")
#define PG8_BAR __builtin_amdgcn_s_barrier()
#define PG8_SCHED __builtin_amdgcn_sched_barrier(0)
    Unit cur, nxt; int ui = 0;
    if (!S.next(0, cur)) return;
    f32x4 acc[2][2][4][2];
#pragma unroll
    for (int a = 0; a < 2; ++a)
#pragma unroll
        for (int b = 0; b < 2; ++b)
#pragma unroll
            for (int m = 0; m < 4; ++m)
#pragma unroll
                for (int n = 0; n < 2; ++n) acc[a][b][m][n] = (f32x4){0.f, 0.f, 0.f, 0.f};
    bf16x8 At[4][2], B0[2][2], B1[2][2];
    const char* cA = (const char*)g.A + (size_t)tile_row0(g, cur.pm) * rstep + (size_t)cur.kt0 * kstep; const char* cB = (const char*)g.Bt + (size_t)cur.pn * tstep + (size_t)cur.kt0 * kstep;
    if constexpr (SP2) {
        PG8_STAGE(PG8_SB(0, 0), cB, voffB); PG8_STAGE(PG8_SB(0, 1), cB + hstep, voffB); PG8_STAGE(PG8_SA(0, 0), cA, voffA); PG8_STAGE(PG8_SA(0, 1), cA + hstep, voffA);
        if (wr == 1) PG8_BAR;
        PG8_WAIT_V(2); PG8_BAR;
        PG8_STAGE(PG8_SB(1, 0), cB + kstep, voffB); PG8_STAGE(PG8_SA(1, 0), cA + kstep, voffA); PG8_STAGE(PG8_SB(1, 1), cB + hstep + kstep, voffB);
        PG8_WAIT_V(6); PG8_BAR;
    } else {
        PG8_STAGE(PG8_SB(0, 0), cB, voffB); PG8_STAGE(PG8_SA(0, 0), cA, voffA); PG8_STAGE(PG8_SB(0, 1), cB + hstep, voffB); PG8_STAGE(PG8_SA(0, 1), cA + hstep, voffA);
        if (wr == 1) PG8_BAR;
        PG8_WAIT_V(4); PG8_BAR;
        PG8_STAGE(PG8_SB(1, 0), cB + kstep, voffB); PG8_STAGE(PG8_SA(1, 0), cA + kstep, voffA); PG8_STAGE(PG8_SB(1, 1), cB + hstep + kstep, voffB);
        PG8_WAIT_V(6); PG8_BAR;
    }
    for (;;) {
        const bool has_next = S.next(ui + 1, nxt);
        const char* nA = has_next ? (const char*)g.A + (size_t)tile_row0(g, nxt.pm) * rstep + (size_t)nxt.kt0 * kstep : cA; const char* nB = has_next ? (const char*)g.Bt + (size_t)nxt.pn * tstep + (size_t)nxt.kt0 * kstep : cB;
        const int nt = cur.nkt;
        for (int t = 0; t < nt; t += 2) {
            const bool last = (t == nt - 2);
            const char* a1 = cA + (size_t)(t + 1) * kstep;
            const char* a2 = last ? nA : cA + (size_t)(t + 2) * kstep; const char* b2 = last ? nB : cB + (size_t)(t + 2) * kstep;
            const char* a3 = a2 + kstep; const char* b3 = b2 + kstep;
            if constexpr (SP2) {
            PG8_LDB(B0, 0, 0); PG8_LDB(B1, 0, 1); PG8_SCHED; PG8_LDA(At, 0, 0); PG8_STAGE(PG8_SA(1, 1), a1 + hstep, voffA);
            PG8_WAIT_V(8); PG8_WAIT_L(0); PG8_BAR; PG8_MMA(0, 0, At, B0); PG8_MMA(0, 1, At, B1); PG8_BAR; PG8_SCHED;
            PG8_LDA(At, 0, 1); PG8_STAGE(PG8_SB(0, 0), b2, voffB); PG8_STAGE(PG8_SB(0, 1), b2 + hstep, voffB); PG8_STAGE(PG8_SA(0, 0), a2, voffA);
            PG8_WAIT_V(8); PG8_WAIT_L(0); PG8_BAR; PG8_MMA(1, 0, At, B0); PG8_MMA(1, 1, At, B1); PG8_BAR; PG8_SCHED;
            PG8_LDB(B0, 1, 0); PG8_LDB(B1, 1, 1); PG8_SCHED; PG8_LDA(At, 1, 0); PG8_STAGE(PG8_SA(0, 1), a2 + hstep, voffA);
            PG8_WAIT_V(8); PG8_WAIT_L(0); PG8_BAR; PG8_MMA(0, 0, At, B0); PG8_MMA(0, 1, At, B1); PG8_BAR; PG8_SCHED;
            PG8_LDA(At, 1, 1); PG8_STAGE(PG8_SB(1, 0), b3, voffB); PG8_STAGE(PG8_SB(1, 1), b3 + hstep, voffB); PG8_STAGE(PG8_SA(1, 0), a3, voffA);
            PG8_WAIT_V(8); PG8_WAIT_L(0); PG8_BAR; PG8_MMA(1, 0, At, B0); PG8_MMA(1, 1, At, B1); PG8_BAR; PG8_SCHED;
            } else {
            PG8_LDB(B0, 0, 0); PG8_SCHED; PG8_LDA(At, 0, 0); PG8_STAGE(PG8_SA(1, 1), a1 + hstep, voffA);
            PG8_WAIT_L(8); PG8_BAR; PG8_WAIT_L(0); PG8_MMA(0, 0, At, B0); PG8_BAR; PG8_SCHED;
            PG8_LDB(B1, 0, 1); PG8_STAGE(PG8_SB(0, 0), b2, voffB);
            PG8_BAR; PG8_WAIT_L(0); PG8_MMA(0, 1, At, B1); PG8_BAR;
            PG8_LDA(At, 0, 1); PG8_STAGE(PG8_SA(0, 0), a2, voffA);
            PG8_BAR; PG8_WAIT_L(0); PG8_MMA(1, 0, At, B0); PG8_BAR; PG8_SCHED;
            PG8_STAGE(PG8_SB(0, 1), b2 + hstep, voffB);
            PG8_WAIT_V(6); PG8_BAR; PG8_MMA(1, 1, At, B1); PG8_BAR;
            PG8_LDB(B0, 1, 0); PG8_SCHED; PG8_LDA(At, 1, 0); PG8_STAGE(PG8_SA(0, 1), a2 + hstep, voffA);
            PG8_WAIT_L(8); PG8_BAR; PG8_WAIT_L(0); PG8_MMA(0, 0, At, B0); PG8_BAR; PG8_SCHED;
            PG8_LDB(B1, 1, 1); PG8_STAGE(PG8_SB(1, 0), b3, voffB);
            PG8_BAR; PG8_WAIT_L(0); PG8_MMA(0, 1, At, B1); PG8_BAR;
            PG8_LDA(At, 1, 1); PG8_STAGE(PG8_SA(1, 0), a3, voffA);
            PG8_BAR; PG8_WAIT_L(0); PG8_MMA(1, 0, At, B0); PG8_BAR; PG8_SCHED;
            PG8_STAGE(PG8_SB(1, 1), b3 + hstep, voffB);
            PG8_WAIT_V(6); PG8_BAR; PG8_MMA(1, 1, At, B1); PG8_BAR;
            }
        }
        if constexpr (ALIGN_EPI) { if (wr == 0) PG8_BAR; }
        E(acc, cur, tile_row0(g, cur.pm), wid, wr, wc, fr, fq);
        if (!has_next) break;
#pragma unroll
        for (int a = 0; a < 2; ++a)
#pragma unroll
            for (int b = 0; b < 2; ++b)
#pragma unroll
                for (int m = 0; m < 4; ++m)
#pragma unroll
                    for (int n = 0; n < 2; ++n) acc[a][b][m][n] = (f32x4){0.f, 0.f, 0.f, 0.f};
        cur = nxt; cA = nA; cB = nB; ++ui;
        if constexpr (ALIGN_EPI) { if (wr == 1) PG8_BAR; }
    }
    PG8_WAIT_V(0);
    if constexpr (!ALIGN_EPI) { if (wr == 0) PG8_BAR; }
    PG8_BAR;
#undef PG8_SA
#undef PG8_SB
#undef PG8_STAGE
#undef PG8_LDA
#undef PG8_LDB
#undef PG8_MMA
#undef PG8_WAIT_V
#undef PG8_WAIT_L
#undef PG8_BAR
#undef PG8_SCHED
}
}

typedef GAS unsigned gu32;
#define RLX_AGENT __ATOMIC_RELAXED, __HIP_MEMORY_SCOPE_AGENT
#define LDS_WAIT() asm volatile("s_waitcnt lgkmcnt(0)" ::: "memory")
#define VM_WAIT() asm volatile("s_waitcnt vmcnt(0)" ::: "memory")

#define XB_TMO      128
#define XB_XCNT(j)  (256  + 64 * (j))
#define XB_XSUB(j)  (1280 + 64 * (j))
#define XB_XGEN(j)  (2304 + 64 * (j))
#define XB_TOP      3328
#define XB_TOPGEN   3392
#define XCD_BAR_WORDS 3456
#define XB_SPIN_CAP (1u << 18)
__device__ __forceinline__ unsigned xb_ld(unsigned* p)              { return __hip_atomic_load(p, __ATOMIC_RELAXED, __HIP_MEMORY_SCOPE_AGENT); }
__device__ __forceinline__ unsigned xb_add(unsigned* p, unsigned v) { return __hip_atomic_fetch_add(p, v, __ATOMIC_RELAXED, __HIP_MEMORY_SCOPE_AGENT); }
__device__ __forceinline__ unsigned xb_xcc_id() { return (unsigned)__builtin_amdgcn_s_getreg((3 << 11) | 20) & 0xFu; }
#define XB_SPIN(cond, bar) do { unsigned _sp = 0; while (cond) { __builtin_amdgcn_s_sleep(1); \
    if ((++_sp & 255u) == 0u) { if (xb_ld(&(bar)[XB_TMO])) break; if (_sp > XB_SPIN_CAP) { atomicAdd(&(bar)[XB_TMO], 1u); break; } } } } while (0)
struct XcdBarrier { unsigned* bar; unsigned x; volatile LAS unsigned* st; };
__device__ __forceinline__ XcdBarrier xcd_barrier_post(unsigned* bar, volatile LAS unsigned* st) {
    XcdBarrier b; b.bar = bar; b.x = xb_xcc_id(); b.st = st;
    if (threadIdx.x == 0) (void)xb_add(&bar[XB_XCNT(b.x)], 1u);
    return b;
}
__device__ __forceinline__ void xcd_barrier_complete(unsigned* bar, unsigned x, unsigned& nloc, unsigned& nx) {
    const unsigned G = gridDim.x * gridDim.y * gridDim.z;
    unsigned sum, cnt, mine, sp = 0u;
    for (;;) {
        sum = 0u; cnt = 0u; mine = 0u;
#pragma unroll
        for (unsigned j = 0; j < 16; ++j) { const unsigned c = xb_ld(&bar[XB_XCNT(j)]); sum += c; cnt += (c > 0u) ? 1u : 0u; mine = (j == x) ? c : mine; }
        if (sum == G) break;
        __builtin_amdgcn_s_sleep(1);
        if ((++sp & 255u) == 0u) { if (xb_ld(&bar[XB_TMO])) break; if (sp > XB_SPIN_CAP) { atomicAdd(&bar[XB_TMO], 1u); break; } }
    }
    nloc = mine > 0u ? mine : 1u; nx = cnt > 0u ? cnt : 1u;
}
__device__ __forceinline__ void xcd_barrier(const XcdBarrier& b) {
    asm volatile("s_waitcnt vmcnt(0)" ::: "memory");
    __syncthreads();
    if (threadIdx.x == 0) {
        unsigned* bar = b.bar;
        __builtin_amdgcn_s_waitcnt(0);
        unsigned nloc = b.st[0], nx = b.st[1];
        if (nloc == 0u) { xcd_barrier_complete(bar, b.x, nloc, nx); b.st[0] = nloc; b.st[1] = nx; }
        const unsigned old = xb_add(&bar[XB_XSUB(b.x)], 1u);
        const unsigned gen = old / nloc;
        if (old + 1u == (gen + 1u) * nloc) {
            __builtin_amdgcn_fence(__ATOMIC_RELEASE, "agent");
            asm volatile("s_waitcnt vmcnt(0)" ::: "memory");
            const unsigned og = xb_add(&bar[XB_TOP], 1u);
            const unsigned tg = og / nx;
            if (og + 1u == (tg + 1u) * nx) xb_add(&bar[XB_TOPGEN], 1u);
            else XB_SPIN(xb_ld(&bar[XB_TOPGEN]) == tg, bar);
            __builtin_amdgcn_fence(__ATOMIC_ACQUIRE, "agent");
            xb_add(&bar[XB_XGEN(b.x)], 1u);
            asm volatile("s_waitcnt vmcnt(0)" ::: "memory");
        } else {
            XB_SPIN(xb_ld(&bar[XB_XGEN(b.x)]) == gen, bar);
            __builtin_amdgcn_fence(__ATOMIC_ACQUIRE, "agent");
            asm volatile("s_waitcnt vmcnt(0)" ::: "memory");
        }
    }
    __syncthreads();
}

constexpr int NWAVES = 8;
struct Args { const float* in[29]; float* out; unsigned char* ws; int ph_lo, ph_hi; };
struct Frame {
    LAS unsigned char* lds;
    int tid, lane, wave, vcu, G;
    const float* const* in;
    float* out; unsigned char* ws;
};
__device__ __forceinline__ float wave_sum(float v) {
#pragma unroll
    for (int o = 1; o < 64; o <<= 1) v += __shfl_xor(v, o);
    return v;
}
__device__ __forceinline__ float row_rs(const float* SS, int row, int fq) {
    const f32x4* p = (const f32x4*)((const char*)SS + (unsigned)(row * 128 + fq * 32));
    const f32x4 a = p[0], b = p[1];
    float s = (a.x + a.y) + (a.z + a.w) + (b.x + b.y) + (b.z + b.w);
    s += __shfl_xor(s, 16); s += __shfl_xor(s, 32);
    return __builtin_amdgcn_rsqf(s * (1.f / DM) + EPS);
}
template <int D> __device__ __forceinline__ float dpp_shift(float cur, float prevblk) {
    const int o = __builtin_amdgcn_update_dpp(0, __builtin_bit_cast(int, prevblk), 0x120 + D, 0xf, 0xf, false);
    const int r = __builtin_amdgcn_update_dpp(o, __builtin_bit_cast(int, cur), 0x110 + D, 0xf, 0xf, false);
    return __builtin_bit_cast(float, r);
}

struct EpiNull {
    static constexpr bool PERM = true;
    __device__ __forceinline__ void operator()(const f32x4 (&acc)[2][2][4][2], const pg8::Unit& u, int row0, int wid, int wr, int wc, int fr, int fq) const {
#pragma unroll
        for (int ai = 0; ai < 2; ++ai)
#pragma unroll
            for (int bj = 0; bj < 2; ++bj)
#pragma unroll
                for (int m = 0; m < 4; ++m)
#pragma unroll
                    for (int n = 0; n < 2; ++n) asm volatile("" :: "v"(acc[ai][bj][m][n]));
    }
};
__device__ __forceinline__ float* yrow_ptr(float* out, int row) {
    if (row >= ROWS_P) return out + O_YS + (size_t)(row - ROWS_P) * DM;
    const int b = row / TP, pos = row - b * TP;
    return pos < NMETA ? nullptr : out + O_YP + ((size_t)b * SEQ + (pos - NMETA)) * DM;
}
struct EpiGlu {
    static constexpr bool PERM = true;
    const float* xp; const float* xsmp; const float* meta; bf16* XB; float* SS; float* slab;
    __device__ __forceinline__ void operator()(const f32x4 (&acc)[2][2][4][2], const pg8::Unit& u, int row0, int wid, int wr, int wc, int fr_, int fq_) const {
        int t_ = (int)threadIdx.x; asm volatile("" : "+v"(t_)); const int fr = t_ & 15, fq = (t_ >> 4) & 3;
        if (u.sub >= 0) {
            float* sl = slab + (size_t)u.sub * 65536;
#pragma unroll
            for (int ai = 0; ai < 2; ++ai)
#pragma unroll
                for (int m = 0; m < 4; ++m)
#pragma unroll
                    for (int bj = 0; bj < 2; ++bj)
#pragma unroll
                        for (int n = 0; n < 2; ++n) *(f32x4*)(sl + (size_t)(128 * ai + 64 * wr + 16 * m + fr) * 256 + 128 * bj + 32 * wc + 8 * fq + 4 * n) = acc[ai][bj][m][n];
            return;
        }
        const int col = 128 * u.pn + 32 * wc + 8 * fq;
#pragma unroll
        for (int ai = 0; ai < 2; ++ai)
#pragma unroll
            for (int m = 0; m < 4; ++m) {
                const int row = row0 + 128 * ai + 64 * wr + 16 * m + fr;
                const float* xi = xin_ptr(xp, xsmp, meta, row) + col;
                float ss = 0.f; f32x4 v[2];
#pragma unroll
                for (int n = 0; n < 2; ++n) { const f32x4 a = acc[ai][0][m][n], b = acc[ai][1][m][n], x = *(const f32x4*)(xi + 4 * n);
#pragma unroll
                    for (int j = 0; j < 4; ++j) { v[n][j] = x[j] + a[j] * sigmoidf_(b[j]); ss += v[n][j] * v[n][j]; } }
                u32x4 w; w.x = pk2(v[0][0], v[0][1]); w.y = pk2(v[0][2], v[0][3]); w.z = pk2(v[1][0], v[1][1]); w.w = pk2(v[1][2], v[1][3]);
                *(u32x4*)(XB + (size_t)row * DM + col) = w;
                ss += __shfl_xor(ss, 16); ss += __shfl_xor(ss, 32);
                if (fq == 0) SS[(size_t)row * 32 + u.pn * 4 + wc] = ss;
            }
    }
};
template <bool FINAL> struct EpiRes {
    static constexpr bool PERM = true;
    bf16* XB; float* out; float* SS; float* slab;
    __device__ __forceinline__ void operator()(const f32x4 (&acc)[2][2][4][2], const pg8::Unit& u, int row0, int wid, int wr, int wc, int fr_, int fq_) const {
        int t_ = (int)threadIdx.x; asm volatile("" : "+v"(t_)); const int fr = t_ & 15, fq = (t_ >> 4) & 3;
        if (u.sub >= 0) {
            float* sl = slab + (size_t)u.sub * 65536;
#pragma unroll
            for (int ai = 0; ai < 2; ++ai)
#pragma unroll
                for (int m = 0; m < 4; ++m)
#pragma unroll
                    for (int bj = 0; bj < 2; ++bj)
#pragma unroll
                        for (int n = 0; n < 2; ++n) *(f32x4*)(sl + (size_t)(128 * ai + 64 * wr + 16 * m + fr) * 256 + 128 * bj + 32 * wc + 8 * fq + 4 * n) = acc[ai][bj][m][n];
            return;
        }
        u32x4 xv[2][4][2];
#pragma unroll
        for (int ai = 0; ai < 2; ++ai)
#pragma unroll
            for (int m = 0; m < 4; ++m)
#pragma unroll
                for (int bj = 0; bj < 2; ++bj) xv[ai][m][bj] = *(const u32x4*)(XB + (size_t)(row0 + 128 * ai + 64 * wr + 16 * m + fr) * DM + 256 * u.pn + 128 * bj + 32 * wc + 8 * fq);
#pragma unroll
        for (int ai = 0; ai < 2; ++ai)
#pragma unroll
            for (int m = 0; m < 4; ++m) {
                const int row = row0 + 128 * ai + 64 * wr + 16 * m + fr;
                float* yr = FINAL ? yrow_ptr(out, row) : nullptr;
#pragma unroll
                for (int bj = 0; bj < 2; ++bj) {
                    const int col = 256 * u.pn + 128 * bj + 32 * wc + 8 * fq;
                    const u32x4 x = xv[ai][m][bj];
                    f32x4 v[2]; v[0] = (f32x4){bflo(x.x), bfhi(x.x), bflo(x.y), bfhi(x.y)} + acc[ai][bj][m][0]; v[1] = (f32x4){bflo(x.z), bfhi(x.z), bflo(x.w), bfhi(x.w)} + acc[ai][bj][m][1];
                    float ss = (v[0].x * v[0].x + v[0].y * v[0].y) + (v[0].z * v[0].z + v[0].w * v[0].w) + (v[1].x * v[1].x + v[1].y * v[1].y) + (v[1].z * v[1].z + v[1].w * v[1].w);
                    if (FINAL) { if (yr) { *(f32x4*)(yr + col) = v[0]; *(f32x4*)(yr + col + 4) = v[1]; } }
                    else { u32x4 w; w.x = pk2(v[0][0], v[0][1]); w.y = pk2(v[0][2], v[0][3]); w.z = pk2(v[1][0], v[1][1]); w.w = pk2(v[1][2], v[1][3]);
                        *(u32x4*)(XB + (size_t)row * DM + col) = w; }
                    ss += __shfl_xor(ss, 16); ss += __shfl_xor(ss, 32);
                    if (fq == 0) SS[(size_t)row * 32 + u.pn * 8 + wc * 2 + bj] = ss;
                }
            }
    }
};
template <bool FINAL> __device__ __forceinline__ void res_fixup(Frame& F, bf16* XB, float* SS, const float* slab, int nsplit) {
    for (int r = F.vcu; r < 256; r += F.G) {
        const int row = 64 * 256 + r;
        const int col = 2 * F.tid, pn = col >> 8, cc = col & 255;
        const unsigned xb = *(const unsigned*)(XB + (size_t)row * DM + col);
        f32x2 v = (f32x2){bflo(xb), bfhi(xb)};
        for (int s = 0; s < nsplit; ++s) v += *(const f32x2*)(slab + ((size_t)(pn * nsplit + s) * 256 + r) * 256 + cc);
        if (FINAL) { float* yr = yrow_ptr(F.out, row); if (yr) *(f32x2*)(yr + col) = v; }
        else *(unsigned*)(XB + (size_t)row * DM + col) = pk2(v.x, v.y);
        float ss = v.x * v.x + v.y * v.y;
        ss += __shfl_xor(ss, 1); ss += __shfl_xor(ss, 2); ss += __shfl_xor(ss, 4); ss += __shfl_xor(ss, 8);
        if ((F.tid & 15) == 0) { const int g32 = col >> 5; SS[(size_t)row * 32 + (g32 >> 3) * 8 + (g32 & 3) * 2 + ((g32 >> 2) & 1)] = ss; }
    }
}
__device__ __forceinline__ void glu_fixup(Frame& F, bf16* XB, float* SS, const float* slab, int nsplit) {
    for (int r = F.vcu; r < 256; r += F.G) {
        const int row = 64 * 256 + r, ch = 2 * F.tid, pn = ch >> 7, cc = ch & 127;
        f32x2 a = (f32x2){0.f, 0.f}, g = a;
        for (int s = 0; s < nsplit; ++s) { const float* sl = slab + ((size_t)(pn * nsplit + s) * 256 + r) * 256; a += *(const f32x2*)(sl + cc); g += *(const f32x2*)(sl + 128 + cc); }
        const f32x2 x = *(const f32x2*)(xin_ptr(F.in[0], F.in[1], F.in[7], row) + ch);
        const f32x2 v = (f32x2){x.x + a.x * sigmoidf_(g.x), x.y + a.y * sigmoidf_(g.y)};
        *(unsigned*)(XB + (size_t)row * DM + ch) = pk2(v.x, v.y);
        float ss = v.x * v.x + v.y * v.y;
        ss += __shfl_xor(ss, 1); ss += __shfl_xor(ss, 2); ss += __shfl_xor(ss, 4); ss += __shfl_xor(ss, 8);
        if ((F.tid & 15) == 0) SS[(size_t)row * 32 + (ch >> 5)] = ss;
    }
}
__device__ __forceinline__ int exch_off(int ai, int wave, int g4, int fr, int fq) { return ((((ai * 8 + wave) * 4 + g4) * 12) + (fr - 13) * 4 + fq) * 16; }
__device__ __forceinline__ void exch_publish(LAS unsigned char* ex, const f32x4 (&acc)[2][2][4][2], const float (&rs)[2][4], int wid, int fr, int fq) {
    if (fr >= 13) {
#pragma unroll
        for (int ai = 0; ai < 2; ++ai)
#pragma unroll
            for (int g4 = 0; g4 < 4; ++g4) *(LAS f32x4*)(ex + exch_off(ai, wid, g4, fr, fq)) = acc[ai][g4 >> 1][3][g4 & 1] * rs[ai][3];
    }
    asm volatile("s_waitcnt lgkmcnt(0)" ::: "memory");
    __builtin_amdgcn_s_barrier();
    asm volatile("" ::: "memory");
}
__device__ __forceinline__ f32x4 exch_prev(LAS unsigned char* ex, int ai, int wid, int wr, int g4, int fr, int fq) {
    f32x4 p = (f32x4){0.f, 0.f, 0.f, 0.f};
    if (fr >= 13) {
        if (wr == 1) p = *(const LAS f32x4*)(ex + exch_off(ai, wid - 4, g4, fr, fq));
        else if (ai == 1) p = *(const LAS f32x4*)(ex + exch_off(0, wid + 4, g4, fr, fq));
    }
    return p;
}
struct EpiUp {
    static constexpr bool PERM = true;
    bf16* ACT; const float* SS; const float* cw; const float* st; float* pf; float* sf; LAS unsigned char* ex; int nMp;
    __device__ __forceinline__ void operator()(const f32x4 (&acc)[2][2][4][2], const pg8::Unit& u, int row0, int wid, int wr, int wc, int fr_, int fq_) const {
        int t_ = (int)threadIdx.x; asm volatile("" : "+v"(t_)); const int fr = t_ & 15, fq = (t_ >> 4) & 3;
        const bool sample = (u.pm >= nMp);
        const int lo = (u.pm == 0 || sample) ? 0 : 2;
        float rs[2][4];
#pragma unroll
        for (int ai = 0; ai < 2; ++ai)
#pragma unroll
            for (int m = 0; m < 4; ++m) rs[ai][m] = row_rs(SS, row0 + 128 * ai + 64 * wr + 16 * m + fr, fq);
        exch_publish(ex, acc, rs, wid, fr, fq);
        if (!sample) {
#pragma unroll
            for (int n = 0; n < 2; ++n) {
                const int ch = 128 * u.pn + 32 * wc + 8 * fq + 4 * n;
                const f32x4 w0a = *(const f32x4*)(cw + ch), w1a = *(const f32x4*)(cw + UPN + ch), w2a = *(const f32x4*)(cw + 2 * UPN + ch);
                const f32x4 w0b = *(const f32x4*)(cw + DFF + ch), w1b = *(const f32x4*)(cw + UPN + DFF + ch), w2b = *(const f32x4*)(cw + 2 * UPN + DFF + ch);
                asm volatile("" :: "v"(w0a), "v"(w1a), "v"(w2a), "v"(w0b), "v"(w1b), "v"(w2b));
#pragma unroll
                for (int ai = 0; ai < 2; ++ai) {
                    f32x4 pa = exch_prev(ex, ai, wid, wr, n, fr, fq), pb = exch_prev(ex, ai, wid, wr, 2 + n, fr, fq);
#pragma unroll
                    for (int m = 0; m < 4; ++m) {
                        const int R = 128 * ai + 64 * wr + 16 * m + fr, row = row0 + R;
                        const float rsv = rs[ai][m]; const f32x4 ca = acc[ai][0][m][n] * rsv, cb = acc[ai][1][m][n] * rsv;
                        const int b = row / TP, pos = row - b * TP;
                        const float m1 = pos >= 1 ? 1.f : 0.f, m2 = pos >= 2 ? 1.f : 0.f;
                        f32x4 o;
#pragma unroll
                        for (int j = 0; j < 4; ++j) {
                            const float s1a = dpp_shift<1>(ca[j], pa[j]) * m1, s2a = dpp_shift<2>(ca[j], pa[j]) * m2;
                            const float s1b = dpp_shift<1>(cb[j], pb[j]) * m1, s2b = dpp_shift<2>(cb[j], pb[j]) * m2;
                            const float ua = w2a[j] * ca[j] + w1a[j] * s1a + w0a[j] * s2a, ub = w2b[j] * cb[j] + w1b[j] * s1b + w0b[j] * s2b;
                            o[j] = siluf_(ua) * ub;
                        }
                        if (R >= lo && row < ROWS_P) {
                            u32x2 w; w.x = pk2(o[0], o[1]); w.y = pk2(o[2], o[3]);
                            *(u32x2*)(ACT + (size_t)row * DFF + ch) = w;
                            if (pos >= TP - 2) { float* d = pf + (size_t)(b * 2 + pos - (TP - 2)) * UPN + ch; *(f32x4*)d = ca; *(f32x4*)(d + DFF) = cb; }
                        }
                        pa = ca; pb = cb;
                    }
                }
            }
        } else {
#pragma unroll
            for (int n = 0; n < 2; ++n) {
                const int ch = 128 * u.pn + 32 * wc + 8 * fq + 4 * n;
                const f32x4 w0a = *(const f32x4*)(cw + ch), w1a = *(const f32x4*)(cw + UPN + ch), w2a = *(const f32x4*)(cw + 2 * UPN + ch);
                const f32x4 w0b = *(const f32x4*)(cw + DFF + ch), w1b = *(const f32x4*)(cw + UPN + DFF + ch), w2b = *(const f32x4*)(cw + 2 * UPN + DFF + ch);
#pragma unroll
                for (int m = 0; m < 4; ++m) {
                    const int s = 64 * wr + 16 * m + fr, row = row0 + s;
                    const float rsv = rs[0][m]; const f32x4 ca = acc[0][0][m][n] * rsv, cb = acc[0][1][m][n] * rsv;
                    const float* s0 = st + (size_t)(s * 2) * UPN + ch; const float* s1 = s0 + UPN;
                    const f32x4 a0 = *(const f32x4*)s0, a1 = *(const f32x4*)s1, b0 = *(const f32x4*)(s0 + DFF), b1 = *(const f32x4*)(s1 + DFF);
                    f32x4 o;
#pragma unroll
                    for (int j = 0; j < 4; ++j) { const float ua = w2a[j] * ca[j] + w1a[j] * a1[j] + w0a[j] * a0[j], ub = w2b[j] * cb[j] + w1b[j] * b1[j] + w0b[j] * b0[j]; o[j] = siluf_(ua) * ub; }
                    u32x2 w; w.x = pk2(o[0], o[1]); w.y = pk2(o[2], o[3]);
                    *(u32x2*)(ACT + (size_t)row * DFF + ch) = w;
                    float* d0 = sf + (size_t)(s * 2) * UPN + ch; float* d1 = d0 + UPN;
                    *(f32x4*)d0 = a1; *(f32x4*)(d0 + DFF) = b1; *(f32x4*)d1 = ca; *(f32x4*)(d1 + DFF) = cb;
                }
            }
        }
    }
};
struct EpiIn {
    static constexpr bool PERM = true;
    bf16* QKV; bf16* GATE; float* AB; const float* SS; const float* cw; const float* st; float* pg; float* sg; LAS unsigned char* ex; int nMp;
    __device__ __forceinline__ void operator()(const f32x4 (&acc)[2][2][4][2], const pg8::Unit& u, int row0, int wid, int wr, int wc, int fr_, int fq_) const {
        int t_ = (int)threadIdx.x; asm volatile("" : "+v"(t_)); const int fr = t_ & 15, fq = (t_ >> 4) & 3;
        const bool sample = (u.pm >= nMp);
        const int lo = (u.pm == 0 || sample) ? 0 : 3;
        float rs[2][4];
#pragma unroll
        for (int ai = 0; ai < 2; ++ai)
#pragma unroll
            for (int m = 0; m < 4; ++m) rs[ai][m] = row_rs(SS, row0 + 128 * ai + 64 * wr + 16 * m + fr, fq);
        exch_publish(ex, acc, rs, wid, fr, fq);
        if (u.pn < 12 && !sample) {
#pragma unroll
            for (int g4 = 0; g4 < 4; ++g4) {
                const int bj = g4 >> 1, n = g4 & 1, col = 256 * u.pn + 128 * bj + 32 * wc + 8 * fq + 4 * n;
                const f32x4 w0 = *(const f32x4*)(cw + col), w1 = *(const f32x4*)(cw + GCONV + col), w2 = *(const f32x4*)(cw + 2 * GCONV + col), w3 = *(const f32x4*)(cw + 3 * GCONV + col);
                asm volatile("" :: "v"(w0), "v"(w1), "v"(w2), "v"(w3));
#pragma unroll
                for (int ai = 0; ai < 2; ++ai) {
                    f32x4 p = exch_prev(ex, ai, wid, wr, g4, fr, fq);
#pragma unroll
                    for (int m = 0; m < 4; ++m) {
                        const int R = 128 * ai + 64 * wr + 16 * m + fr, row = row0 + R;
                        const float rsv = rs[ai][m]; const f32x4 c = acc[ai][bj][m][n] * rsv;
                        const int b = row / TP, pos = row - b * TP;
                        const float m1 = pos >= 1 ? 1.f : 0.f, m2 = pos >= 2 ? 1.f : 0.f, m3 = pos >= 3 ? 1.f : 0.f;
                        f32x4 o;
#pragma unroll
                        for (int j = 0; j < 4; ++j) {
                            const float s1 = dpp_shift<1>(c[j], p[j]) * m1, s2 = dpp_shift<2>(c[j], p[j]) * m2, s3 = dpp_shift<3>(c[j], p[j]) * m3;
                            o[j] = siluf_(w3[j] * c[j] + w2[j] * s1 + w1[j] * s2 + w0[j] * s3);
                        }
                        if (R >= lo && row < ROWS_P) {
                            u32x2 w; w.x = pk2(o[0], o[1]); w.y = pk2(o[2], o[3]);
                            *(u32x2*)(QKV + (size_t)row * GCONV + col) = w;
                            if (pos >= TP - 3) *(f32x4*)(pg + (size_t)(b * 3 + pos - (TP - 3)) * GCONV + col) = c;
                        }
                        p = c;
                    }
                }
            }
        } else if (u.pn < 12) {
#pragma unroll
            for (int g4 = 0; g4 < 4; ++g4) {
                const int bj = g4 >> 1, n = g4 & 1, col = 256 * u.pn + 128 * bj + 32 * wc + 8 * fq + 4 * n;
                const f32x4 w0 = *(const f32x4*)(cw + col), w1 = *(const f32x4*)(cw + GCONV + col), w2 = *(const f32x4*)(cw + 2 * GCONV + col), w3 = *(const f32x4*)(cw + 3 * GCONV + col);
#pragma unroll
                for (int m = 0; m < 4; ++m) {
                    const int s = 64 * wr + 16 * m + fr, row = row0 + s;
                    const float rsv = rs[0][m]; const f32x4 c = acc[0][bj][m][n] * rsv;
                    const float* sp = st + (size_t)(s * 3) * GCONV + col;
                    const f32x4 t0 = *(const f32x4*)sp, t1 = *(const f32x4*)(sp + GCONV), t2 = *(const f32x4*)(sp + 2 * GCONV);
                    f32x4 o;
#pragma unroll
                    for (int j = 0; j < 4; ++j) o[j] = siluf_(w3[j] * c[j] + w2[j] * t2[j] + w1[j] * t1[j] + w0[j] * t0[j]);
                    u32x2 w; w.x = pk2(o[0], o[1]); w.y = pk2(o[2], o[3]);
                    *(u32x2*)(QKV + (size_t)row * GCONV + col) = w;
                    float* d = sg + (size_t)(s * 3) * GCONV + col;
                    *(f32x4*)d = t1; *(f32x4*)(d + GCONV) = t2; *(f32x4*)(d + 2 * GCONV) = c;
                }
            }
        } else {
#pragma unroll
            for (int ai = 0; ai < 2; ++ai)
#pragma unroll
                for (int m = 0; m < 4; ++m) {
                    const int R = 128 * ai + 64 * wr + 16 * m + fr, row = row0 + R;
                    const bool valid = sample ? (ai == 0) : (R >= lo && row < ROWS_P);
                    const float rsv = rs[ai][m];
                    if (!valid) continue;
                    if (u.pn < 16) {
#pragma unroll
                        for (int bj = 0; bj < 2; ++bj) {
                            const f32x4 c0 = acc[ai][bj][m][0] * rsv, c1 = acc[ai][bj][m][1] * rsv;
                            u32x4 w; w.x = pk2(c0[0], c0[1]); w.y = pk2(c0[2], c0[3]); w.z = pk2(c1[0], c1[1]); w.w = pk2(c1[2], c1[3]);
                            *(u32x4*)(GATE + (size_t)row * DM + 256 * (u.pn - 12) + 128 * bj + 32 * wc + 8 * fq) = w;
                        }
                    } else if (wc == 0 && fq < 2) {
                        *(f32x4*)(AB + (size_t)row * 16 + 8 * fq) = acc[ai][0][m][0] * rsv;
                        *(f32x4*)(AB + (size_t)row * 16 + 8 * fq + 4) = acc[ai][0][m][1] * rsv;
                    }
                }
        }
    }
};
#ifdef SEG_ID
#define SEGT(i) do { __builtin_amdgcn_sched_barrier(0); if (F.vcu == SEG_BLOCK && F.tid == 0) { const unsigned long long t_ = __builtin_amdgcn_s_memrealtime(); volatile LAS unsigned long long* a_ = (volatile LAS unsigned long long*)(F.lds + LDSCTL_OFF + 64); \
    if ((i) == SEG_ID) a_[1] = t_; if ((i) == SEG_ID + 1) a_[0] += t_ - a_[1]; } __builtin_amdgcn_sched_barrier(0); } while (0)
#else
#define SEGT(i) do {} while (0)
#endif

__device__ __forceinline__ void tr_item(const float* W, int ldw, int K, bf16* WT, int n0, int src0, int nvalid, int k0, const float* scale, LAS float* scr, int lane) {
    const int j = lane & 31;
    float tv[32];
    const int jc = (j < nvalid) ? j : 0; const float jm = (j < nvalid) ? 1.f : 0.f;
#pragma unroll
    for (int i = 0; i < 32; ++i) { const int kk = 2 * i + (lane >> 5); tv[i] = W[(size_t)(k0 + kk) * ldw + src0 + jc]; }
    if (scale) {
        float sc[32];
#pragma unroll
        for (int i = 0; i < 32; ++i) sc[i] = scale[k0 + 2 * i + (lane >> 5)];
#pragma unroll
        for (int i = 0; i < 32; ++i) tv[i] *= sc[i];
    }
#pragma unroll
    for (int i = 0; i < 32; ++i) { const int kk = 2 * i + (lane >> 5); scr[kk * 33 + j] = tv[i] * jm; }
    LDS_WAIT(); asm volatile("" ::: "memory");
    const int c = lane & 7;
#pragma unroll
    for (int jj = 0; jj < 4; ++jj) { const int n = (lane >> 3) + 8 * jj; const LAS float* s = scr + (8 * c) * 33 + n;
        u32x4 o; o.x = pk2(s[0 * 33], s[1 * 33]); o.y = pk2(s[2 * 33], s[3 * 33]); o.z = pk2(s[4 * 33], s[5 * 33]); o.w = pk2(s[6 * 33], s[7 * 33]);
        *(u32x4*)(WT + (size_t)(n0 + n) * K + k0 + 8 * c) = o; }
    LDS_WAIT(); asm volatile("" ::: "memory");
}
__device__ __forceinline__ int glu_src(int n0, int half_stride) { const int pn = n0 >> 8, bj = (n0 >> 7) & 1, cc0 = n0 & 127; return bj * half_stride + 128 * pn + cc0; }

__device__ __forceinline__ void p0_s5_group(Frame& F, int g, int qtr) {
    const float* lam_re = F.in[11]; const float* lam_im = F.in[12]; const float* log_step = F.in[13];
    const float* b_re = F.in[14]; const float* b_im = F.in[15]; const float* c_re = F.in[16]; const float* c_im = F.in[17]; const float* dsk = F.in[18];
    LAS float* LP = (LAS float*)(F.lds);
    LAS float* BB = (LAS float*)(F.lds + 8704);
    LAS float* CC = (LAS float*)(F.lds + 16896);
    LAS float* KT = (LAS float*)(F.lds + 25088);
    const float dl = __expf(log_step[g]);
    for (int idx = F.tid; idx < 17 * 64; idx += 512) { const int n = idx >> 6, p = idx & 63;
        const float lre = lam_re[g * 64 + p], lim = lam_im[g * 64 + p];
        const float mag = expf((float)n * dl * lre); float sn, cs; sincosf((float)n * dl * lim, &sn, &cs);
        LP[idx * 2] = mag * cs; LP[idx * 2 + 1] = mag * sn; }
    for (int idx = F.tid; idx < 16 * 64; idx += 512) { const int c = idx >> 6, p = idx & 63; CC[idx * 2] = c_re[(g * 16 + c) * 64 + p]; CC[idx * 2 + 1] = c_im[(g * 16 + c) * 64 + p]; }
    __syncthreads();
    for (int idx = F.tid; idx < 64 * 16; idx += 512) { const int p = idx >> 4;
        const float lre = lam_re[g * 64 + p], lim = lam_im[g * 64 + p];
        const float nr = LP[(64 + p) * 2] - 1.f, ni = LP[(64 + p) * 2 + 1], den = 1.f / (lre * lre + lim * lim);
        const float qr = (nr * lre + ni * lim) * den, qi = (ni * lre - nr * lim) * den;
        const float br = b_re[(size_t)g * 1024 + idx], bi = b_im[(size_t)g * 1024 + idx];
        BB[idx * 2] = qr * br - qi * bi; BB[idx * 2 + 1] = qr * bi + qi * br; }
    __syncthreads();
    for (int idx = F.tid; idx < 1024; idx += 512) { const int tau = idx >> 6, c = 4 * qtr + ((idx >> 4) & 3), c2 = idx & 15; float s = 0.f;
        for (int p = 0; p < 64; ++p) { const float cr = CC[(c * 64 + p) * 2], ci = CC[(c * 64 + p) * 2 + 1], lr = LP[(tau * 64 + p) * 2], li = LP[(tau * 64 + p) * 2 + 1];
            const float tr = cr * lr - ci * li, ti = cr * li + ci * lr, br = BB[(p * 16 + c2) * 2], bi = BB[(p * 16 + c2) * 2 + 1];
            s += tr * br - ti * bi; }
        KT[(tau * 16 + c) * 16 + c2] = s; }
    __syncthreads();
    float* misc = (float*)(F.ws + WS_MISC);
    if (qtr == 0) for (int idx = F.tid; idx < 64; idx += 512) { misc[(g * 64 + idx) * 2] = LP[(16 * 64 + idx) * 2]; misc[(g * 64 + idx) * 2 + 1] = LP[(16 * 64 + idx) * 2 + 1];
        misc[8192 + (g * 64 + idx) * 2] = LP[(64 + idx) * 2]; misc[8192 + (g * 64 + idx) * 2 + 1] = LP[(64 + idx) * 2 + 1]; }
    if (qtr == 0) for (int idx = F.tid; idx < 2048; idx += 512) misc[32768 + g * 2048 + idx] = BB[idx];
    unsigned* wg = (unsigned*)(F.ws + WS_S5M + (size_t)g * S5M_G);
    for (int idx = qtr * 4096 + F.tid; idx < (qtr + 1) * 4096; idx += 512) { const int pp = idx >> 7, k = 2 * (idx & 127), s = k >> 4, c2 = k & 15, p = pp >> 1;
        const float lr = LP[((15 - s) * 64 + p) * 2], li = LP[((15 - s) * 64 + p) * 2 + 1];
        float v[2];
#pragma unroll
        for (int e = 0; e < 2; ++e) { const float br = BB[(p * 16 + c2 + e) * 2], bi = BB[(p * 16 + c2 + e) * 2 + 1]; v[e] = (pp & 1) ? (lr * bi + li * br) : (lr * br - li * bi); }
        wg[idx] = pk2(v[0], v[1]); }
    unsigned* tv = (unsigned*)(F.ws + WS_S5M + (size_t)g * S5M_G + S5M_WG);
    for (int idx = F.tid; idx < 12288; idx += 512) { const int nl = idx / 192, k = 2 * (idx - nl * 192), t = nl >> 2, c = 4 * qtr + (nl & 3), n = 16 * t + c;
        float v0, v1;
        if (k < 256) { const int s = k >> 4, c2 = k & 15;
            if (s <= t) { v0 = KT[((t - s) * 16 + c) * 16 + c2]; v1 = KT[((t - s) * 16 + c) * 16 + c2 + 1];
                if (s == t) { const float dd = dsk[g * 16 + c]; if (c2 == c) v0 += dd; if (c2 + 1 == c) v1 += dd; } }
            else { v0 = 0.f; v1 = 0.f; } }
        else { const int p = (k - 256) >> 1; const float cr = CC[(c * 64 + p) * 2], ci = CC[(c * 64 + p) * 2 + 1], lr = LP[((t + 1) * 64 + p) * 2], li = LP[((t + 1) * 64 + p) * 2 + 1];
            v0 = cr * lr - ci * li; v1 = -(cr * li + ci * lr); }
        tv[n * 192 + (k >> 1)] = pk2(v0, v1); }
    __syncthreads();
}

__device__ __forceinline__ void p0_weights(Frame& F, int set, int gw, int NGW) {
    LAS float* scr = (LAS float*)(F.lds + F.wave * 8704);
    const int I_GLU = 16 * 64, I_UP = 16 * 176, I_DN = 44 * 32, I_IN = 16 * 136, I_O = 16 * 32;
    if (set == 0) {
        const int NIT = I_GLU + I_UP + I_DN + I_IN;
        for (int it = gw; it < NIT; it += NGW) {
            int r = it;
            if (r < I_GLU) { const int kb = r / 64, nb = r % 64, n0 = 32 * nb; tr_item(F.in[19], 2048, DM, (bf16*)(F.ws + WS_WGLU), n0, glu_src(n0, 1024), 32, 64 * kb, nullptr, scr, F.lane); continue; } r -= I_GLU;
            if (r < I_UP) { const int kb = r / 176, nb = r % 176, n0 = 32 * nb; tr_item(F.in[26], UPN, DM, (bf16*)(F.ws + WS_WUP0), n0, glu_src(n0, DFF), 32, 64 * kb, F.in[9], scr, F.lane); continue; } r -= I_UP;
            if (r < I_DN) { const int kb = r / 32, nb = r % 32, n0 = 32 * nb; tr_item(F.in[28], DM, DFF, (bf16*)(F.ws + WS_WDN0), n0, n0, 32, 64 * kb, nullptr, scr, F.lane); continue; } r -= I_DN;
            { const int kb = r / 136, nb = r % 136, n0 = 32 * nb; int nv = GIN - n0; nv = nv < 0 ? 0 : (nv > 32 ? 32 : nv);
              tr_item(F.in[20], GIN, DM, (bf16*)(F.ws + WS_WIN), n0, n0, nv, 64 * kb, F.in[8] + DM, scr, F.lane); }
        }
    } else {
        const int NIT = I_O + I_UP + I_DN;
        for (int it = gw; it < NIT; it += NGW) {
            int r = it;
            if (r < I_O) { const int kb = r / 32, nb = r % 32, n0 = 32 * nb; tr_item(F.in[25], DM, DM, (bf16*)(F.ws + WS_WO), n0, n0, 32, 64 * kb, nullptr, scr, F.lane); continue; } r -= I_O;
            if (r < I_UP) { const int kb = r / 176, nb = r % 176, n0 = 32 * nb; tr_item(F.in[26] + (size_t)DM * UPN, UPN, DM, (bf16*)(F.ws + WS_WUP1), n0, glu_src(n0, DFF), 32, 64 * kb, F.in[9] + DM, scr, F.lane); continue; } r -= I_UP;
            { const int kb = r / 32, nb = r % 32, n0 = 32 * nb; tr_item(F.in[28] + (size_t)DFF * DM, DM, DFF, (bf16*)(F.ws + WS_WDN1), n0, n0, 32, 64 * kb, nullptr, scr, F.lane); }
        }
    }
}

__device__ __forceinline__ void p0_prologue(Frame& F) {
    SEGT(0);
    if (F.G == 256) p0_s5_group(F, F.vcu >> 2, F.vcu & 3);
    else for (int u = F.vcu; u < 256; u += F.G) p0_s5_group(F, u >> 2, u & 3);
    SEGT(1);
    const int gw = F.vcu * NWAVES + F.wave, NGW = F.G * NWAVES;
    { const float* nw = F.in[8]; bf16* U = (bf16*)(F.ws + WS_BIG); float* HS = (float*)(F.ws + WS_HS);
      f32x4 nv[4];
#pragma unroll
      for (int j = 0; j < 4; ++j) nv[j] = *(const f32x4*)(nw + 4 * F.lane + 256 * j);
      f32x4 vnx[4];
      if (gw < ROWS) { const float* xr = xin_ptr(F.in[0], F.in[1], F.in[7], gw);
#pragma unroll
        for (int j = 0; j < 4; ++j) vnx[j] = *(const f32x4*)(xr + 4 * F.lane + 256 * j); }
      for (int row = gw; row < ROWS; row += NGW) {
        f32x4 v[4]; float s = 0.f;
#pragma unroll
        for (int j = 0; j < 4; ++j) v[j] = vnx[j];
        if (row + NGW < ROWS) { const float* xr = xin_ptr(F.in[0], F.in[1], F.in[7], row + NGW);
#pragma unroll
            for (int j = 0; j < 4; ++j) vnx[j] = *(const f32x4*)(xr + 4 * F.lane + 256 * j); }
#pragma unroll
        for (int j = 0; j < 4; ++j) s += (v[j].x * v[j].x + v[j].y * v[j].y) + (v[j].z * v[j].z + v[j].w * v[j].w);
        const float r = 1.f / sqrtf(wave_sum(s) * (1.f / DM) + EPS);
        if (row < ROWS_P) {
#pragma unroll
            for (int j = 0; j < 4; ++j) { const f32x4 h = v[j] * r * nv[j];
                u32x2 w; w.x = pk2(h.x, h.y); w.y = pk2(h.z, h.w);
                *(u32x2*)(U + (size_t)row * DM + 4 * F.lane + 256 * j) = w; } }
        else {
#pragma unroll
            for (int j = 0; j < 4; ++j) *(f32x4*)(HS + (size_t)(row - ROWS_P) * DM + 4 * F.lane + 256 * j) = v[j] * r * nv[j]; }
      } }
    SEGT(2);
    p0_weights(F, 0, gw, NGW);
    SEGT(3);
}

#define MFMA16(a, b, c) __builtin_amdgcn_mfma_f32_16x16x32_bf16((a), (b), (c), 0, 0, 0)
constexpr int S5_UST = 528, S5_HL = 68608;
__device__ __forceinline__ void s5_prompt_item(Frame& F, int b, int g) {
    SEGT(10);
    LAS unsigned char* UT = F.lds; LAS unsigned char* HL = F.lds + S5_HL;
    const int fr = F.lane & 15, fq = F.lane >> 4, w = F.wave;
    { const unsigned char* src = F.ws + WS_BIG + ((size_t)(b * TP) * DM + 16 * g) * 2;
      for (int piece = F.tid; piece < TP * 2; piece += 512) { const int r = piece >> 1, hf = piece & 1;
          *(LAS u32x4*)(UT + (r >> 4) * S5_UST + (r & 15) * 32 + hf * 16) = *(const u32x4*)(src + (size_t)r * (DM * 2) + hf * 16); } }
    __syncthreads();
    SEGT(11);
    const unsigned char* wg = F.ws + WS_S5M + (size_t)g * S5M_G; const unsigned char* tv = wg + S5M_WG;
    {
        bf16x8 af[8];
#pragma unroll
        for (int ks = 0; ks < 8; ++ks) af[ks] = *(const bf16x8*)(wg + ((size_t)(16 * w + fr) * 256 + 32 * ks + 8 * fq) * 2);
        for (int jt = 0; jt < 9; ++jt) { const int chunk = 16 * jt + fr, cr = chunk < S5NCH ? chunk : S5NCH - 1;
            f32x4 acc = (f32x4){0.f, 0.f, 0.f, 0.f};
#pragma unroll
            for (int ks = 0; ks < 8; ++ks) acc = MFMA16(af[ks], *(const LAS bf16x8*)(UT + cr * S5_UST + (32 * ks + 8 * fq) * 2), acc);
            if (chunk < S5NCH) *(LAS f32x4*)(HL + chunk * 512 + (16 * w + 4 * fq) * 4) = acc; }
    }
    __syncthreads();
    SEGT(12);
    {
        const int p = F.lane, c0 = 16 * w, nc = (w == 7) ? 17 : 16; const float* misc = (const float*)(F.ws + WS_MISC);
        const float lr = misc[(g * 64 + p) * 2], li = misc[(g * 64 + p) * 2 + 1];
        f32x2 hv[17];
#pragma unroll
        for (int e = 0; e < 17; ++e) { const int c = (e < nc) ? c0 + e : c0; hv[e] = *(const LAS f32x2*)(HL + c * 512 + 8 * p); }
        f32x2 loc[17]; float tr = 0.f, ti = 0.f, pr = 1.f, pi = 0.f;
#pragma unroll
        for (int e = 0; e < 17; ++e) { loc[e] = (f32x2){tr, ti};
            if (e < nc) { const float nr = lr * tr - li * ti + hv[e].x, ni = lr * ti + li * tr + hv[e].y; tr = nr; ti = ni;
                const float qr = lr * pr - li * pi, qi = lr * pi + li * pr; pr = qr; pi = qi; } }
        LAS float* XT = (LAS float*)(HL + S5NCH * 512);
        *(LAS f32x4*)(XT + (w * 64 + p) * 4) = (f32x4){tr, ti, pr, pi};
        __syncthreads();
        float cr = 0.f, ci = 0.f;
        for (int v = 0; v < w; ++v) { const f32x4 x = *(const LAS f32x4*)(XT + (v * 64 + p) * 4);
            const float nr = x.z * cr - x.w * ci + x.x, ni = x.z * ci + x.w * cr + x.y; cr = nr; ci = ni; }
        float wr_ = 1.f, wi_ = 0.f;
#pragma unroll
        for (int e = 0; e < 17; ++e) {
            if (e < nc) { const int c = c0 + e; const float sr = loc[e].x + wr_ * cr - wi_ * ci, si = loc[e].y + wr_ * ci + wi_ * cr;
                *(LAS unsigned*)(HL + c * 512 + (((p >> 2) ^ (c & 15)) * 16) + (p & 3) * 4) = pk2(sr, si);
                const float qr = lr * wr_ - li * wi_, qi = lr * wi_ + li * wr_; wr_ = qr; wi_ = qi; } }
        if (w == 7) { const float fr_ = tr + wr_ * cr - wi_ * ci, fi_ = ti + wr_ * ci + wi_ * cr;
            F.out[O_PS5RE + (size_t)(b * 64 + g) * 64 + p] = fr_; F.out[O_PS5IM + (size_t)(b * 64 + g) * 64 + p] = fi_; }
    }
    __syncthreads();
    SEGT(13);
    {
        bf16x8 af[2][12];
#pragma unroll
        for (int il = 0; il < 2; ++il)
#pragma unroll
            for (int ks = 0; ks < 12; ++ks) af[il][ks] = *(const bf16x8*)(tv + ((size_t)(16 * (2 * w + il) + fr) * 384 + 32 * ks + 8 * fq) * 2);
        bf16* A1 = (bf16*)(F.ws + WS_B2);
#pragma unroll 3
        for (int jt = 0; jt < 9; ++jt) { const int chunk = 16 * jt + fr, cr = chunk < S5NCH ? chunk : S5NCH - 1;
            bf16x8 bfr[12];
#pragma unroll
            for (int ks = 0; ks < 8; ++ks) bfr[ks] = *(const LAS bf16x8*)(UT + cr * S5_UST + (32 * ks + 8 * fq) * 2);
#pragma unroll
            for (int ks = 0; ks < 4; ++ks) bfr[8 + ks] = *(const LAS bf16x8*)(HL + cr * 512 + (((4 * ks + fq) ^ (cr & 15)) * 16));
#pragma unroll
            for (int il = 0; il < 2; ++il) { f32x4 acc = (f32x4){0.f, 0.f, 0.f, 0.f};
#pragma unroll
                for (int ks = 0; ks < 12; ++ks) acc = MFMA16(af[il][ks], bfr[ks], acc);
                if (chunk < S5NCH) { u32x2 o; o.x = pk2(gelu_tanh(acc[0]), gelu_tanh(acc[1])); o.y = pk2(gelu_tanh(acc[2]), gelu_tanh(acc[3]));
                    *(u32x2*)(A1 + (size_t)(b * TP + chunk * 16 + 2 * w + il) * DM + 16 * g + 4 * fq) = o; } } }
    }
    __syncthreads();
    SEGT(14);
}
__device__ __forceinline__ void p1_s5(Frame& F) {
    for (int it = F.vcu; it < NB * S5G; it += F.G) s5_prompt_item(F, it >> 6, it & 63);
    SEGT(15);
    const int gw = F.vcu * NWAVES + F.wave, NGW = F.G * NWAVES, p = F.lane;
    const float* misc = (const float*)(F.ws + WS_MISC); const float* HS = (const float*)(F.ws + WS_HS); bf16* A1 = (bf16*)(F.ws + WS_B2);
    const float* c_re = F.in[16]; const float* c_im = F.in[17]; const float* dsk = F.in[18];
    for (int it = gw; it < NS * S5G; it += NGW) { const int s = it >> 6, g = it & 63;
        float u[16];
#pragma unroll
        for (int j = 0; j < 16; ++j) u[j] = ldv_f32(HS + (size_t)s * DM + 16 * g + j);
        const size_t si = (size_t)(s * 64 + g) * 64 + p;
        const float h0r = F.in[2][si], h0i = F.in[3][si], lr = misc[8192 + (g * 64 + p) * 2], li = misc[8192 + (g * 64 + p) * 2 + 1];
        float hr = lr * h0r - li * h0i, hi = lr * h0i + li * h0r;
        const float* bb = misc + 32768 + (size_t)(g * 64 + p) * 32;
#pragma unroll
        for (int j = 0; j < 8; ++j) { const f32x4 t = *(const f32x4*)(bb + 4 * j); hr += t.x * u[2 * j] + t.z * u[2 * j + 1]; hi += t.y * u[2 * j] + t.w * u[2 * j + 1]; }
        F.out[O_SS5RE + si] = hr; F.out[O_SS5IM + si] = hi;
        LAS float* hb = (LAS float*)(F.lds + F.wave * 512);
        *(LAS f32x2*)(hb + 2 * p) = (f32x2){hr, hi};
        { const int c = p & 15, pq = p >> 4; const float* cr = c_re + (size_t)(g * 16 + c) * 64 + 16 * pq; const float* ci = c_im + (size_t)(g * 16 + c) * 64 + 16 * pq;
          float acc = 0.f;
#pragma unroll
          for (int j = 0; j < 4; ++j) { const f32x4 a = *(const f32x4*)(cr + 4 * j), b = *(const f32x4*)(ci + 4 * j);
              const f32x4 h0 = *(const LAS f32x4*)(hb + 2 * (16 * pq + 4 * j)), h1 = *(const LAS f32x4*)(hb + 2 * (16 * pq + 4 * j) + 4);
              acc += a.x * h0.x - b.x * h0.y + a.y * h0.z - b.y * h0.w + a.z * h1.x - b.z * h1.y + a.w * h1.z - b.w * h1.w; }
          acc += __shfl_xor(acc, 16); acc += __shfl_xor(acc, 32);
          if (p < 16) { const float y = acc + dsk[16 * g + p] * HS[(size_t)s * DM + 16 * g + p];
              A1[(size_t)(ROWS_P + s) * DM + 16 * g + p] = (bf16)f2bf(gelu_tanh(y)); } }
    }
    SEGT(16);
}

struct Slot { unsigned char* base; int stride; };
__device__ __forceinline__ Slot gdn_slot(unsigned char* ws, int bh, int c, int which) {
    Slot s;
    if (c == 0) { s.base = ws + WS_C0 + (size_t)((bh & 7) * 3 + which) * 16384; s.stride = 256; }
    else { const int b = bh >> 3, h = bh & 7; s.base = ws + WS_BIG + ((size_t)(b * TP + NMETA + 64 * (c - 1)) * GCONV + which * 1024 + 128 * h) * 2; s.stride = GCONV * 2; }
    return s;
}
__device__ __forceinline__ int gdn_row(int b, int c, int i) { return c == 0 ? (i >= GNULL ? b * TP + i - GNULL : -1) : b * TP + NMETA + 64 * (c - 1) + i; }
__device__ __forceinline__ float softplusf_(float x) { return x > 20.f ? x : log1pf(__expf(x)); }
__device__ __forceinline__ bf16x8 mk8(u32x2 lo, u32x2 hi) { u32x4 t; t.x = lo.x; t.y = lo.y; t.z = hi.x; t.w = hi.y; return __builtin_bit_cast(bf16x8, t); }
__device__ __forceinline__ float sq8(bf16x8 v) { const u32x4 t = __builtin_bit_cast(u32x4, v); float s = 0.f;
#pragma unroll
    for (int e = 0; e < 4; ++e) { const float a = bflo(t[e]), b = bfhi(t[e]); s += a * a + b * b; } return s; }

__device__ __forceinline__ f32x4 ld4bf(const void* p) { const u32x2 v = *(const u32x2*)p; return (f32x4){bflo(v.x), bfhi(v.x), bflo(v.y), bfhi(v.y)}; }
__device__ __forceinline__ bf16x8 pack2(const f32x4& a, const f32x4& b) { u32x2 lo, hi; lo.x = pk2(a[0], a[1]); lo.y = pk2(a[2], a[3]); hi.x = pk2(b[0], b[1]); hi.y = pk2(b[2], b[3]); return mk8(lo, hi); }
__device__ __forceinline__ float dot4_asm(float a0, float a1, float a2, float a3, const f32x4& v) {
    float t;
    asm("v_mul_f32 %0, %1, %2" : "=v"(t) : "v"(a0), "v"(v.x));
    asm("v_fmac_f32 %0, %1, %2" : "+v"(t) : "v"(a1), "v"(v.y));
    asm("v_fmac_f32 %0, %1, %2" : "+v"(t) : "v"(a2), "v"(v.z));
    asm("v_fmac_f32 %0, %1, %2" : "+v"(t) : "v"(a3), "v"(v.w));
    return t;
}
#ifdef P6_SEG
#define P6S(i) do { if (!C0) { __builtin_amdgcn_sched_barrier(0); const unsigned long long t_ = __builtin_amdgcn_s_memrealtime(); \
    if ((i) == P6_SEG) p6_t0 = t_; if ((i) == P6_SEG + 1) { if (blockIdx.x == 3 && F.wave == 0 && l == 0) *(volatile LAS unsigned long long*)(F.lds + LDSCTL_OFF + 64) += t_ - p6_t0; } __builtin_amdgcn_sched_barrier(0); } } while (0)
#else
#define P6S(i) do {} while (0)
#endif
template <bool C0> __device__ __forceinline__ void p6_item(Frame& F, int bh, int c, LAS unsigned char* wl) {
    constexpr int R0 = C0 ? 3 : 0;
    const int item = bh * GNCH + c;
    unsigned long long p6_t0 = 0;
    int l_ = F.lane; asm volatile("" : "+v"(l_));
    const int b = bh >> 3, h = bh & 7, l = l_, fr = l & 15, fq = l >> 4;
    LAS float* LmT = (LAS float*)wl; LAS float* SC = (LAS float*)(wl + 16384);
    LAS unsigned char* TM = wl; LAS unsigned char* AT = wl + 8192;
    const f32x4 z4 = (f32x4){0.f, 0.f, 0.f, 0.f};
    const bf16x8 zf = (bf16x8){0, 0, 0, 0, 0, 0, 0, 0};
    const int rb0 = C0 ? b * TP - GNULL : b * TP + NMETA + 64 * (c - 1);
    const unsigned char* qkvu = F.ws + WS_BIG + ((size_t)rb0 * GCONV + 128 * h) * 2;
    const Slot qs = gdn_slot(F.ws, bh, c, 0), ksl = gdn_slot(F.ws, bh, c, 1), vsl = gdn_slot(F.ws, bh, c, 2);
    unsigned char* wxu = F.ws + WS_WX + (size_t)item * 16384;
    constexpr int ONS = C0 ? 256 : DM * 2;
    unsigned char* onu = C0 ? F.ws + WS_OL0 + (size_t)h * 16384 : (unsigned char*)(F.out + O_YP) + ((size_t)rb0 * DM + 128 * h) * 2;
    const unsigned vo_f = (unsigned)(fr * (GCONV * 2) + fq * 16);
    const unsigned vo_q = (unsigned)(fr * (GCONV * 2) + fq * 8);
    const unsigned vo_u = (unsigned)((fr >> 1) * ksl.stride + (fr & 1) * 128 + fq * 8);
    const unsigned vo_t = (unsigned)((fr >> 1) * ksl.stride + (fr & 1) * 128 + fq * 16);
    const unsigned vo_p = (unsigned)(fr * qs.stride + fq * 16);
    const unsigned vo_w = (unsigned)(fr * 256 + fq * 16);
    const unsigned vo_o = (unsigned)(fr * ONS + fq * 8);
#define P6_RTV(rt) (!C0 || (rt) == 3)
    if (C0) {
        const u32x4 z = (u32x4){0u, 0u, 0u, 0u};
#pragma unroll 4
        for (int q = 0; q < 16; ++q) { *(u32x4*)(qs.base + (q * 64 + l) * 16) = z; *(u32x4*)(ksl.base + (q * 64 + l) * 16) = z; *(u32x4*)(vsl.base + (q * 64 + l) * 16) = z; *(u32x4*)(wxu + (q * 64 + l) * 16) = z; }
    }
#pragma unroll
    for (int q = 0; q < 16; ++q) *(LAS f32x4*)(wl + (q * 64 + l) * 16) = z4;
    P6S(0);
    float gl;
    { const bool rv = !C0 || (l >= GNULL); float g = 0.f, be = 0.f;
      if (rv) { const float* ab = (const float*)(F.ws + WS_AB) + (size_t)(rb0 + l) * 16; const float a = ab[h], bq = ab[8 + h];
          g = -__expf(F.in[22][h]) * softplusf_(a + F.in[23][h]); be = sigmoidf_(bq); }
      float gc = g;
#pragma unroll
      for (int o = 1; o < 64; o <<= 1) { const float t = __shfl_up(gc, o); if (l >= o) gc += t; }
      gl = __shfl(gc, 63);
      SC[l] = gc; SC[64 + l] = be; }
    {
        bf16x8 kf[4][4];
#pragma unroll
        for (int rt = 0; rt < R0; ++rt) { if (fq == 0) SC[128 + 16 * rt + fr] = 1000.f; }
#pragma unroll
        for (int rt = R0; rt < 4; ++rt) {
#pragma unroll
            for (int ks = 0; ks < 4; ++ks) kf[rt][ks] = *(const bf16x8*)(qkvu + (size_t)(rt * 16 * GCONV * 2 + 2048 + ks * 64) + vo_f);
            float sk = 0.f;
#pragma unroll
            for (int ks = 0; ks < 4; ++ks) sk += sq8(kf[rt][ks]);
            sk += __shfl_xor(sk, 16); sk += __shfl_xor(sk, 32);
            if (fq == 0) SC[128 + 16 * rt + fr] = 1.f / sqrtf(sk + 1e-6f); }
#pragma unroll
        for (int it = R0; it < 4; ++it) {
            const f32x4 gci = *(const LAS f32x4*)(SC + 16 * it + 4 * fq), bei = *(const LAS f32x4*)(SC + 64 + 16 * it + 4 * fq), rki = *(const LAS f32x4*)(SC + 128 + 16 * it + 4 * fq);
#pragma unroll
            for (int jt = R0; jt <= it; ++jt) {
                f32x4 dk = z4;
#pragma unroll
                for (int ks = 0; ks < 4; ++ks) dk = MFMA16(kf[it][ks], kf[jt][ks], dk);
                const int j = 16 * jt + fr; const float gcj = SC[j], rkj = SC[128 + j];
                f32x4 lm;
#pragma unroll
                for (int r = 0; r < 4; ++r) { const int i = 16 * it + 4 * fq + r; lm[r] = (j < i) ? bei[r] * rki[r] * __expf(gci[r] - gcj) * rkj * dk[r] : 0.f; }
                *(LAS f32x4*)(LmT + j * 64 + 16 * it + 4 * fq) = lm;
            } }
    }
    P6S(1);
    __builtin_amdgcn_sched_barrier(0);
    {
        f32x2 r2[32];
#pragma unroll
        for (int j = 0; j < 32; ++j) r2[j] = (f32x2){0.f, 0.f};
#pragma unroll
        for (int j = 16 * R0 - 1; j >= 0; --j) r2[j >> 1][j & 1] = (l == j) ? 1.f : 0.f;
#pragma unroll
        for (int j = 63; j >= 16 * R0; --j) { f32x2 acc = (f32x2){(l == j) ? 1.f : 0.f, 0.f};
#pragma unroll
            for (int kg = ((j + 1) & ~3); kg < 64; kg += 4) { const f32x4 v = *(const LAS f32x4*)(LmT + j * 64 + kg);
                acc -= r2[kg >> 1] * (f32x2){v.x, v.y}; acc -= r2[(kg >> 1) + 1] * (f32x2){v.z, v.w}; }
            r2[j >> 1][j & 1] = acc.x + acc.y; }
        float r[64];
#pragma unroll
        for (int j = 0; j < 64; ++j) r[j] = r2[j >> 1][j & 1];
#pragma unroll
        for (int c8 = 0; c8 < 8; ++c8) { u32x4 o; o.x = pk2(r[8 * c8], r[8 * c8 + 1]); o.y = pk2(r[8 * c8 + 2], r[8 * c8 + 3]); o.z = pk2(r[8 * c8 + 4], r[8 * c8 + 5]); o.w = pk2(r[8 * c8 + 6], r[8 * c8 + 7]);
            *(LAS u32x4*)(TM + l * 128 + c8 * 16) = o; }
    }
    __builtin_amdgcn_sched_barrier(0);
    P6S(2);
    bf16x8 sel[2];
#pragma unroll
    for (int hf = 0; hf < 2; ++hf) {
#pragma unroll
        for (int jj = 0; jj < 8; ++jj) sel[hf][jj] = (8 * fq + jj == 16 * hf + fr) ? (short)0x3F80 : (short)0; }
    bf16x8 tmF[4][2], atF[4][2];
    {
#pragma unroll
        for (int q = 0; q < 8; ++q) *(LAS u32x4*)(AT + (q * 64 + l) * 16) = (u32x4){0u, 0u, 0u, 0u};
        bf16x8 kf[4][4];
#pragma unroll
        for (int rt = R0; rt < 4; ++rt)
#pragma unroll
            for (int ks = 0; ks < 4; ++ks) kf[rt][ks] = *(const bf16x8*)(qkvu + (size_t)(rt * 16 * GCONV * 2 + 2048 + ks * 64) + vo_f);
#pragma unroll
        for (int it = R0; it < 4; ++it) {
            bf16x8 qf[4];
#pragma unroll
            for (int ks = 0; ks < 4; ++ks) qf[ks] = *(const bf16x8*)(qkvu + (size_t)(it * 16 * GCONV * 2 + ks * 64) + vo_f);
            { float sq = 0.f;
#pragma unroll
              for (int ks = 0; ks < 4; ++ks) sq += sq8(qf[ks]);
              sq += __shfl_xor(sq, 16); sq += __shfl_xor(sq, 32);
              if (fq == 0) SC[192 + 16 * it + fr] = 0.08838834764831845f / sqrtf(sq + 1e-6f); }
            const f32x4 gci = *(const LAS f32x4*)(SC + 16 * it + 4 * fq), rqi = *(const LAS f32x4*)(SC + 192 + 16 * it + 4 * fq);
#pragma unroll
            for (int jt = R0; jt <= it; ++jt) {
                f32x4 dq = z4;
#pragma unroll
                for (int ks = 0; ks < 4; ++ks) dq = MFMA16(qf[ks], kf[jt][ks], dq);
                const int j = 16 * jt + fr; const float gcj = SC[j], rkj = SC[128 + j];
                LAS unsigned short* ap = (LAS unsigned short*)(AT + ((16 * it + 4 * fq) * 64 + j) * 2);
#pragma unroll
                for (int r = 0; r < 4; ++r) { const int i = 16 * it + 4 * fq + r; const float aa = (j <= i) ? rqi[r] * __expf(gci[r] - gcj) * rkj * dq[r] : 0.f; ap[64 * r] = (unsigned short)f2bf(aa); }
            } }
        __builtin_amdgcn_sched_barrier(0);
        asm volatile("s_waitcnt vmcnt(0)" ::: "memory");
#pragma unroll
        for (int it = R0; it < 4; ++it)
#pragma unroll
            for (int js = 0; js < 2; ++js) {
                tmF[it][js] = mk8(*(const LAS u32x2*)(TM + (16 * it + fr) * 128 + (32 * js + 4 * fq) * 2), *(const LAS u32x2*)(TM + (16 * it + fr) * 128 + (32 * js + 16 + 4 * fq) * 2));
                atF[it][js] = mk8(*(const LAS u32x2*)(AT + (16 * it + fr) * 128 + (32 * js + 4 * fq) * 2), *(const LAS u32x2*)(AT + (16 * it + fr) * 128 + (32 * js + 16 + 4 * fq) * 2)); }
        P6S(3);
        bf16x8 wA[8][2];
        float qsc[4];
#pragma unroll
        for (int it2 = R0; it2 < 4; ++it2) qsc[it2] = SC[192 + 16 * it2 + fr] * __expf(SC[16 * it2 + fr]);
#pragma unroll
        for (int ks = 0; ks < 4; ++ks)
#pragma unroll
            for (int hf = 0; hf < 2; ++hf) { const int dt = 2 * ks + hf; u32x2 hh[4];
#pragma unroll
                for (int rt = 0; rt < R0; ++rt) hh[rt] = (u32x2){0u, 0u};
#pragma unroll
                for (int rt = R0; rt < 4; ++rt) { const f32x4 d = MFMA16(kf[rt][ks], sel[hf], z4);
                    const f32x4 gci = *(const LAS f32x4*)(SC + 16 * rt + 4 * fq), bei = *(const LAS f32x4*)(SC + 64 + 16 * rt + 4 * fq), rki = *(const LAS f32x4*)(SC + 128 + 16 * rt + 4 * fq);
                    f32x4 sw, sd;
#pragma unroll
                    for (int e = 0; e < 4; ++e) { sw[e] = d[e] * bei[e] * rki[e] * __expf(gci[e]); sd[e] = d[e] * rki[e] * __expf(gl - gci[e]); }
                    hh[rt].x = pk2(sw[0], sw[1]); hh[rt].y = pk2(sw[2], sw[3]);
                    u32x2 kd; kd.x = pk2(sd[0], sd[1]); kd.y = pk2(sd[2], sd[3]);
                    *(u32x2*)(ksl.base + (size_t)(8 * dt * ksl.stride + 64 * (rt >> 1) + 8 * (rt & 1)) + vo_t) = kd; }
                const bf16x8 Rw0 = mk8(hh[0], hh[1]), Rw1 = mk8(hh[2], hh[3]);
                f32x4 wD[4];
#pragma unroll
                for (int it = 0; it < R0; ++it) wD[it] = z4;
#pragma unroll
                for (int it = R0; it < 4; ++it) { f32x4 a = MFMA16(tmF[it][0], Rw0, z4); a = MFMA16(tmF[it][1], Rw1, a); f32x4 t = MFMA16(Rw0, tmF[it][0], z4); t = MFMA16(Rw1, tmF[it][1], t);
                    wD[it] = a;
                    u32x2 o; o.x = pk2(t[0], t[1]); o.y = pk2(t[2], t[3]);
                    *(u32x2*)(wxu + (size_t)(it * 4096 + 64 * (dt >> 1) + 8 * (dt & 1)) + vo_w) = o; }
                wA[dt][0] = pack2(wD[0], wD[1]); wA[dt][1] = pack2(wD[2], wD[3]);
                __builtin_amdgcn_sched_barrier(0);
            }
        u32x2 qv[8][4];
#pragma unroll
        for (int dt = 0; dt < 8; ++dt)
#pragma unroll
            for (int it2 = R0; it2 < 4; ++it2) qv[dt][it2] = *(const u32x2*)(qkvu + (size_t)(it2 * 16 * GCONV * 2 + 32 * dt) + vo_q);
#pragma unroll
        for (int dt = 0; dt < 8; ++dt)
#pragma unroll
            for (int it2 = R0; it2 < 4; ++it2) { f32x4 a = MFMA16(wA[dt][0], atF[it2][0], z4); a = MFMA16(wA[dt][1], atF[it2][1], a);
                const float sc = qsc[it2]; const u32x2 q2 = qv[dt][it2];
                u32x2 o; o.x = pk2(bflo(q2.x) * sc - a[0], bfhi(q2.x) * sc - a[1]); o.y = pk2(bflo(q2.y) * sc - a[2], bfhi(q2.y) * sc - a[3]);
                *(u32x2*)(qs.base + (size_t)(16 * it2 * qs.stride + 64 * (dt >> 1) + 8 * (dt & 1)) + vo_p) = o; }
    }
    __builtin_amdgcn_sched_barrier(0);
    P6S(4);
    {
        bf16x8 vf[4][4];
#pragma unroll
        for (int rt = R0; rt < 4; ++rt)
#pragma unroll
            for (int ks = 0; ks < 4; ++ks) vf[rt][ks] = *(const bf16x8*)(qkvu + (size_t)(rt * 16 * GCONV * 2 + 4096 + ks * 64) + vo_f);
        asm volatile("s_waitcnt vmcnt(0)" ::: "memory");
        __builtin_amdgcn_sched_barrier(0);
#pragma unroll
        for (int ks = 0; ks < 4; ++ks)
#pragma unroll
            for (int hf = 0; hf < 2; ++hf) { const int dt = 2 * ks + hf; u32x2 hh[4];
#pragma unroll
                for (int rt = 0; rt < R0; ++rt) hh[rt] = (u32x2){0u, 0u};
#pragma unroll
                for (int rt = R0; rt < 4; ++rt) { const f32x4 d = MFMA16(vf[rt][ks], sel[hf], z4); const f32x4 sb = *(const LAS f32x4*)(SC + 64 + 16 * rt + 4 * fq);
                    hh[rt].x = pk2(d[0] * sb[0], d[1] * sb[1]); hh[rt].y = pk2(d[2] * sb[2], d[3] * sb[3]); }
                const bf16x8 Ru0 = mk8(hh[0], hh[1]), Ru1 = mk8(hh[2], hh[3]);
                f32x4 uD[4];
#pragma unroll
                for (int it = 0; it < R0; ++it) uD[it] = z4;
#pragma unroll
                for (int it = R0; it < 4; ++it) { f32x4 a = MFMA16(tmF[it][0], Ru0, z4); a = MFMA16(tmF[it][1], Ru1, a); uD[it] = a;
                    u32x2 o; o.x = pk2(a[0], a[1]); o.y = pk2(a[2], a[3]);
                    *(u32x2*)(vsl.base + (size_t)(8 * dt * vsl.stride + 32 * it) + vo_u) = o; }
                const bf16x8 uA0 = pack2(uD[0], uD[1]), uA1 = pack2(uD[2], uD[3]);
#pragma unroll
                for (int it2 = R0; it2 < 4; ++it2) { f32x4 a = MFMA16(uA0, atF[it2][0], z4); a = MFMA16(uA1, atF[it2][1], a);
                    u32x2 o; o.x = pk2(a[0], a[1]); o.y = pk2(a[2], a[3]); *(u32x2*)(onu + (size_t)(it2 * 16 * ONS + 32 * dt) + vo_o) = o; }
                __builtin_amdgcn_sched_barrier(0);
            }
    }
    P6S(5);
#undef P6_RTV
    if (l == 0) ((float*)(F.ws + WS_HS + 768 * 1024))[item] = __expf(gl);
}
__device__ __forceinline__ void p6_gdn_pre(Frame& F) {
    const int gw = F.vcu * NWAVES + F.wave, NGW = F.G * NWAVES;
    LAS unsigned char* wl = F.lds + F.wave * 17408;
    if (F.wave == 0) for (int h = F.vcu; h < GH; h += F.G) p6_item<true>(F, h, 0, wl);
    for (int m = gw; m < NB * GH * (GNCH - 1); m += NGW) p6_item<false>(F, m >> 5, 1 + (m & 31), wl);
}

__device__ __forceinline__ bf16x8 p7_ld16(const LAS unsigned char* tb, int r, int ch) { return *(const LAS bf16x8*)(tb + r * 256 + ((ch ^ (r & 15)) << 4)); }
#define GAS __attribute__((address_space(1)))
struct SSlot { bool in_out; unsigned off; };
__device__ __forceinline__ SSlot p7_sslot(int s) {
    const unsigned so = (unsigned)s * 32768u; SSlot r;
    r.off = (unsigned)(O_YP * 4 + (size_t)ROWS * DM * 2) + so; r.in_out = true;
    if (s >= 1024) { r.off = (unsigned)WS_SLAB + (so - 1024u * 32768u); r.in_out = false; }
    if (s >= 1376) r.off = (unsigned)WS_WIN + (so - 1376u * 32768u);
    if (s >= 1648) r.off = (unsigned)(WS_WX + (size_t)(NB * GH * GNCH) * 16384) + (so - 1648u * 32768u);
    if (s >= 1776) { r.off = (unsigned)(((size_t)O_SFCONV + (size_t)NS * 2 * UPN) * 4) + (so - 1776u * 32768u); r.in_out = true; }
    if (s >= 1952) { r.off = (unsigned)(WS_C0 + 512 * 1024) + (so - 1952u * 32768u); r.in_out = false; }
    if (s >= 2032) r.off = (unsigned)WS_XS + (so - 2032u * 32768u);
    return r;
}
__device__ __forceinline__ __amdgpu_buffer_rsrc_t p7_srsrc(Frame& F, const SSlot& sl) {
    return __builtin_amdgcn_make_buffer_rsrc(sl.in_out ? (void*)F.out : (void*)F.ws, 0, sl.in_out ? (int)((size_t)O_END * 4) : (int)WS_END, 0x00020000); }
static_assert((size_t)O_END * 4 < (1ull << 31) && WS_END < (1ull << 31), "buffer sizes");
static_assert(1024 + 352 + 272 + 128 + 176 + 80 + 32 >= NB * GH * (GNCH - 1), "state slots");
static_assert((size_t)ROWS * DM * 2 + (size_t)1024 * 32768 <= (size_t)ROWS_P * DM * 4, "y_prompt half");
static_assert(WS_SLAB + (size_t)352 * 32768 <= WS_END && WS_WIN + (size_t)272 * 32768 <= WS_WO && WS_WX + (size_t)(NB * GH * GNCH) * 16384 + (size_t)128 * 32768 <= WS_B1, "slot areas");
static_assert((size_t)176 * 32768 <= (size_t)NS * 2 * UPN * 4 && WS_C0 + 512 * 1024 + (size_t)80 * 32768 <= WS_OL0 && WS_XS + (size_t)32 * 32768 <= WS_MISC, "slot areas");

__device__ __forceinline__ void p7_chain(Frame& F, int bh, GAS unsigned* flag) {
    const int h = bh & 7, l = F.lane, fr = l & 15, fq = l >> 4, w = F.wave;
    const f32x4 z4 = (f32x4){0.f, 0.f, 0.f, 0.f};
    f32x4 S[8];
#pragma unroll
    for (int mt = 0; mt < 8; ++mt) S[mt] = z4;
    const float* EG = (const float*)(F.ws + WS_HS + 768 * 1024);
    const int dv = 16 * w + fr;
#define P7_FETCHA(cc, SG, UT, EGV) do { \
        const Slot ks_ = gdn_slot(F.ws, bh, (cc), 1); \
        const unsigned char* wx_ = F.ws + WS_WX + (size_t)(((cc) == 0 ? (bh & 7) : bh) * GNCH + (cc)) * 16384; \
        _Pragma("unroll") for (int i = 0; i < 4; ++i) { const int r = 4 * ((i & 1) * 8 + w) + (l >> 4); \
            const unsigned char* src_ = (i < 2) ? wx_ + (size_t)r * 256 : ks_.base + (size_t)r * ks_.stride; \
            SG[i] = *(const u32x4*)(src_ + (l & 15) * 16); } \
        const Slot vsl_ = gdn_slot(F.ws, bh, (cc), 2); \
        _Pragma("unroll") for (int it = 0; it < 4; ++it) UT[it] = *(const u32x2*)(vsl_.base + (size_t)(dv >> 1) * vsl_.stride + (dv & 1) * 128 + (16 * it + 4 * fq) * 2); \
        EGV = ldv_f32(EG + ((cc) == 0 ? h : bh) * GNCH + (cc)); } while (0)
#define P7_PUT(cc, SG) do { LAS unsigned char* stg_ = F.lds + ((cc) & 1) * 32768; \
        _Pragma("unroll") for (int i = 0; i < 4; ++i) { const int r = 4 * ((i & 1) * 8 + w) + (l >> 4); \
            *(LAS u32x4*)(stg_ + (i >> 1) * 16384 + r * 256 + (((l & 15) ^ (r & 15)) << 4)) = SG[i]; } } while (0)
#ifdef P7_DRAIN
#define P7_CHAIN_SYNC(c) do { asm volatile("s_waitcnt vmcnt(0) lgkmcnt(0)\n\ts_barrier" ::: "memory"); \
        if ((c) >= 1 && F.tid == 0) __hip_atomic_store(flag, (unsigned)(c), __ATOMIC_RELAXED, __HIP_MEMORY_SCOPE_AGENT); } while (0)
#else
#define P7_CHAIN_SYNC(c) do { asm volatile("s_waitcnt lgkmcnt(0)\n\ts_barrier" ::: "memory"); \
        if ((c) >= 2 && F.tid == 0) __hip_atomic_store(flag, (unsigned)((c) - 1), __ATOMIC_RELAXED, __HIP_MEMORY_SCOPE_AGENT); } while (0)
#endif
#define P7_ITER(c, FIRST, UTC, EGC, UTN, EGN) do { \
        const LAS unsigned char* T0 = F.lds + ((c) & 1) * 32768; const LAS unsigned char* T2 = T0 + 16384; \
        { const int cn_ = (c) + 1 < GNCH ? (c) + 1 : GNCH - 1; P7_FETCHA(cn_, sg, UTN, EGN); }        \
        bf16x8 Sb[4]; \
        _Pragma("unroll") for (int ks = 0; ks < 4; ++ks) Sb[ks] = pack2(S[2 * ks], S[2 * ks + 1]); \
        if (!(FIRST)) { const SSlot sl_ = p7_sslot(((c) - 1) * (NB * GH) + bh); const __amdgpu_buffer_rsrc_t rs_ = p7_srsrc(F, sl_); \
            _Pragma("unroll") for (int ks = 0; ks < 4; ++ks) __builtin_amdgcn_raw_buffer_store_b128(__builtin_bit_cast(u32x4, Sb[ks]), rs_, sl_.off + (unsigned)(((ks * 8 + w) * 64 + l) * 16), 0,   16); } \
        f32x4 vn[4]; \
        _Pragma("unroll") for (int it = 0; it < 4; ++it) { f32x4 a = z4; const int r = 16 * it + fr; \
            _Pragma("unroll") for (int ks = 0; ks < 4; ++ks) a = MFMA16(p7_ld16(T0, r, 4 * ks + fq), Sb[ks], a); \
            vn[it] = (f32x4){bflo(UTC[it].x), bfhi(UTC[it].x), bflo(UTC[it].y), bfhi(UTC[it].y)} - a; } \
        const bf16x8 Vb0 = pack2(vn[0], vn[1]), Vb1 = pack2(vn[2], vn[3]); \
        _Pragma("unroll") for (int mt = 0; mt < 8; ++mt) { const int r = 8 * mt + (fr >> 1), ch = 8 * (fr & 1) + fq; \
            f32x4 a = S[mt] * EGC; \
            a = MFMA16(p7_ld16(T2, r, ch), Vb0, a); \
            a = MFMA16(p7_ld16(T2, r, ch + 4), Vb1, a); \
            S[mt] = a; } \
        P7_PUT((c) + 1, sg); \
        P7_CHAIN_SYNC(c); \
    } while (0)
    u32x4 sg[4];
    u32x2 uTa[4], uTb[4]; float ega, egb;
    P7_FETCHA(0, sg, uTa, ega);
    P7_PUT(0, sg);
    asm volatile("s_waitcnt vmcnt(0) lgkmcnt(0)" ::: "memory");
    __syncthreads();
    static_assert((GNCH & 1) == 1, "chunk 0, then pairs");
    P7_ITER(0, true, uTa, ega, uTb, egb);
    for (int c = 1; c < GNCH; c += 2) {
        P7_ITER(c, false, uTb, egb, uTa, ega);
        P7_ITER(c + 1, false, uTa, ega, uTb, egb);
    }
#undef P7_ITER
#undef P7_FETCHA
#undef P7_PUT
    asm volatile("s_waitcnt vmcnt(0)" ::: "memory");
    __syncthreads();
    if (F.tid == 0) __hip_atomic_store(flag, (unsigned)(GNCH - 1), __ATOMIC_RELAXED, __HIP_MEMORY_SCOPE_AGENT);
#pragma unroll
    for (int mt = 0; mt < 8; ++mt)
#pragma unroll
        for (int r = 0; r < 4; ++r) F.out[O_PGDN + ((size_t)bh * 128 + 16 * mt + 4 * fq + r) * 128 + dv] = S[mt][r];
    __syncthreads();
}

__device__ __forceinline__ void p7_opart(Frame& F, int bx, int G, bool flow, GAS unsigned* flags) {
    int t_ = (int)threadIdx.x; asm volatile("" : "+v"(t_));
    const int l = t_ & 63, fr = l & 15, fq = l >> 4, w = F.wave;
    constexpr int NITEM = NB * GH * GNCH;
    const f32x4 z4 = (f32x4){0.f, 0.f, 0.f, 0.f};
    bf16* ON = (bf16*)(F.out + O_YP); const bf16* GATE = (const bf16*)(F.ws + WS_B2); const float* onw = F.in[24];
    const int dv = 16 * w + fr;
    LAS unsigned short* Obase = (LAS unsigned short*)(F.lds + 98304);
    const int ni = t_ >> 3, part = t_ & 7;
    float onv[16];
#pragma unroll
    for (int e = 0; e < 16; ++e) onv[e] = onw[16 * part + e];
#ifdef P7_ACQ
#define P7_CONS_ACQ() do { asm volatile("" ::: "memory"); __builtin_amdgcn_fence(__ATOMIC_ACQUIRE, "agent"); asm volatile("s_waitcnt vmcnt(0)" ::: "memory"); } while (0)
#else
#define P7_CONS_ACQ() asm volatile("" ::: "memory")
#endif
#define P7B_FETCHA(idx, QR, SB) do { const int c_ = (idx) >> 6, bh_ = (idx) & 63; \
        if (flow && c_ > 0) { GAS unsigned* fl_ = flags + bh_ * 32; while (__hip_atomic_load(fl_, __ATOMIC_RELAXED, __HIP_MEMORY_SCOPE_AGENT) < (unsigned)c_) __builtin_amdgcn_s_sleep(4); P7_CONS_ACQ(); } \
        const Slot qs_ = gdn_slot(F.ws, bh_, c_, 0); \
        _Pragma("unroll") for (int j = 0; j < 2; ++j) { const int pc_ = t_ + 512 * j, r = pc_ >> 4; QR[j] = *(const u32x4*)(qs_.base + (size_t)r * qs_.stride + (pc_ & 15) * 16); } \
        const SSlot sl_ = p7_sslot((c_ > 0 ? c_ - 1 : 0) * (NB * GH) + bh_); const __amdgpu_buffer_rsrc_t rs_ = p7_srsrc(F, sl_);        \
        _Pragma("unroll") for (int ks = 0; ks < 4; ++ks) SB[ks] = __builtin_bit_cast(bf16x8, __builtin_amdgcn_raw_buffer_load_b128(rs_, sl_.off + (unsigned)(((ks * 8 + w) * 64 + l) * 16), 0,   16)); } while (0)
#define P7B_PUT(k, QR) do { LAS unsigned char* qt_ = F.lds + ((k) & 1) * 16384; \
        _Pragma("unroll") for (int j = 0; j < 2; ++j) { const int pc_ = t_ + 512 * j, r = pc_ >> 4; *(LAS u32x4*)(qt_ + r * 256 + (((pc_ & 15) ^ (r & 15)) << 4)) = QR[j]; } } while (0)
#define P7B_FETCHB(idx, VALID, OL0, OL1, GT0, GT1, OO) do { const int c_ = (idx) >> 6, bh_ = (idx) & 63, b_ = bh_ >> 3, h_ = bh_ & 7; \
        const int nrow_ = gdn_row(b_, c_, ni); const int o_ = (nrow_ >= 0 ? nrow_ : 0) * DM + 128 * h_ + 16 * part; \
        const bf16* olp_ = (c_ == 0) ? (const bf16*)(F.ws + WS_OL0) + (size_t)(h_ * 64 + ni) * 128 + 16 * part : ON + o_; \
        OL0 = *(const u32x4*)(olp_); OL1 = *(const u32x4*)(olp_ + 8); GT0 = *(const u32x4*)(GATE + o_); GT1 = *(const u32x4*)(GATE + o_ + 8); \
        OO = (nrow_ >= 0 && (VALID)) ? o_ : -1; } while (0)
#define P7B_NORM(OT, OL0, OL1, GT0, GT1, OO) do { \
        float o[16]; float ss = 0.f; \
        _Pragma("unroll") for (int e = 0; e < 4; ++e) { o[2 * e] = bflo(OL0[e]); o[2 * e + 1] = bfhi(OL0[e]); o[8 + 2 * e] = bflo(OL1[e]); o[8 + 2 * e + 1] = bfhi(OL1[e]); } \
        { const u32x4 q0 = *(const LAS u32x4*)((OT) + ni * 136 + 16 * part), q1 = *(const LAS u32x4*)((OT) + ni * 136 + 16 * part + 8); \
          _Pragma("unroll") for (int e = 0; e < 4; ++e) { o[2 * e] += bflo(q0[e]); o[2 * e + 1] += bfhi(q0[e]); o[8 + 2 * e] += bflo(q1[e]); o[8 + 2 * e + 1] += bfhi(q1[e]); } } \
        _Pragma("unroll") for (int e = 0; e < 16; ++e) ss += o[e] * o[e]; \
        ss += __shfl_xor(ss, 1); ss += __shfl_xor(ss, 2); ss += __shfl_xor(ss, 4); \
        const float rn = 1.f / sqrtf(ss * (1.f / 128.f) + EPS); \
        float gt[16]; \
        _Pragma("unroll") for (int e = 0; e < 4; ++e) { gt[2 * e] = bflo(GT0[e]); gt[2 * e + 1] = bfhi(GT0[e]); gt[8 + 2 * e] = bflo(GT1[e]); gt[8 + 2 * e + 1] = bfhi(GT1[e]); } \
        float v[16]; \
        _Pragma("unroll") for (int e = 0; e < 16; ++e) v[e] = o[e] * rn * onv[e] * siluf_(gt[e]); \
        u32x4 s0, s1; \
        _Pragma("unroll") for (int e = 0; e < 4; ++e) { s0[e] = pk2(v[2 * e], v[2 * e + 1]); s1[e] = pk2(v[8 + 2 * e], v[8 + 2 * e + 1]); } \
        bf16* dst_ = (OO) >= 0 ? ON + (OO) : dump; \
        *(u32x4*)(dst_) = s0; *(u32x4*)(dst_ + 8) = s1; } while (0)
#define P7B_ITER(k, FIRST, SBC, SBN, OLP0, OLP1, GTP0, GTP1, OOP, OLQ0, OLQ1, GTQ0, GTQ1, OOQ) do { \
        const int idt_ = bx + G * (k), idc_ = idt_ < NITEM ? idt_ : NITEM - 1, idn_ = idt_ + G < NITEM ? idt_ + G : NITEM - 1; \
        P7B_FETCHA(idn_, qr, SBN); \
        P7B_FETCHB(idc_, idt_ < NITEM, OLQ0, OLQ1, GTQ0, GTQ1, OOQ); \
        if (!(FIRST)) P7B_NORM(Obase + (((k) - 1) & 1) * (64 * 136), OLP0, OLP1, GTP0, GTP1, OOP); \
        { LAS unsigned short* O = Obase + ((k) & 1) * (64 * 136); const LAS unsigned char* QT = F.lds + ((k) & 1) * 16384; const bool zs_ = idc_ < NB * GH;        \
            _Pragma("unroll") for (int it = 0; it < 4; ++it) { f32x4 o = z4; const int r = 16 * it + fr; \
                _Pragma("unroll") for (int ks = 0; ks < 4; ++ks) o = MFMA16(p7_ld16(QT, r, 4 * ks + fq), SBC[ks], o); \
                _Pragma("unroll") for (int rr = 0; rr < 4; ++rr) O[(16 * it + 4 * fq + rr) * 136 + dv] = zs_ ? (unsigned short)0 : (unsigned short)(pk2(o[rr], 0.f) & 0xffffu); } } \
        P7B_PUT((k) + 1, qr); \
        asm volatile("s_waitcnt lgkmcnt(0)\n\ts_barrier" ::: "memory"); } while (0)
    bf16* dump = (bf16*)(F.ws + WS_MISC) + (size_t)t_ * 16;
    u32x4 qr[2]; bf16x8 sba[4], sbb[4];
    u32x4 pl0, pl1, pg0, pg1, ql0, ql1, qg0, qg1; int poo = -1, qoo = -1;
    __syncthreads();
    const int K = (NITEM + G - 1) / G;
    P7B_FETCHA(bx, qr, sba);
    P7B_PUT(0, qr);
    asm volatile("s_waitcnt vmcnt(0) lgkmcnt(0)" ::: "memory");
    __syncthreads();
    P7B_ITER(0, true, sba, sbb, pl0, pl1, pg0, pg1, poo, ql0, ql1, qg0, qg1, qoo);
    int k = 1;
    for (; k + 1 < K; k += 2) {
        P7B_ITER(k, false, sbb, sba, ql0, ql1, qg0, qg1, qoo, pl0, pl1, pg0, pg1, poo);
        P7B_ITER(k + 1, false, sba, sbb, pl0, pl1, pg0, pg1, poo, ql0, ql1, qg0, qg1, qoo);
    }
    if (k < K) { P7B_ITER(k, false, sbb, sba, ql0, ql1, qg0, qg1, qoo, pl0, pl1, pg0, pg1, poo);
        P7B_NORM(Obase + (k & 1) * (64 * 136), pl0, pl1, pg0, pg1, poo); }
    else { P7B_NORM(Obase + ((k - 1) & 1) * (64 * 136), ql0, ql1, qg0, qg1, qoo); }
#undef P7B_ITER
#undef P7B_NORM
#undef P7B_FETCHB
#undef P7B_PUT
#undef P7B_FETCHA
    __syncthreads();
}
__device__ __forceinline__ void p7_sample(Frame& F, int sh) {
    const int s = sh >> 3, h = sh & 7, t = F.tid, row = ROWS_P + s;
    LAS float* qkv = (LAS float*)F.lds;
    LAS float* part = (LAS float*)(F.lds + 2048);
    LAS float* red = (LAS float*)(F.lds + 4096);
    const bf16* QKV = (const bf16*)(F.ws + WS_BIG); const float* AB = (const float*)(F.ws + WS_AB);
    if (t < 384) qkv[t] = bflo((unsigned)QKV[(size_t)row * GCONV + (t >> 7) * 1024 + 128 * h + (t & 127)]);
    __syncthreads();
    if (F.wave < 2) { const float a0 = qkv[F.wave * 128 + F.lane], a1 = qkv[F.wave * 128 + 64 + F.lane]; const float ssum = wave_sum(a0 * a0 + a1 * a1); if (F.lane == 0) red[F.wave] = ssum; }
    __syncthreads();
    const float rq = 0.08838834764831845f / sqrtf(red[0] + 1e-6f), rk = 1.f / sqrtf(red[1] + 1e-6f);
    const float a = ldv_f32(AB + (size_t)row * 16 + h), bq = ldv_f32(AB + (size_t)row * 16 + 8 + h);
    const float eg = __expf(-__expf(F.in[22][h]) * softplusf_(a + F.in[23][h])), be = sigmoidf_(bq);
    const int j = t & 127, qd = t >> 7;
    const float* S0 = F.in[4] + ((size_t)sh * 128 + 32 * qd) * 128 + j; float* S1 = F.out + O_SGDN + ((size_t)sh * 128 + 32 * qd) * 128 + j;
    float s0[32]; float ks = 0.f;
#pragma unroll
    for (int e = 0; e < 32; ++e) { s0[e] = S0[(size_t)e * 128]; ks += qkv[128 + 32 * qd + e] * s0[e]; }
    part[qd * 128 + j] = ks * rk;
    __syncthreads();
    const float kS = part[j] + part[128 + j] + part[256 + j] + part[384 + j];
    const float vnew = be * (qkv[256 + j] - eg * kS);
    __syncthreads();
    float op = 0.f;
#pragma unroll
    for (int e = 0; e < 32; ++e) { const float v1 = eg * s0[e] + qkv[128 + 32 * qd + e] * rk * vnew; S1[(size_t)e * 128] = v1; op += qkv[32 * qd + e] * v1; }
    part[qd * 128 + j] = op * rq;
    __syncthreads();
    const float o = part[j] + part[128 + j] + part[256 + j] + part[384 + j];
    { const float ssum = wave_sum(o * o); if (F.lane == 0) red[2 + F.wave] = ssum; }
    __syncthreads();
    if (t < 128) { const float rn = 1.f / sqrtf((red[2] + red[3]) * (1.f / 128.f) + EPS);
        const float gt = bflo((unsigned)((const bf16*)(F.ws + WS_B2))[(size_t)row * DM + 128 * h + j]);
        ((bf16*)(F.out + O_YP))[(size_t)row * DM + 128 * h + j] = (bf16)f2bf(o * rn * F.in[24][j] * siluf_(gt)); }
    __syncthreads();
}
__device__ __forceinline__ void p7_gdn_rec(Frame& F) {
    const int bx = (int)blockIdx.x;
    if (bx < NB * GH) p7_chain(F, bx, (GAS unsigned*)(F.ws + WS_CTL) + bx * 32);
    const int nsb = F.G - NB * GH;
    if (nsb > 0) { if (bx >= NB * GH) { for (int it = bx - NB * GH; it < NS * GH; it += nsb) p7_sample(F, it);
            p0_weights(F, 1, (bx - NB * GH) * NWAVES + F.wave, nsb * NWAVES);
#ifdef DUP_W1
            p0_weights(F, 1, (bx - NB * GH) * NWAVES + F.wave, nsb * NWAVES);
#endif
            } }
    else { for (int it = bx; it < NS * GH; it += F.G) p7_sample(F, it); p0_weights(F, 1, bx * NWAVES + F.wave, F.G * NWAVES); }
}

__device__ __forceinline__ void p11_final(Frame& F, const bf16* XB, const float* slab, int nsplit) {
    int t_ = (int)threadIdx.x; asm volatile("" : "+v"(t_)); const int lane = t_ & 63;
    const int gw = F.vcu * NWAVES + F.wave, NGW = F.G * NWAVES;
    const float* SS = (const float*)(F.ws + WS_SS); const float* nf = F.in[10];
    f32x4 nv[4];
#pragma unroll
    for (int j = 0; j < 4; ++j) nv[j] = *(const f32x4*)(nf + 4 * lane + 256 * j);
    for (int row = gw; row < ROWS; row += NGW) {
        float* y = yrow_ptr(F.out, row); if (!y) continue;
        f32x4 v[4]; float ss = 0.f;
#pragma unroll
        for (int j = 0; j < 4; ++j) { const u32x2 xb = *(const u32x2*)(XB + (size_t)row * DM + 4 * lane + 256 * j); v[j] = (f32x4){bflo(xb.x), bfhi(xb.x), bflo(xb.y), bfhi(xb.y)}; }
        float rs;
        if (row < 64 * 256) {
            const float sl = (lane < 32) ? SS[(size_t)row * 32 + lane] : 0.f;
            rs = 1.f / sqrtf(wave_sum(sl) * (1.f / DM) + EPS);
        } else {
            const int r = row - 64 * 256;
#pragma unroll
            for (int j = 0; j < 4; ++j) {
                for (int s = 0; s < nsplit; ++s) v[j] += *(const f32x4*)(slab + ((size_t)(j * nsplit + s) * 256 + r) * 256 + 4 * lane);
                ss += (v[j].x * v[j].x + v[j].y * v[j].y) + (v[j].z * v[j].z + v[j].w * v[j].w); }
            rs = 1.f / sqrtf(wave_sum(ss) * (1.f / DM) + EPS);
        }
#pragma unroll
        for (int j = 0; j < 4; ++j) *(f32x4*)(y + 4 * lane + 256 * j) = v[j] * rs * nv[j];
    }
}

constexpr int NPHASE = 12;
__global__ void __launch_bounds__(NWAVES * 64, 2) hybrid_fwd(Args args) {
    extern __shared__ __attribute__((aligned(16))) unsigned char lds[];
    Frame F;
    F.lds = (LAS unsigned char*)lds;
    F.tid = threadIdx.x; F.lane = F.tid & 63; F.wave = __builtin_amdgcn_readfirstlane(F.tid >> 6);
    F.G = gridDim.x; { const int bx = blockIdx.x; F.vcu = (F.G % 8 == 0) ? (bx % 8) * (F.G / 8) + bx / 8 : bx; }
    F.in = args.in; F.out = args.out; F.ws = args.ws;
    for (int u = F.tid; u < (LDS_BYTES - LDSCTL_OFF) / 4; u += NWAVES * 64) ((LAS unsigned*)(F.lds + LDSCTL_OFF))[u] = 0u;
    __syncthreads();
#if !MK_PER_PHASE
    const XcdBarrier bar = xcd_barrier_post((unsigned*)(F.ws + WS_CTL) + 4096, (volatile LAS unsigned*)(F.lds + LDSCTL_OFF + 32));
#define GRID_BAR() xcd_barrier(bar)
#else
#define GRID_BAR() do {} while (0)
#endif
    const int lo = args.ph_lo, hi = args.ph_hi;
#ifdef PROBE_PHASE
    unsigned long long pr_t0 = 0, pr_t1 = 0, pr_ta = 0;
#define PROBE_BEGIN(k) do { if ((k) == PROBE_PHASE) pr_t0 = __builtin_amdgcn_s_memrealtime(); } while (0)
#ifdef PROBE_PRE
#define PROBE_PRE_END(k) do { if ((k) == PROBE_PHASE) pr_t1 = __builtin_amdgcn_s_memrealtime(); } while (0)
#define PROBE_END(k) do {} while (0)
#else
#define PROBE_PRE_END(k) do {} while (0)
#define PROBE_END(k) do { if ((k) == PROBE_PHASE) pr_t1 = __builtin_amdgcn_s_memrealtime(); } while (0)
#endif
#ifndef PROBE_BLOCK
#define PROBE_BLOCK 0
#endif
#else
#define PROBE_PRE_END(k) do {} while (0)
#define PROBE_BEGIN(k) do {} while (0)
#define PROBE_END(k) do {} while (0)
#endif
#if defined(PROBE_PHASE) && defined(PROBE_P7A)
#define P7A_END() do { if (PROBE_PHASE == 7) pr_ta = __builtin_amdgcn_s_memrealtime(); } while (0)
#else
#define P7A_END() do {} while (0)
#endif
#define IN(k) (lo <= (k) && (k) < hi)
#define BOTH(k) (IN(k) && IN((k) + 1))
    float* SS = (float*)(F.ws + WS_SS); bf16* ONB = (bf16*)(F.out + O_YP);
    bf16* B1 = (bf16*)(F.ws + WS_B1); bf16* B2 = (bf16*)(F.ws + WS_B2); bf16* BIG = (bf16*)(F.ws + WS_BIG);
    LAS unsigned char* ex = F.lds + EXCH_OFF; float* slab = (float*)(F.ws + WS_SLAB);

    PROBE_BEGIN(0); if (IN(0)) { p0_prologue(F); PROBE_PRE_END(0); if (BOTH(0)) GRID_BAR(); } PROBE_END(0);
    PROBE_BEGIN(1); if (IN(1)) { p1_s5(F); PROBE_PRE_END(1); if (BOTH(1)) GRID_BAR(); } PROBE_END(1);
    PROBE_BEGIN(2); if (IN(2)) {
        pg8::Gemm g{B2, (const bf16*)(F.ws + WS_WGLU), DM, 0, 0}; pg8::StaticOrder S; S.init(64, 8, F.G, (int)blockIdx.x, DM / 64, 4, 4);
        EpiGlu E{F.in[0], F.in[1], F.in[7], B1, SS, slab};
        pg8::gemm_phase<EpiGlu, pg8::StaticOrder, true, true>(F.lds, g, S, E);
        GRID_BAR(); glu_fixup(F, B1, SS, slab, 4);
        PROBE_PRE_END(2); if (BOTH(2)) GRID_BAR(); } PROBE_END(2);
    PROBE_BEGIN(3); if (IN(3)) {
#ifdef DRY_P3
        { pg8::Gemm g{B1, (const bf16*)(F.ws + WS_WUP0), DM, 2, 65}; pg8::StaticOrder S; S.init(66, 22, F.G, (int)blockIdx.x, DM / 64);
          EpiNull E{}; pg8::gemm_phase<EpiNull, pg8::StaticOrder, true, true>(F.lds, g, S, E); GRID_BAR(); }
#endif
        pg8::Gemm g{B1, (const bf16*)(F.ws + WS_WUP0), DM, 2, 65}; pg8::StaticOrder S; S.init(66, 22, F.G, (int)blockIdx.x, DM / 64);
        EpiUp E{BIG, SS, F.in[27], F.in[6], F.out + O_PFCONV, F.out + O_SFCONV, ex, 65};
        pg8::gemm_phase<EpiUp, pg8::StaticOrder, true, true>(F.lds, g, S, E);
        PROBE_PRE_END(3); if (BOTH(3)) GRID_BAR(); } PROBE_END(3);
    PROBE_BEGIN(4); if (IN(4)) {
        pg8::Gemm g{BIG, (const bf16*)(F.ws + WS_WDN0), DFF, 0, 0}; pg8::StaticOrder S; S.init(64, 4, F.G, (int)blockIdx.x, DFF / 64, 11, 4);
        EpiRes<false> E{B1, F.out, SS, slab};
        pg8::gemm_phase<EpiRes<false>, pg8::StaticOrder, true, true>(F.lds, g, S, E);
        GRID_BAR(); res_fixup<false>(F, B1, SS, slab, 11);
        PROBE_PRE_END(4); if (BOTH(4)) GRID_BAR(); } PROBE_END(4);
    PROBE_BEGIN(5); if (IN(5)) {
        pg8::Gemm g{B1, (const bf16*)(F.ws + WS_WIN), DM, 3, 66}; pg8::StaticOrder S; S.init(67, 17, F.G, (int)blockIdx.x, DM / 64);
        EpiIn E{BIG, B2, (float*)(F.ws + WS_AB), SS, F.in[21], F.in[5], F.out + O_PGCONV, F.out + O_SGCONV, ex, 66};
        pg8::gemm_phase<EpiIn, pg8::StaticOrder, true, true>(F.lds, g, S, E);
        PROBE_PRE_END(5); if (BOTH(5)) GRID_BAR(); } PROBE_END(5);
    PROBE_BEGIN(6); if (IN(6)) { p6_gdn_pre(F); PROBE_PRE_END(6); if (BOTH(6)) GRID_BAR(); } PROBE_END(6);
    PROBE_BEGIN(7); if (IN(7)) { const int nsb = F.G - NB * GH; const bool flow = nsb >= NB * GH;
        p7_gdn_rec(F); P7A_END(); if (!flow) GRID_BAR();
        if (!flow || (int)blockIdx.x >= NB * GH) p7_opart(F, flow ? (int)blockIdx.x - NB * GH : (int)blockIdx.x, flow ? nsb : F.G, flow, (GAS unsigned*)(F.ws + WS_CTL));
        PROBE_PRE_END(7); if (BOTH(7)) GRID_BAR(); } PROBE_END(7);
    PROBE_BEGIN(8); if (IN(8)) {
        pg8::Gemm g{ONB, (const bf16*)(F.ws + WS_WO), DM, 0, 0}; pg8::StaticOrder S; S.init(64, 4, F.G, (int)blockIdx.x, DM / 64, 4, 4);
        EpiRes<false> E{B1, F.out, SS, slab};
        pg8::gemm_phase<EpiRes<false>, pg8::StaticOrder, true, true>(F.lds, g, S, E);
        GRID_BAR(); res_fixup<false>(F, B1, SS, slab, 4);
        PROBE_PRE_END(8); if (BOTH(8)) GRID_BAR(); } PROBE_END(8);
    PROBE_BEGIN(9); if (IN(9)) {
        pg8::Gemm g{B1, (const bf16*)(F.ws + WS_WUP1), DM, 2, 65}; pg8::StaticOrder S; S.init(66, 22, F.G, (int)blockIdx.x, DM / 64);
        EpiUp E{BIG, SS, F.in[27] + 3 * UPN, F.in[6] + (size_t)NS * 2 * UPN, F.out + O_PFCONV + (size_t)NB * 2 * UPN, F.out + O_SFCONV + (size_t)NS * 2 * UPN, ex, 65};
        pg8::gemm_phase<EpiUp, pg8::StaticOrder, true, true>(F.lds, g, S, E);
        PROBE_PRE_END(9); if (BOTH(9)) GRID_BAR(); } PROBE_END(9);
    PROBE_BEGIN(10); if (IN(10)) {
        pg8::Gemm g{BIG, (const bf16*)(F.ws + WS_WDN1), DFF, 0, 0}; pg8::StaticOrder S; S.init(64, 4, F.G, (int)blockIdx.x, DFF / 64, 11, 4);
        EpiRes<false> E{B1, F.out, SS, slab};
        pg8::gemm_phase<EpiRes<false>, pg8::StaticOrder, true, true>(F.lds, g, S, E);
        PROBE_PRE_END(10); if (BOTH(10)) GRID_BAR(); } PROBE_END(10);
    PROBE_BEGIN(11); if (IN(11)) p11_final(F, B1, slab, 11); PROBE_END(11);
#ifdef SEG_ID
    __syncthreads();
    if (F.vcu == SEG_BLOCK) { const unsigned long long tend = __builtin_amdgcn_s_memrealtime(), wait = *(volatile LAS unsigned long long*)(F.lds + LDSCTL_OFF + 64) * SEG_AMP; while (__builtin_amdgcn_s_memrealtime() - tend < wait) __builtin_amdgcn_s_sleep(8); }
#endif
#ifdef P6_SEG
    __syncthreads();
    if (blockIdx.x == 3) { const unsigned long long tend = __builtin_amdgcn_s_memrealtime(), wait = *(volatile LAS unsigned long long*)(F.lds + LDSCTL_OFF + 64) * P6_AMP; while (__builtin_amdgcn_s_memrealtime() - tend < wait) __builtin_amdgcn_s_sleep(8); }
#endif
#ifdef P7_SEG
    __syncthreads();
    if (blockIdx.x == 0) { const unsigned long long tend = __builtin_amdgcn_s_memrealtime(), wait = *(volatile LAS unsigned long long*)(F.lds + LDSCTL_OFF + 64) * P7_AMP; while (__builtin_amdgcn_s_memrealtime() - tend < wait) __builtin_amdgcn_s_sleep(8); }
#endif
#ifdef PROBE_PHASE
#ifdef PROBE_P7A
    pr_t1 = pr_ta;
#endif
    if (F.vcu == PROBE_BLOCK) { const unsigned long long tend = __builtin_amdgcn_s_memrealtime(), wait = (pr_t1 - pr_t0) * PROBE_AMP; while (__builtin_amdgcn_s_memrealtime() - tend < wait) __builtin_amdgcn_s_sleep(8); }
#endif
#undef IN
#undef BOTH
}

extern "C" void kernel_launch(void* const* d_in, const int* in_sizes, int n_in, void* d_out, int out_size, void* d_ws, size_t ws_size, hipStream_t stream) {
    static int grid = 0;
    if (grid == 0) {
        if (n_in != 29 || (size_t)out_size != O_END || ws_size < WS_END) { fprintf(stderr, "kernel_launch: unexpected shapes (n_in %d, out %d, ws %zu); nothing launched\n", n_in, out_size, ws_size); grid = -1; return; }
        int dev = 0, cus = 0, per_cu = 0;
        if (hipGetDevice(&dev) != hipSuccess || hipDeviceGetAttribute(&cus, hipDeviceAttributeMultiprocessorCount, dev) != hipSuccess) { grid = -1; return; }
        if (hipFuncSetAttribute((const void*)hybrid_fwd, hipFuncAttributeMaxDynamicSharedMemorySize, LDS_BYTES) != hipSuccess) { fprintf(stderr, "kernel_launch: hipFuncSetAttribute failed\n"); grid = -1; return; }
        if (hipOccupancyMaxActiveBlocksPerMultiprocessor(&per_cu, (const void*)hybrid_fwd, NWAVES * 64, LDS_BYTES) != hipSuccess || per_cu < 1)
            fprintf(stderr, "kernel_launch: note: occupancy query reports %d workgroups per CU\n", per_cu);
        (void)hipGetLastError();
        grid = cus;
    }
    if (grid < 0) return;
    if (hipMemsetAsync((char*)d_ws + WS_CTL, 0, CTL_ZERO_BYTES, stream) != hipSuccess) { fprintf(stderr, "kernel_launch: memset failed\n"); return; }
    Args a{};
    for (int i = 0; i < 29; ++i) a.in[i] = (const float*)d_in[i];
    a.out = (float*)d_out; a.ws = (unsigned char*)d_ws;
#if MK_PER_PHASE
    for (int p = 0; p < NPHASE; ++p) { a.ph_lo = p; a.ph_hi = p + 1; hipLaunchKernelGGL(hybrid_fwd, dim3(grid), dim3(NWAVES * 64), LDS_BYTES, stream, a); }
#else
    a.ph_lo = 0; a.ph_hi = NPHASE;
    hipLaunchKernelGGL(hybrid_fwd, dim3(grid), dim3(NWAVES * 64), LDS_BYTES, stream, a);
#endif
    const hipError_t le = hipPeekAtLastError();
    if (le != hipSuccess) fprintf(stderr, "kernel_launch: launch failed: %s\n", hipGetErrorName(le));
}
```

```cpp
#include <hip/hip_runtime.h>
#include <cstdio>
#include <cstdint>

#ifndef MK_PER_PHASE
#define MK_PER_PHASE 0
#endif

#define GAS __attribute__((address_space(1)))
#define LAS __attribute__((address_space(3)))
typedef unsigned short bf16;
typedef unsigned short bf16_t;
typedef short bf16x8 __attribute__((ext_vector_type(8)));
typedef float f32x4 __attribute__((ext_vector_type(4)));
typedef float f32x2 __attribute__((ext_vector_type(2)));
typedef unsigned u32x4 __attribute__((ext_vector_type(4)));
typedef unsigned u32x2 __attribute__((ext_vector_type(2)));

constexpr int DM = 1024, NB = 8, SEQ = 2048, NMETA = 16, TP = NMETA + SEQ  , NS = 128;
constexpr int ROWS_P = NB * TP  , ROWS = ROWS_P + NS  , ROWS_PAD = 16896;
constexpr int S5G = 64, S5P = 64, S5L = 16, S5NCH = TP / S5L  , S5NCHP = 144;
constexpr int DFF = 2816, UPN = 2 * DFF;
constexpr int GH = 8, GDK = 128, GCONV = 3072, GIN = 4112, GINP = 4352;
constexpr int GNCH = 33, GNULL = 48;
constexpr float EPS = 1e-6f;

constexpr size_t O_YP = 0, O_YS = 16777216, O_PS5RE = 16908288, O_PS5IM = 16941056, O_PGDN = 16973824, O_PGCONV = 18022400, O_PFCONV = 18096128,
                 O_SS5RE = 18276352, O_SS5IM = 18800640, O_SGDN = 19324928, O_SGCONV = 36102144, O_SFCONV = 37281792, O_END = 40165376;

constexpr size_t MiB = 1u << 20;
constexpr size_t WS_CTL = 0, CTL_ZERO_BYTES = 64 * 1024;
constexpr size_t WS_SS = 1 * MiB;
constexpr size_t WS_AB = 3 * MiB + 512 * 1024;
constexpr size_t WS_XS = 5 * MiB;
constexpr size_t WS_MISC = 6 * MiB;
constexpr size_t WS_HS = 7 * MiB;
constexpr size_t WS_C0 = 8 * MiB;
constexpr size_t WS_OL0 = 11 * MiB;
constexpr size_t WS_W1 = 12 * MiB;
constexpr size_t WS_WIN = WS_W1, WS_WO = WS_WIN + (size_t)GINP * DM * 2, WS_WUP1 = WS_WO + (size_t)DM * DM * 2, WS_WDN1 = WS_WUP1 + (size_t)UPN * DM * 2;
constexpr size_t WS_W0 = 40 * MiB;
constexpr size_t WS_WGLU = WS_W0, WS_WUP0 = WS_WGLU + (size_t)2048 * DM * 2, WS_WDN0 = WS_WUP0 + (size_t)UPN * DM * 2, WS_S5M = WS_WDN0 + (size_t)DM * DFF * 2;
constexpr size_t S5M_WG = 128 * 256 * 2, S5M_TV = 256 * 384 * 2, S5M_G = S5M_WG + S5M_TV;
constexpr size_t WS_WX = WS_W0;
constexpr size_t WS_B1 = 77 * MiB;
constexpr size_t WS_B2 = 110 * MiB;
constexpr size_t WS_BIG = 143 * MiB;
constexpr size_t WS_SLAB = 241 * MiB;
constexpr size_t WS_END = 252 * MiB;
static_assert(WS_WDN1 + (size_t)DM * DFF * 2 <= WS_W0 && WS_S5M + 64 * S5M_G <= WS_B1 && WS_WX + (size_t)NB * GH * GNCH * 16384 <= WS_B1, "ws map");
static_assert(WS_B1 + (size_t)ROWS_PAD * DM * 2 <= WS_B2 && WS_B2 + (size_t)ROWS_PAD * DM * 2 <= WS_BIG && WS_BIG + (size_t)ROWS * GCONV * 2 <= WS_END, "ws map");
static_assert(WS_BIG + (size_t)ROWS_PAD * DFF * 2 <= WS_END && WS_BIG + (size_t)NB * S5G * S5NCHP * 512 <= WS_END, "ws map");

constexpr int LDS_BYTES = 147456;
constexpr int LDSCTL_OFF = LDS_BYTES - 512;
constexpr int EXCH_OFF = 131072;

__device__ __forceinline__ unsigned f2bf(float f) { unsigned u = __builtin_bit_cast(unsigned, f); return (u + 0x7fffu + ((u >> 16) & 1u)) >> 16; }
typedef __bf16 bf16x2_t __attribute__((ext_vector_type(2)));
__device__ __forceinline__ unsigned pk2(float lo, float hi) { const f32x2 v = {lo, hi}; const bf16x2_t b = __builtin_convertvector(v, bf16x2_t); return __builtin_bit_cast(unsigned, b); }
__device__ __forceinline__ float bflo(unsigned u) { return __builtin_bit_cast(float, u << 16); }
__device__ __forceinline__ float bfhi(unsigned u) { return __builtin_bit_cast(float, u & 0xffff0000u); }
__device__ __forceinline__ float sigmoidf_(float x) { return __builtin_amdgcn_rcpf(1.f + __expf(-x)); }
__device__ __forceinline__ float siluf_(float x) { return x * __builtin_amdgcn_rcpf(1.f + __expf(-x)); }
__device__ __forceinline__ float gelu_tanh(float x) { const float z = 1.5957691216057308f * (x + 0.044715f * x * x * x); return x * __builtin_amdgcn_rcpf(1.f + __expf(-z)); }

__device__ __forceinline__ float ldv_f32(const float* p) { return __builtin_bit_cast(float, __hip_atomic_load((const unsigned*)p, __ATOMIC_RELAXED, __HIP_MEMORY_SCOPE_AGENT)); }
__device__ __forceinline__ float xsum_16_32(float s) {
    const unsigned u = __builtin_bit_cast(unsigned, s);
    const auto a = __builtin_amdgcn_permlane16_swap(u, u, false, false);
    const float t = __builtin_bit_cast(float, (unsigned)a[0]) + __builtin_bit_cast(float, (unsigned)a[1]);
    const unsigned v = __builtin_bit_cast(unsigned, t);
    const auto b = __builtin_amdgcn_permlane32_swap(v, v, false, false);
    return __builtin_bit_cast(float, (unsigned)b[0]) + __builtin_bit_cast(float, (unsigned)b[1]);
}

__device__ __forceinline__ float* xrow_ptr(float* yp, float* xs, int row) {
    if (row >= ROWS_P) return xs + (size_t)(128 + row - ROWS_P) * DM;
    const int b = row / TP, pos = row - b * TP;
    return pos < NMETA ? xs + (size_t)(b * NMETA + pos) * DM : yp + ((size_t)b * SEQ + (pos - NMETA)) * DM;
}
__device__ __forceinline__ const float* xin_ptr(const float* xp, const float* xsmp, const float* meta, int row) {
    if (row >= ROWS_P) return xsmp + (size_t)(row - ROWS_P) * DM;
    const int b = row / TP, pos = row - b * TP;
    return pos < NMETA ? meta + (size_t)pos * DM : xp + ((size_t)b * SEQ + (pos - NMETA)) * DM;
}

namespace pg8 {
#define PG8_LAS __attribute__((address_space(3)))
constexpr int BM = 256, BK = 64, HALF = 128, HTB = HALF * BK * 2  , STAGE_BYTES = 8 * HTB, NXCD = 8, WGM = 8;
__host__ __device__ __forceinline__ int lds_byte(int r, int c) { const int st = (r >> 4) * 2 + (c >> 5), rr = r & 15, cc = c & 31, ob = rr * 64 + cc * 2; return st * 1024 + (ob ^ (((ob >> 9) & 1) << 5)); }
__host__ __device__ __forceinline__ void stage_rc(int b, int& R, int& C) { const int st = b / 1024, sb = b % 1024, swz = sb ^ (((sb >> 9) & 1) << 5); R = (st >> 1) * 16 + swz / 64; C = (st & 1) * 32 + (swz % 64) / 2; }
__host__ __device__ __forceinline__ int perm32(int rho) { const int n = rho >> 4, i = rho & 15; return 8 * (i >> 2) + 4 * n + (i & 3); }

struct Unit { int pm, pn, kt0, nkt, sub; };
struct Gemm { const bf16_t* A; const bf16_t* Bt; int K, halo, nMp; };
__device__ __forceinline__ int tile_row0(const Gemm& g, int pm) { return g.halo == 0 ? 256 * pm : (pm >= g.nMp ? ROWS_P : (256 - g.halo) * pm); }

struct StaticOrder {
    int nM, nN, nwg, G, c, nkt, nsub, nsplit, skt;
    __host__ __device__ __forceinline__ void init(int nM_, int nN_, int G_, int c_, int nkt_, int nsplit_ = 0, int skt_ = 0) { nM = nM_; nN = nN_; nwg = nM * nN; G = G_; c = c_; nkt = nkt_; nsplit = nsplit_; skt = skt_; nsub = nsplit_ * nN_; }
    __host__ __device__ __forceinline__ bool next(int i, Unit& u) const {
        const long L = (long)i * G + c; if (L >= nwg + nsub) return false;
        const bool is_sub = L >= nwg; const int s = is_sub ? (int)L - nwg : 0, nsp = nsplit > 0 ? nsplit : 1;
        int wgid = is_sub ? 0 : (int)L; { const int q = nwg / NXCD, r = nwg % NXCD, xcd = wgid % NXCD, off = wgid / NXCD; wgid = (xcd < r ? xcd * (q + 1) : r * (q + 1) + (xcd - r) * q) + off; }
        const int nig = WGM * nN, gid = wgid / nig, fm = gid * WGM, gsz = (nM - fm) < WGM ? (nM - fm) : WGM;
        const int pm_m = fm + ((wgid % nig) % gsz), pn_m = (wgid % nig) / gsz;
        u.pm = is_sub ? nM : pm_m; u.pn = is_sub ? s / nsp : pn_m; u.kt0 = is_sub ? skt * (s % nsp) : 0; u.nkt = is_sub ? skt : nkt; u.sub = is_sub ? s : -1;
        return true;
    }
};

template <class Epi, class Sched, bool ALIGN_EPI = false, bool SP2 = false>
__device__ __forceinline__ void gemm_phase(PG8_LAS unsigned char* lds, const Gemm g, const Sched& S, const Epi& E) {
    const int tid = threadIdx.x, wid = __builtin_amdgcn_readfirstlane(tid >> 6), lane = tid & 63, wr = wid >> 2, wc = wid & 3, fr = lane & 15, fq = lane >> 4;
    const int K = g.K;
    unsigned voffA[2], voffB[2];
#pragma unroll
    for (int i = 0; i < 2; ++i) { int R, C; stage_rc(tid * 16 + i * 8192, R, C); const int Rb = Epi::PERM ? ((R & ~31) + perm32(R & 31)) : R;
        voffA[i] = (unsigned)(R * K + C) * 2u; voffB[i] = (unsigned)(Rb * K + C) * 2u; }
    const size_t kstep = (size_t)(BK * 2);
    const size_t hstep = (size_t)HALF * K * 2;
    const size_t tstep = 2 * hstep;
    const size_t rstep = (size_t)K * 2;
    const unsigned ldsw = (unsigned)wid * 1024u;
    const int aoff = lds_byte(wr * 64 + fr, fq * 8), boff = lds_byte(wc * 32 + fr, fq * 8);
#define PG8_SA(b, h) (((b) * 2 + (h)) * HTB)
#define PG8_SB(b, h) ((4 + (b) * 2 + (h)) * HTB)
#define PG8_STAGE(bufoff, gbase, voff) do { _Pragma("unroll") for (int _i = 0; _i < 2; ++_i) \
        __builtin_amdgcn_global_load_lds((const unsigned*)((const char*)(gbase) + (voff)[_i]), (PG8_LAS unsigned*)(lds + (bufoff) + ldsw + _i * 8192), 16, 0, 0); } while (0)
#define PG8_LDA(dst, b, h) do { _Pragma("unroll") for (int m = 0; m < 4; ++m) _Pragma("unroll") for (int k = 0; k < 2; ++k) dst[m][k] = *(const PG8_LAS bf16x8*)(lds + PG8_SA(b, h) + aoff + m * 2048 + k * 1024); } while (0)
#define PG8_LDB(dst, b, h) do { _Pragma("unroll") for (int n = 0; n < 2; ++n) _Pragma("unroll") for (int k = 0; k < 2; ++k) dst[n][k] = *(const PG8_LAS bf16x8*)(lds + PG8_SB(b, h) + boff + n * 2048 + k * 1024); } while (0)
#define PG8_MMA(ai, bj, At, Bt) do { __builtin_amdgcn_s_setprio(1); _Pragma("unroll") for (int m = 0; m < 4; ++m) _Pragma("unroll") for (int n = 0; n < 2; ++n) _Pragma("unroll") for (int k = 0; k < 2; ++k) \
        acc[ai][bj][m][n] = __builtin_amdgcn_mfma_f32_16x16x32_bf16(Bt[n][k], At[m][k], acc[ai][bj][m][n], 0, 0, 0); __builtin_amdgcn_s_setprio(0); } while (0)
#define PG8_WAIT_V(n) asm volatile("s_waitcnt vmcnt(" #n ")" ::: "memory")
#define PG8_WAIT_L(n) asm volatile("s_waitcnt lgkmcnt(" #n ")" ::: "memory")
#define PG8_BAR __builtin_amdgcn_s_barrier()
#define PG8_SCHED __builtin_amdgcn_sched_barrier(0)
    Unit cur, nxt; int ui = 0;
    if (!S.next(0, cur)) return;
    f32x4 acc[2][2][4][2];
#pragma unroll
    for (int a = 0; a < 2; ++a)
#pragma unroll
        for (int b = 0; b < 2; ++b)
#pragma unroll
            for (int m = 0; m < 4; ++m)
#pragma unroll
                for (int n = 0; n < 2; ++n) acc[a][b][m][n] = (f32x4){0.f, 0.f, 0.f, 0.f};
    bf16x8 At[4][2], B0[2][2], B1[2][2];
    const char* cA = (const char*)g.A + (size_t)tile_row0(g, cur.pm) * rstep + (size_t)cur.kt0 * kstep; const char* cB = (const char*)g.Bt + (size_t)cur.pn * tstep + (size_t)cur.kt0 * kstep;
    if constexpr (SP2) {
        PG8_STAGE(PG8_SB(0, 0), cB, voffB); PG8_STAGE(PG8_SB(0, 1), cB + hstep, voffB); PG8_STAGE(PG8_SA(0, 0), cA, voffA); PG8_STAGE(PG8_SA(0, 1), cA + hstep, voffA);
        if (wr == 1) PG8_BAR;
        PG8_WAIT_V(2); PG8_BAR;
        PG8_STAGE(PG8_SB(1, 0), cB + kstep, voffB); PG8_STAGE(PG8_SA(1, 0), cA + kstep, voffA); PG8_STAGE(PG8_SB(1, 1), cB + hstep + kstep, voffB);
        PG8_WAIT_V(6); PG8_BAR;
    } else {
        PG8_STAGE(PG8_SB(0, 0), cB, voffB); PG8_STAGE(PG8_SA(0, 0), cA, voffA); PG8_STAGE(PG8_SB(0, 1), cB + hstep, voffB); PG8_STAGE(PG8_SA(0, 1), cA + hstep, voffA);
        if (wr == 1) PG8_BAR;
        PG8_WAIT_V(4); PG8_BAR;
        PG8_STAGE(PG8_SB(1, 0), cB + kstep, voffB); PG8_STAGE(PG8_SA(1, 0), cA + kstep, voffA); PG8_STAGE(PG8_SB(1, 1), cB + hstep + kstep, voffB);
        PG8_WAIT_V(6); PG8_BAR;
    }
    for (;;) {
        const bool has_next = S.next(ui + 1, nxt);
        const char* nA = has_next ? (const char*)g.A + (size_t)tile_row0(g, nxt.pm) * rstep + (size_t)nxt.kt0 * kstep : cA; const char* nB = has_next ? (const char*)g.Bt + (size_t)nxt.pn * tstep + (size_t)nxt.kt0 * kstep : cB;
        const int nt = cur.nkt;
        for (int t = 0; t < nt; t += 2) {
            const bool last = (t == nt - 2);
            const char* a1 = cA + (size_t)(t + 1) * kstep;
            const char* a2 = last ? nA : cA + (size_t)(t + 2) * kstep; const char* b2 = last ? nB : cB + (size_t)(t + 2) * kstep;
            const char* a3 = a2 + kstep; const char* b3 = b2 + kstep;
            if constexpr (SP2) {
            PG8_LDB(B0, 0, 0); PG8_LDB(B1, 0, 1); PG8_SCHED; PG8_LDA(At, 0, 0); PG8_STAGE(PG8_SA(1, 1), a1 + hstep, voffA);
            PG8_WAIT_V(8); PG8_WAIT_L(0); PG8_BAR; PG8_MMA(0, 0, At, B0); PG8_MMA(0, 1, At, B1); PG8_BAR; PG8_SCHED;
            PG8_LDA(At, 0, 1); PG8_STAGE(PG8_SB(0, 0), b2, voffB); PG8_STAGE(PG8_SB(0, 1), b2 + hstep, voffB); PG8_STAGE(PG8_SA(0, 0), a2, voffA);
            PG8_WAIT_V(8); PG8_WAIT_L(0); PG8_BAR; PG8_MMA(1, 0, At, B0); PG8_MMA(1, 1, At, B1); PG8_BAR; PG8_SCHED;
            PG8_LDB(B0, 1, 0); PG8_LDB(B1, 1, 1); PG8_SCHED; PG8_LDA(At, 1, 0); PG8_STAGE(PG8_SA(0, 1), a2 + hstep, voffA);
            PG8_WAIT_V(8); PG8_WAIT_L(0); PG8_BAR; PG8_MMA(0, 0, At, B0); PG8_MMA(0, 1, At, B1); PG8_BAR; PG8_SCHED;
            PG8_LDA(At, 1, 1); PG8_STAGE(PG8_SB(1, 0), b3, voffB); PG8_STAGE(PG8_SB(1, 1), b3 + hstep, voffB); PG8_STAGE(PG8_SA(1, 0), a3, voffA);
            PG8_WAIT_V(8); PG8_WAIT_L(0); PG8_BAR; PG8_MMA(1, 0, At, B0); PG8_MMA(1, 1, At, B1); PG8_BAR; PG8_SCHED;
            } else {
            PG8_LDB(B0, 0, 0); PG8_SCHED; PG8_LDA(At, 0, 0); PG8_STAGE(PG8_SA(1, 1), a1 + hstep, voffA);
            PG8_WAIT_L(8); PG8_BAR; PG8_WAIT_L(0); PG8_MMA(0, 0, At, B0); PG8_BAR; PG8_SCHED;
            PG8_LDB(B1, 0, 1); PG8_STAGE(PG8_SB(0, 0), b2, voffB);
            PG8_BAR; PG8_WAIT_L(0); PG8_MMA(0, 1, At, B1); PG8_BAR;
            PG8_LDA(At, 0, 1); PG8_STAGE(PG8_SA(0, 0), a2, voffA);
            PG8_BAR; PG8_WAIT_L(0); PG8_MMA(1, 0, At, B0); PG8_BAR; PG8_SCHED;
            PG8_STAGE(PG8_SB(0, 1), b2 + hstep, voffB);
            PG8_WAIT_V(6); PG8_BAR; PG8_MMA(1, 1, At, B1); PG8_BAR;
            PG8_LDB(B0, 1, 0); PG8_SCHED; PG8_LDA(At, 1, 0); PG8_STAGE(PG8_SA(0, 1), a2 + hstep, voffA);
            PG8_WAIT_L(8); PG8_BAR; PG8_WAIT_L(0); PG8_MMA(0, 0, At, B0); PG8_BAR; PG8_SCHED;
            PG8_LDB(B1, 1, 1); PG8_STAGE(PG8_SB(1, 0), b3, voffB);
            PG8_BAR; PG8_WAIT_L(0); PG8_MMA(0, 1, At, B1); PG8_BAR;
            PG8_LDA(At, 1, 1); PG8_STAGE(PG8_SA(1, 0), a3, voffA);
            PG8_BAR; PG8_WAIT_L(0); PG8_MMA(1, 0, At, B0); PG8_BAR; PG8_SCHED;
            PG8_STAGE(PG8_SB(1, 1), b3 + hstep, voffB);
            PG8_WAIT_V(6); PG8_BAR; PG8_MMA(1, 1, At, B1); PG8_BAR;
            }
        }
        if constexpr (ALIGN_EPI) { if (wr == 0) PG8_BAR; }
        E(acc, cur, tile_row0(g, cur.pm), wid, wr, wc, fr, fq);
        if (!has_next) break;
#pragma unroll
        for (int a = 0; a < 2; ++a)
#pragma unroll
            for (int b = 0; b < 2; ++b)
#pragma unroll
                for (int m = 0; m < 4; ++m)
#pragma unroll
                    for (int n = 0; n < 2; ++n) acc[a][b][m][n] = (f32x4){0.f, 0.f, 0.f, 0.f};
        cur = nxt; cA = nA; cB = nB; ++ui;
        if constexpr (ALIGN_EPI) { if (wr == 1) PG8_BAR; }
    }
    PG8_WAIT_V(0);
    if constexpr (!ALIGN_EPI) { if (wr == 0) PG8_BAR; }
    PG8_BAR;
#undef PG8_SA
#undef PG8_SB
#undef PG8_STAGE
#undef PG8_LDA
#undef PG8_LDB
#undef PG8_MMA
#undef PG8_WAIT_V
#undef PG8_WAIT_L
#undef PG8_BAR
#undef PG8_SCHED
}
}

typedef GAS unsigned gu32;
#define RLX_AGENT __ATOMIC_RELAXED, __HIP_MEMORY_SCOPE_AGENT
#define LDS_WAIT() asm volatile("s_waitcnt lgkmcnt(0)" ::: "memory")
#define VM_WAIT() asm volatile("s_waitcnt vmcnt(0)" ::: "memory")

#define XB_TMO      128
#define XB_XCNT(j)  (256  + 64 * (j))
#define XB_XSUB(j)  (1280 + 64 * (j))
#define XB_XGEN(j)  (2304 + 64 * (j))
#define XB_TOP      3328
#define XB_TOPGEN   3392
#define XCD_BAR_WORDS 3456
#define XB_SPIN_CAP (1u << 18)
__device__ __forceinline__ unsigned xb_ld(unsigned* p)              { return __hip_atomic_load(p, __ATOMIC_RELAXED, __HIP_MEMORY_SCOPE_AGENT); }
__device__ __forceinline__ unsigned xb_add(unsigned* p, unsigned v) { return __hip_atomic_fetch_add(p, v, __ATOMIC_RELAXED, __HIP_MEMORY_SCOPE_AGENT); }
__device__ __forceinline__ unsigned xb_xcc_id() { return (unsigned)__builtin_amdgcn_s_getreg((3 << 11) | 20) & 0xFu; }
#define XB_SPIN(cond, bar) do { unsigned _sp = 0; while (cond) { __builtin_amdgcn_s_sleep(1); \
    if ((++_sp & 255u) == 0u) { if (xb_ld(&(bar)[XB_TMO])) break; if (_sp > XB_SPIN_CAP) { atomicAdd(&(bar)[XB_TMO], 1u); break; } } } } while (0)
struct XcdBarrier { unsigned* bar; unsigned x; volatile LAS unsigned* st; };
__device__ __forceinline__ XcdBarrier xcd_barrier_post(unsigned* bar, volatile LAS unsigned* st) {
    XcdBarrier b; b.bar = bar; b.x = xb_xcc_id(); b.st = st;
    if (threadIdx.x == 0) (void)xb_add(&bar[XB_XCNT(b.x)], 1u);
    return b;
}
__device__ __forceinline__ void xcd_barrier_complete(unsigned* bar, unsigned x, unsigned& nloc, unsigned& nx) {
    const unsigned G = gridDim.x * gridDim.y * gridDim.z;
    unsigned sum, cnt, mine, sp = 0u;
    for (;;) {
        sum = 0u; cnt = 0u; mine = 0u;
#pragma unroll
        for (unsigned j = 0; j < 16; ++j) { const unsigned c = xb_ld(&bar[XB_XCNT(j)]); sum += c; cnt += (c > 0u) ? 1u : 0u; mine = (j == x) ? c : mine; }
        if (sum == G) break;
        __builtin_amdgcn_s_sleep(1);
        if ((++sp & 255u) == 0u) { if (xb_ld(&bar[XB_TMO])) break; if (sp > XB_SPIN_CAP) { atomicAdd(&bar[XB_TMO], 1u); break; } }
    }
    nloc = mine > 0u ? mine : 1u; nx = cnt > 0u ? cnt : 1u;
}
__device__ __forceinline__ void xcd_barrier(const XcdBarrier& b) {
    asm volatile("s_waitcnt vmcnt(0)" ::: "memory");
    __syncthreads();
    if (threadIdx.x == 0) {
        unsigned* bar = b.bar;
        __builtin_amdgcn_s_waitcnt(0);
        unsigned nloc = b.st[0], nx = b.st[1];
        if (nloc == 0u) { xcd_barrier_complete(bar, b.x, nloc, nx); b.st[0] = nloc; b.st[1] = nx; }
        const unsigned old = xb_add(&bar[XB_XSUB(b.x)], 1u);
        const unsigned gen = old / nloc;
        if (old + 1u == (gen + 1u) * nloc) {
            __builtin_amdgcn_fence(__ATOMIC_RELEASE, "agent");
            asm volatile("s_waitcnt vmcnt(0)" ::: "memory");
            const unsigned og = xb_add(&bar[XB_TOP], 1u);
            const unsigned tg = og / nx;
            if (og + 1u == (tg + 1u) * nx) xb_add(&bar[XB_TOPGEN], 1u);
            else XB_SPIN(xb_ld(&bar[XB_TOPGEN]) == tg, bar);
            __builtin_amdgcn_fence(__ATOMIC_ACQUIRE, "agent");
            xb_add(&bar[XB_XGEN(b.x)], 1u);
            asm volatile("s_waitcnt vmcnt(0)" ::: "memory");
        } else {
            XB_SPIN(xb_ld(&bar[XB_XGEN(b.x)]) == gen, bar);
            __builtin_amdgcn_fence(__ATOMIC_ACQUIRE, "agent");
            asm volatile("s_waitcnt vmcnt(0)" ::: "memory");
        }
    }
    __syncthreads();
}

constexpr int NWAVES = 8;
struct Args { const float* in[29]; float* out; unsigned char* ws; int ph_lo, ph_hi; };
struct Frame {
    LAS unsigned char* lds;
    int tid, lane, wave, vcu, G;
    const float* const* in;
    float* out; unsigned char* ws;
};
__device__ __forceinline__ float wave_sum(float v) {
#pragma unroll
    for (int o = 1; o < 16; o <<= 1) v += __shfl_xor(v, o);
    return xsum_16_32(v);
}
__device__ __forceinline__ float row_rs(const float* SS, int row, int fq) {
    const f32x4* p = (const f32x4*)((const char*)SS + (unsigned)(row * 128 + fq * 32));
    const f32x4 a = p[0], b = p[1];
    float s = (a.x + a.y) + (a.z + a.w) + (b.x + b.y) + (b.z + b.w);
    s = xsum_16_32(s);
    return __builtin_amdgcn_rsqf(s * (1.f / DM) + EPS);
}
template <int D> __device__ __forceinline__ float dpp_shift(float cur, float prevblk) {
    const int o = __builtin_amdgcn_mov_dpp(__builtin_bit_cast(int, prevblk), 0x120 + D, 0xf, 0xf, true);
    const int r = __builtin_amdgcn_update_dpp(o, __builtin_bit_cast(int, cur), 0x110 + D, 0xf, 0xf, false);
    return __builtin_bit_cast(float, r);
}

struct EpiNull {
    static constexpr bool PERM = true;
    __device__ __forceinline__ void operator()(const f32x4 (&acc)[2][2][4][2], const pg8::Unit& u, int row0, int wid, int wr, int wc, int fr, int fq) const {
#pragma unroll
        for (int ai = 0; ai < 2; ++ai)
#pragma unroll
            for (int bj = 0; bj < 2; ++bj)
#pragma unroll
                for (int m = 0; m < 4; ++m)
#pragma unroll
                    for (int n = 0; n < 2; ++n) asm volatile("" :: "v"(acc[ai][bj][m][n]));
    }
};
__device__ __forceinline__ float* yrow_ptr(float* out, int row) {
    if (row >= ROWS_P) return out + O_YS + (size_t)(row - ROWS_P) * DM;
    const int b = row / TP, pos = row - b * TP;
    return pos < NMETA ? nullptr : out + O_YP + ((size_t)b * SEQ + (pos - NMETA)) * DM;
}
struct EpiGlu {
    static constexpr bool PERM = true;
    const float* xp; const float* xsmp; const float* meta; bf16* XB; float* SS; float* slab;
    __device__ __forceinline__ void operator()(const f32x4 (&acc)[2][2][4][2], const pg8::Unit& u, int row0, int wid, int wr, int wc, int fr_, int fq_) const {
        int t_ = (int)threadIdx.x; asm volatile("" : "+v"(t_)); const int fr = t_ & 15, fq = (t_ >> 4) & 3;
        if (u.sub >= 0) {
            float* sl = slab + (size_t)u.sub * 65536;
#pragma unroll
            for (int ai = 0; ai < 2; ++ai)
#pragma unroll
                for (int m = 0; m < 4; ++m)
#pragma unroll
                    for (int bj = 0; bj < 2; ++bj)
#pragma unroll
                        for (int n = 0; n < 2; ++n) *(f32x4*)(sl + (size_t)(128 * ai + 64 * wr + 16 * m + fr) * 256 + 128 * bj + 32 * wc + 8 * fq + 4 * n) = acc[ai][bj][m][n];
            return;
        }
        const int col = 128 * u.pn + 32 * wc + 8 * fq;
        f32x4 xv[2][4][2];
#pragma unroll
        for (int ai = 0; ai < 2; ++ai)
#pragma unroll
            for (int m = 0; m < 4; ++m) { const float* xi = xin_ptr(xp, xsmp, meta, row0 + 128 * ai + 64 * wr + 16 * m + fr) + col;
                xv[ai][m][0] = *(const f32x4*)xi; xv[ai][m][1] = *(const f32x4*)(xi + 4); }
#pragma unroll
        for (int ai = 0; ai < 2; ++ai)
#pragma unroll
            for (int m = 0; m < 4; ++m) {
                const int row = row0 + 128 * ai + 64 * wr + 16 * m + fr;
                float ss = 0.f; f32x4 v[2];
#pragma unroll
                for (int n = 0; n < 2; ++n) { const f32x4 a = acc[ai][0][m][n], b = acc[ai][1][m][n], x = xv[ai][m][n];
#pragma unroll
                    for (int j = 0; j < 4; ++j) { v[n][j] = x[j] + a[j] * sigmoidf_(b[j]); ss += v[n][j] * v[n][j]; } }
                u32x4 w; w.x = pk2(v[0][0], v[0][1]); w.y = pk2(v[0][2], v[0][3]); w.z = pk2(v[1][0], v[1][1]); w.w = pk2(v[1][2], v[1][3]);
                *(u32x4*)(XB + (size_t)row * DM + col) = w;
                ss = xsum_16_32(ss);
                if (fq == 0) SS[(size_t)row * 32 + u.pn * 4 + wc] = ss;
            }
    }
};
template <bool FINAL> struct EpiRes {
    static constexpr bool PERM = true;
    bf16* XB; float* out; float* SS; float* slab;
    __device__ __forceinline__ void operator()(const f32x4 (&acc)[2][2][4][2], const pg8::Unit& u, int row0, int wid, int wr, int wc, int fr_, int fq_) const {
        int t_ = (int)threadIdx.x; asm volatile("" : "+v"(t_)); const int fr = t_ & 15, fq = (t_ >> 4) & 3;
        if (u.sub >= 0) {
            float* sl = slab + (size_t)u.sub * 65536;
#pragma unroll
            for (int ai = 0; ai < 2; ++ai)
#pragma unroll
                for (int m = 0; m < 4; ++m)
#pragma unroll
                    for (int bj = 0; bj < 2; ++bj)
#pragma unroll
                        for (int n = 0; n < 2; ++n) *(f32x4*)(sl + (size_t)(128 * ai + 64 * wr + 16 * m + fr) * 256 + 128 * bj + 32 * wc + 8 * fq + 4 * n) = acc[ai][bj][m][n];
            return;
        }
        u32x4 xv[2][4][2];
#pragma unroll
        for (int ai = 0; ai < 2; ++ai)
#pragma unroll
            for (int m = 0; m < 4; ++m)
#pragma unroll
                for (int bj = 0; bj < 2; ++bj) xv[ai][m][bj] = *(const u32x4*)(XB + (size_t)(row0 + 128 * ai + 64 * wr + 16 * m + fr) * DM + 256 * u.pn + 128 * bj + 32 * wc + 8 * fq);
#pragma unroll
        for (int ai = 0; ai < 2; ++ai)
#pragma unroll
            for (int m = 0; m < 4; ++m) {
                const int row = row0 + 128 * ai + 64 * wr + 16 * m + fr;
                float* yr = FINAL ? yrow_ptr(out, row) : nullptr;
#pragma unroll
                for (int bj = 0; bj < 2; ++bj) {
                    const int col = 256 * u.pn + 128 * bj + 32 * wc + 8 * fq;
                    const u32x4 x = xv[ai][m][bj];
                    f32x4 v[2]; v[0] = (f32x4){bflo(x.x), bfhi(x.x), bflo(x.y), bfhi(x.y)} + acc[ai][bj][m][0]; v[1] = (f32x4){bflo(x.z), bfhi(x.z), bflo(x.w), bfhi(x.w)} + acc[ai][bj][m][1];
                    float ss = (v[0].x * v[0].x + v[0].y * v[0].y) + (v[0].z * v[0].z + v[0].w * v[0].w) + (v[1].x * v[1].x + v[1].y * v[1].y) + (v[1].z * v[1].z + v[1].w * v[1].w);
                    if (FINAL) { if (yr) { *(f32x4*)(yr + col) = v[0]; *(f32x4*)(yr + col + 4) = v[1]; } }
                    else { u32x4 w; w.x = pk2(v[0][0], v[0][1]); w.y = pk2(v[0][2], v[0][3]); w.z = pk2(v[1][0], v[1][1]); w.w = pk2(v[1][2], v[1][3]);
                        *(u32x4*)(XB + (size_t)row * DM + col) = w; }
                    ss = xsum_16_32(ss);
                    if (fq == 0) SS[(size_t)row * 32 + u.pn * 8 + wc * 2 + bj] = ss;
                }
            }
    }
};
template <bool FINAL> __device__ __forceinline__ void res_fixup(Frame& F, bf16* XB, float* SS, const float* slab, int nsplit) {
    for (int r = F.vcu; r < 256; r += F.G) {
        const int row = 64 * 256 + r;
        const int col = 2 * F.tid, pn = col >> 8, cc = col & 255;
        const unsigned xb = *(const unsigned*)(XB + (size_t)row * DM + col);
        f32x2 v = (f32x2){bflo(xb), bfhi(xb)};
        for (int s = 0; s < nsplit; ++s) v += *(const f32x2*)(slab + ((size_t)(pn * nsplit + s) * 256 + r) * 256 + cc);
        if (FINAL) { float* yr = yrow_ptr(F.out, row); if (yr) *(f32x2*)(yr + col) = v; }
        else *(unsigned*)(XB + (size_t)row * DM + col) = pk2(v.x, v.y);
        float ss = v.x * v.x + v.y * v.y;
        ss += __shfl_xor(ss, 1); ss += __shfl_xor(ss, 2); ss += __shfl_xor(ss, 4); ss += __shfl_xor(ss, 8);
        if ((F.tid & 15) == 0) { const int g32 = col >> 5; SS[(size_t)row * 32 + (g32 >> 3) * 8 + (g32 & 3) * 2 + ((g32 >> 2) & 1)] = ss; }
    }
}
__device__ __forceinline__ void glu_fixup(Frame& F, bf16* XB, float* SS, const float* slab, int nsplit) {
    for (int r = F.vcu; r < 256; r += F.G) {
        const int row = 64 * 256 + r, ch = 2 * F.tid, pn = ch >> 7, cc = ch & 127;
        f32x2 a = (f32x2){0.f, 0.f}, g = a;
        for (int s = 0; s < nsplit; ++s) { const float* sl = slab + ((size_t)(pn * nsplit + s) * 256 + r) * 256; a += *(const f32x2*)(sl + cc); g += *(const f32x2*)(sl + 128 + cc); }
        const f32x2 x = *(const f32x2*)(xin_ptr(F.in[0], F.in[1], F.in[7], row) + ch);
        const f32x2 v = (f32x2){x.x + a.x * sigmoidf_(g.x), x.y + a.y * sigmoidf_(g.y)};
        *(unsigned*)(XB + (size_t)row * DM + ch) = pk2(v.x, v.y);
        float ss = v.x * v.x + v.y * v.y;
        ss += __shfl_xor(ss, 1); ss += __shfl_xor(ss, 2); ss += __shfl_xor(ss, 4); ss += __shfl_xor(ss, 8);
        if ((F.tid & 15) == 0) SS[(size_t)row * 32 + (ch >> 5)] = ss;
    }
}
__device__ __forceinline__ int exch_off(int ai, int wave, int g4, int fr, int fq) { return ((((ai * 8 + wave) * 4 + g4) * 12) + (fr - 13) * 4 + fq) * 16; }
__device__ __forceinline__ void exch_publish(LAS unsigned char* ex, const f32x4 (&acc)[2][2][4][2], const float (&rs)[2][4], int wid, int fr, int fq) {
    if (fr >= 13) {
#pragma unroll
        for (int ai = 0; ai < 2; ++ai)
#pragma unroll
            for (int g4 = 0; g4 < 4; ++g4) *(LAS f32x4*)(ex + exch_off(ai, wid, g4, fr, fq)) = acc[ai][g4 >> 1][3][g4 & 1] * rs[ai][3];
    }
    asm volatile("s_waitcnt lgkmcnt(0)" ::: "memory");
    __builtin_amdgcn_s_barrier();
    asm volatile("" ::: "memory");
}
__device__ __forceinline__ f32x4 exch_prev(LAS unsigned char* ex, int ai, int wid, int wr, int g4, int fr, int fq) {
    f32x4 p = (f32x4){0.f, 0.f, 0.f, 0.f};
    if (fr >= 13) {
        if (wr == 1) p = *(const LAS f32x4*)(ex + exch_off(ai, wid - 4, g4, fr, fq));
        else if (ai == 1) p = *(const LAS f32x4*)(ex + exch_off(0, wid + 4, g4, fr, fq));
    }
    return p;
}
struct EpiUp {
    static constexpr bool PERM = true;
    bf16* ACT; const float* SS; const float* cw; const float* st; float* pf; float* sf; LAS unsigned char* ex; int nMp;
    __device__ __forceinline__ void operator()(const f32x4 (&acc)[2][2][4][2], const pg8::Unit& u, int row0, int wid, int wr, int wc, int fr_, int fq_) const {
        int t_ = (int)threadIdx.x; asm volatile("" : "+v"(t_)); const int fr = t_ & 15, fq = (t_ >> 4) & 3;
        const bool sample = (u.pm >= nMp);
        const int lo = (u.pm == 0 || sample) ? 0 : 2;
        float rs[2][4];
#pragma unroll
        for (int ai = 0; ai < 2; ++ai)
#pragma unroll
            for (int m = 0; m < 4; ++m) rs[ai][m] = row_rs(SS, row0 + 128 * ai + 64 * wr + 16 * m + fr, fq);
        exch_publish(ex, acc, rs, wid, fr, fq);
        if (!sample) {
            const int p0_ = row0 - (row0 / TP) * TP; const bool edge = (p0_ < 2) || (p0_ + 256 > TP - 2) || (row0 + 256 > ROWS_P);
#define EPIUP_PROMPT(EDGE) \
            _Pragma("unroll") for (int n = 0; n < 2; ++n) { \
                const int ch = 128 * u.pn + 32 * wc + 8 * fq + 4 * n; \
                const f32x4 w0a = *(const f32x4*)(cw + ch), w1a = *(const f32x4*)(cw + UPN + ch), w2a = *(const f32x4*)(cw + 2 * UPN + ch); \
                const f32x4 w0b = *(const f32x4*)(cw + DFF + ch), w1b = *(const f32x4*)(cw + UPN + DFF + ch), w2b = *(const f32x4*)(cw + 2 * UPN + DFF + ch); \
                asm volatile("" :: "v"(w0a), "v"(w1a), "v"(w2a), "v"(w0b), "v"(w1b), "v"(w2b));     \
                _Pragma("unroll") for (int ai = 0; ai < 2; ++ai) { \
                    f32x4 pa = exch_prev(ex, ai, wid, wr, n, fr, fq), pb = exch_prev(ex, ai, wid, wr, 2 + n, fr, fq); \
                    _Pragma("unroll") for (int m = 0; m < 4; ++m) { \
                        const int R = 128 * ai + 64 * wr + 16 * m + fr, row = row0 + R; \
                        const float rsv = rs[ai][m]; const f32x4 ca = acc[ai][0][m][n] * rsv, cb = acc[ai][1][m][n] * rsv; \
                        const int b = (EDGE) ? row / TP : 0, pos = (EDGE) ? row - b * TP : 2; \
                        const float m1 = pos >= 1 ? 1.f : 0.f, m2 = pos >= 2 ? 1.f : 0.f; \
                        f32x4 o; \
                        _Pragma("unroll") for (int j = 0; j < 4; ++j) { \
                            float s1a = dpp_shift<1>(ca[j], pa[j]), s2a = dpp_shift<2>(ca[j], pa[j]), s1b = dpp_shift<1>(cb[j], pb[j]), s2b = dpp_shift<2>(cb[j], pb[j]); \
                            if (EDGE) { s1a *= m1; s2a *= m2; s1b *= m1; s2b *= m2; } \
                            const float ua = w2a[j] * ca[j] + w1a[j] * s1a + w0a[j] * s2a, ub = w2b[j] * cb[j] + w1b[j] * s1b + w0b[j] * s2b; \
                            o[j] = siluf_(ua) * ub; \
                        } \
                        if (R >= lo && ((EDGE) ? row < ROWS_P : true)) { \
                            u32x2 w; w.x = pk2(o[0], o[1]); w.y = pk2(o[2], o[3]); \
                            *(u32x2*)(ACT + (size_t)row * DFF + ch) = w; \
                            if ((EDGE) && pos >= TP - 2) { float* d = pf + (size_t)(b * 2 + pos - (TP - 2)) * UPN + ch; *(f32x4*)d = ca; *(f32x4*)(d + DFF) = cb; } \
                        } \
                        pa = ca; pb = cb; \
                    } \
                } \
            }
            if (edge) { asm volatile("" ::: "memory"); EPIUP_PROMPT(true) } else { asm volatile("" ::: "memory"); EPIUP_PROMPT(false) }
#undef EPIUP_PROMPT
        } else {
#pragma unroll
            for (int n = 0; n < 2; ++n) {
                const int ch = 128 * u.pn + 32 * wc + 8 * fq + 4 * n;
                const f32x4 w0a = *(const f32x4*)(cw + ch), w1a = *(const f32x4*)(cw + UPN + ch), w2a = *(const f32x4*)(cw + 2 * UPN + ch);
                const f32x4 w0b = *(const f32x4*)(cw + DFF + ch), w1b = *(const f32x4*)(cw + UPN + DFF + ch), w2b = *(const f32x4*)(cw + 2 * UPN + DFF + ch);
#pragma unroll
                for (int m = 0; m < 4; ++m) {
                    const int s = 64 * wr + 16 * m + fr, row = row0 + s;
                    const float rsv = rs[0][m]; const f32x4 ca = acc[0][0][m][n] * rsv, cb = acc[0][1][m][n] * rsv;
                    const float* s0 = st + (size_t)(s * 2) * UPN + ch; const float* s1 = s0 + UPN;
                    const f32x4 a0 = *(const f32x4*)s0, a1 = *(const f32x4*)s1, b0 = *(const f32x4*)(s0 + DFF), b1 = *(const f32x4*)(s1 + DFF);
                    f32x4 o;
#pragma unroll
                    for (int j = 0; j < 4; ++j) { const float ua = w2a[j] * ca[j] + w1a[j] * a1[j] + w0a[j] * a0[j], ub = w2b[j] * cb[j] + w1b[j] * b1[j] + w0b[j] * b0[j]; o[j] = siluf_(ua) * ub; }
                    u32x2 w; w.x = pk2(o[0], o[1]); w.y = pk2(o[2], o[3]);
                    *(u32x2*)(ACT + (size_t)row * DFF + ch) = w;
                    float* d0 = sf + (size_t)(s * 2) * UPN + ch; float* d1 = d0 + UPN;
                    *(f32x4*)d0 = a1; *(f32x4*)(d0 + DFF) = b1; *(f32x4*)d1 = ca; *(f32x4*)(d1 + DFF) = cb;
                }
            }
        }
    }
};
struct EpiIn {
    static constexpr bool PERM = true;
    bf16* QKV; bf16* GATE; float* AB; const float* SS; const float* cw; const float* st; float* pg; float* sg; LAS unsigned char* ex; int nMp; GAS unsigned* pub;
    __device__ __forceinline__ void operator()(const f32x4 (&acc)[2][2][4][2], const pg8::Unit& u, int row0, int wid, int wr, int wc, int fr_, int fq_) const {
        int t_ = (int)threadIdx.x; asm volatile("" : "+v"(t_)); const int fr = t_ & 15, fq = (t_ >> 4) & 3;
        const bool sample = (u.pm >= nMp);
        const int lo = (u.pm == 0 || sample) ? 0 : 3;
        float rs[2][4];
#pragma unroll
        for (int ai = 0; ai < 2; ++ai)
#pragma unroll
            for (int m = 0; m < 4; ++m) rs[ai][m] = row_rs(SS, row0 + 128 * ai + 64 * wr + 16 * m + fr, fq);
        exch_publish(ex, acc, rs, wid, fr, fq);
        if (u.pn < 12 && !sample) {
            const int p0_ = row0 - (row0 / TP) * TP; const bool edge = (p0_ < 3) || (p0_ + 256 > TP - 3) || (row0 + 256 > ROWS_P);
#define EPIIN_PROMPT(EDGE) \
            _Pragma("unroll") for (int g4 = 0; g4 < 4; ++g4) { \
                const int bj = g4 >> 1, n = g4 & 1, col = 256 * u.pn + 128 * bj + 32 * wc + 8 * fq + 4 * n; \
                const f32x4 w0 = *(const f32x4*)(cw + col), w1 = *(const f32x4*)(cw + GCONV + col), w2 = *(const f32x4*)(cw + 2 * GCONV + col), w3 = *(const f32x4*)(cw + 3 * GCONV + col); \
                asm volatile("" :: "v"(w0), "v"(w1), "v"(w2), "v"(w3));     \
                _Pragma("unroll") for (int ai = 0; ai < 2; ++ai) { \
                    f32x4 p = exch_prev(ex, ai, wid, wr, g4, fr, fq); \
                    _Pragma("unroll") for (int m = 0; m < 4; ++m) { \
                        const int R = 128 * ai + 64 * wr + 16 * m + fr, row = row0 + R; \
                        const float rsv = rs[ai][m]; const f32x4 c = acc[ai][bj][m][n] * rsv; \
                        const int b = (EDGE) ? row / TP : 0, pos = (EDGE) ? row - b * TP : 3; \
                        const float m1 = pos >= 1 ? 1.f : 0.f, m2 = pos >= 2 ? 1.f : 0.f, m3 = pos >= 3 ? 1.f : 0.f; \
                        f32x4 o; \
                        _Pragma("unroll") for (int j = 0; j < 4; ++j) { \
                            float s1 = dpp_shift<1>(c[j], p[j]), s2 = dpp_shift<2>(c[j], p[j]), s3 = dpp_shift<3>(c[j], p[j]); \
                            if (EDGE) { s1 *= m1; s2 *= m2; s3 *= m3; } \
                            o[j] = siluf_(w3[j] * c[j] + w2[j] * s1 + w1[j] * s2 + w0[j] * s3); \
                        } \
                        if (R >= lo && ((EDGE) ? row < ROWS_P : true)) { \
                            u32x2 w; w.x = pk2(o[0], o[1]); w.y = pk2(o[2], o[3]); \
                            *(u32x2*)(QKV + (size_t)row * GCONV + col) = w; \
                            if ((EDGE) && pos >= TP - 3) *(f32x4*)(pg + (size_t)(b * 3 + pos - (TP - 3)) * GCONV + col) = c; \
                        } \
                        p = c; \
                    } \
                } \
            }
            if (edge) { asm volatile("" ::: "memory"); EPIIN_PROMPT(true) } else { asm volatile("" ::: "memory"); EPIIN_PROMPT(false) }
#undef EPIIN_PROMPT
        } else if (u.pn < 12) {
#pragma unroll
            for (int g4 = 0; g4 < 4; ++g4) {
                const int bj = g4 >> 1, n = g4 & 1, col = 256 * u.pn + 128 * bj + 32 * wc + 8 * fq + 4 * n;
                const f32x4 w0 = *(const f32x4*)(cw + col), w1 = *(const f32x4*)(cw + GCONV + col), w2 = *(const f32x4*)(cw + 2 * GCONV + col), w3 = *(const f32x4*)(cw + 3 * GCONV + col);
#pragma unroll
                for (int m = 0; m < 4; ++m) {
                    const int s = 64 * wr + 16 * m + fr, row = row0 + s;
                    const float rsv = rs[0][m]; const f32x4 c = acc[0][bj][m][n] * rsv;
                    const float* sp = st + (size_t)(s * 3) * GCONV + col;
                    const f32x4 t0 = *(const f32x4*)sp, t1 = *(const f32x4*)(sp + GCONV), t2 = *(const f32x4*)(sp + 2 * GCONV);
                    f32x4 o;
#pragma unroll
                    for (int j = 0; j < 4; ++j) o[j] = siluf_(w3[j] * c[j] + w2[j] * t2[j] + w1[j] * t1[j] + w0[j] * t0[j]);
                    u32x2 w; w.x = pk2(o[0], o[1]); w.y = pk2(o[2], o[3]);
                    *(u32x2*)(QKV + (size_t)row * GCONV + col) = w;
                    float* d = sg + (size_t)(s * 3) * GCONV + col;
                    *(f32x4*)d = t1; *(f32x4*)(d + GCONV) = t2; *(f32x4*)(d + 2 * GCONV) = c;
                }
            }
        } else {
#pragma unroll
            for (int ai = 0; ai < 2; ++ai)
#pragma unroll
                for (int m = 0; m < 4; ++m) {
                    const int R = 128 * ai + 64 * wr + 16 * m + fr, row = row0 + R;
                    const bool valid = sample ? (ai == 0) : (R >= lo && row < ROWS_P);
                    const float rsv = rs[ai][m];
                    if (!valid) continue;
                    if (u.pn < 16) {
#pragma unroll
                        for (int bj = 0; bj < 2; ++bj) {
                            const f32x4 c0 = acc[ai][bj][m][0] * rsv, c1 = acc[ai][bj][m][1] * rsv;
                            u32x4 w; w.x = pk2(c0[0], c0[1]); w.y = pk2(c0[2], c0[3]); w.z = pk2(c1[0], c1[1]); w.w = pk2(c1[2], c1[3]);
                            *(u32x4*)(GATE + (size_t)row * DM + 256 * (u.pn - 12) + 128 * bj + 32 * wc + 8 * fq) = w;
                        }
                    } else if (wc == 0 && fq < 2) {
                        *(f32x4*)(AB + (size_t)row * 16 + 8 * fq) = acc[ai][0][m][0] * rsv;
                        *(f32x4*)(AB + (size_t)row * 16 + 8 * fq + 4) = acc[ai][0][m][1] * rsv;
                    }
                }
        }
        if (u.pm == 0) {
            asm volatile("s_waitcnt vmcnt(0)" ::: "memory");
            __syncthreads();
            if (threadIdx.x == 0) { __builtin_amdgcn_fence(__ATOMIC_RELEASE, "agent"); asm volatile("s_waitcnt vmcnt(0)" ::: "memory"); __hip_atomic_fetch_add(pub, 1u, __ATOMIC_RELAXED, __HIP_MEMORY_SCOPE_AGENT); }
        }
    }
};
#ifdef SEG_ID
#define SEGT(i) do { __builtin_amdgcn_sched_barrier(0); if (F.vcu == SEG_BLOCK && F.tid == 0) { const unsigned long long t_ = __builtin_amdgcn_s_memrealtime(); volatile LAS unsigned long long* a_ = (volatile LAS unsigned long long*)(F.lds + LDSCTL_OFF + 64); \
    if ((i) == SEG_ID) a_[1] = t_; if ((i) == SEG_ID + 1) a_[0] += t_ - a_[1]; } __builtin_amdgcn_sched_barrier(0); } while (0)
#else
#define SEGT(i) do {} while (0)
#endif

__device__ __forceinline__ void tr_item(const float* W, int ldw, int K, bf16* WT, int n0, int src0, int nvalid, int k0, const float* scale, LAS float* scr, int lane) {
    const int j = lane & 31;
    float tv[32];
    const int jc = (j < nvalid) ? j : 0; const float jm = (j < nvalid) ? 1.f : 0.f;
#pragma unroll
    for (int i = 0; i < 32; ++i) { const int kk = 2 * i + (lane >> 5); tv[i] = W[(size_t)(k0 + kk) * ldw + src0 + jc]; }
    if (scale) {
        float sc[32];
#pragma unroll
        for (int i = 0; i < 32; ++i) sc[i] = scale[k0 + 2 * i + (lane >> 5)];
#pragma unroll
        for (int i = 0; i < 32; ++i) tv[i] *= sc[i];
    }
#pragma unroll
    for (int i = 0; i < 32; ++i) { const int kk = 2 * i + (lane >> 5); scr[kk * 33 + j] = tv[i] * jm; }
    LDS_WAIT(); asm volatile("" ::: "memory");
    const int c = lane & 7;
#pragma unroll
    for (int jj = 0; jj < 4; ++jj) { const int n = (lane >> 3) + 8 * jj; const LAS float* s = scr + (8 * c) * 33 + n;
        u32x4 o; o.x = pk2(s[0 * 33], s[1 * 33]); o.y = pk2(s[2 * 33], s[3 * 33]); o.z = pk2(s[4 * 33], s[5 * 33]); o.w = pk2(s[6 * 33], s[7 * 33]);
        *(u32x4*)(WT + (size_t)(n0 + n) * K + k0 + 8 * c) = o; }
    LDS_WAIT(); asm volatile("" ::: "memory");
}
__device__ __forceinline__ int glu_src(int n0, int half_stride) { const int pn = n0 >> 8, bj = (n0 >> 7) & 1, cc0 = n0 & 127; return bj * half_stride + 128 * pn + cc0; }

__device__ __forceinline__ void p0_s5_group(Frame& F, int g, int qtr) {
    const float* lam_re = F.in[11]; const float* lam_im = F.in[12]; const float* log_step = F.in[13];
    const float* b_re = F.in[14]; const float* b_im = F.in[15]; const float* c_re = F.in[16]; const float* c_im = F.in[17]; const float* dsk = F.in[18];
    LAS float* LP = (LAS float*)(F.lds);
    LAS float* BB = (LAS float*)(F.lds + 8704);
    LAS float* CC = (LAS float*)(F.lds + 16896);
    LAS float* KT = (LAS float*)(F.lds + 25088);
    const float dl = __expf(log_step[g]);
    for (int idx = F.tid; idx < 17 * 64; idx += 512) { const int n = idx >> 6, p = idx & 63;
        const float lre = lam_re[g * 64 + p], lim = lam_im[g * 64 + p];
        const float mag = expf((float)n * dl * lre); float sn, cs; sincosf((float)n * dl * lim, &sn, &cs);
        LP[idx * 2] = mag * cs; LP[idx * 2 + 1] = mag * sn; }
    for (int idx = F.tid; idx < 16 * 64; idx += 512) { const int c = idx >> 6, p = idx & 63; CC[idx * 2] = c_re[(g * 16 + c) * 64 + p]; CC[idx * 2 + 1] = c_im[(g * 16 + c) * 64 + p]; }
    __syncthreads();
    for (int idx = F.tid; idx < 64 * 16; idx += 512) { const int p = idx >> 4;
        const float lre = lam_re[g * 64 + p], lim = lam_im[g * 64 + p];
        const float nr = LP[(64 + p) * 2] - 1.f, ni = LP[(64 + p) * 2 + 1], den = 1.f / (lre * lre + lim * lim);
        const float qr = (nr * lre + ni * lim) * den, qi = (ni * lre - nr * lim) * den;
        const float br = b_re[(size_t)g * 1024 + idx], bi = b_im[(size_t)g * 1024 + idx];
        BB[idx * 2] = qr * br - qi * bi; BB[idx * 2 + 1] = qr * bi + qi * br; }
    __syncthreads();
    for (int idx = F.tid; idx < 1024; idx += 512) { const int tau = idx >> 6, c = 4 * qtr + ((idx >> 4) & 3), c2 = idx & 15; float s = 0.f;
        for (int p = 0; p < 64; ++p) { const float cr = CC[(c * 64 + p) * 2], ci = CC[(c * 64 + p) * 2 + 1], lr = LP[(tau * 64 + p) * 2], li = LP[(tau * 64 + p) * 2 + 1];
            const float tr = cr * lr - ci * li, ti = cr * li + ci * lr, br = BB[(p * 16 + c2) * 2], bi = BB[(p * 16 + c2) * 2 + 1];
            s += tr * br - ti * bi; }
        KT[(tau * 16 + c) * 16 + c2] = s; }
    __syncthreads();
    float* misc = (float*)(F.ws + WS_MISC);
    if (qtr == 0) for (int idx = F.tid; idx < 64; idx += 512) { misc[(g * 64 + idx) * 2] = LP[(16 * 64 + idx) * 2]; misc[(g * 64 + idx) * 2 + 1] = LP[(16 * 64 + idx) * 2 + 1];
        misc[8192 + (g * 64 + idx) * 2] = LP[(64 + idx) * 2]; misc[8192 + (g * 64 + idx) * 2 + 1] = LP[(64 + idx) * 2 + 1]; }
    if (qtr == 0) for (int idx = F.tid; idx < 2048; idx += 512) misc[32768 + g * 2048 + idx] = BB[idx];
    unsigned* wg = (unsigned*)(F.ws + WS_S5M + (size_t)g * S5M_G);
    for (int idx = qtr * 4096 + F.tid; idx < (qtr + 1) * 4096; idx += 512) { const int pp = idx >> 7, k = 2 * (idx & 127), s = k >> 4, c2 = k & 15, p = pp >> 1;
        const float lr = LP[((15 - s) * 64 + p) * 2], li = LP[((15 - s) * 64 + p) * 2 + 1];
        float v[2];
#pragma unroll
        for (int e = 0; e < 2; ++e) { const float br = BB[(p * 16 + c2 + e) * 2], bi = BB[(p * 16 + c2 + e) * 2 + 1]; v[e] = (pp & 1) ? (lr * bi + li * br) : (lr * br - li * bi); }
        wg[idx] = pk2(v[0], v[1]); }
    unsigned* tv = (unsigned*)(F.ws + WS_S5M + (size_t)g * S5M_G + S5M_WG);
    for (int idx = F.tid; idx < 12288; idx += 512) { const int nl = idx / 192, k = 2 * (idx - nl * 192), t = nl >> 2, c = 4 * qtr + (nl & 3), n = 16 * t + c;
        float v0, v1;
        if (k < 256) { const int s = k >> 4, c2 = k & 15;
            if (s <= t) { v0 = KT[((t - s) * 16 + c) * 16 + c2]; v1 = KT[((t - s) * 16 + c) * 16 + c2 + 1];
                if (s == t) { const float dd = dsk[g * 16 + c]; if (c2 == c) v0 += dd; if (c2 + 1 == c) v1 += dd; } }
            else { v0 = 0.f; v1 = 0.f; } }
        else { const int p = (k - 256) >> 1; const float cr = CC[(c * 64 + p) * 2], ci = CC[(c * 64 + p) * 2 + 1], lr = LP[((t + 1) * 64 + p) * 2], li = LP[((t + 1) * 64 + p) * 2 + 1];
            v0 = cr * lr - ci * li; v1 = -(cr * li + ci * lr); }
        tv[n * 192 + (k >> 1)] = pk2(v0, v1); }
    __syncthreads();
}

__device__ __forceinline__ void p0_weights(Frame& F, int set, int gw, int NGW) {
    LAS float* scr = (LAS float*)(F.lds + F.wave * 8704);
    const int I_GLU = 16 * 64, I_UP = 16 * 176, I_DN = 44 * 32, I_IN = 16 * 136, I_O = 16 * 32;
    if (set == 0) {
        const int NIT = I_GLU + I_UP + I_DN + I_IN;
        for (int it = gw; it < NIT; it += NGW) {
            int r = it;
            if (r < I_GLU) { const int kb = r / 64, nb = r % 64, n0 = 32 * nb; tr_item(F.in[19], 2048, DM, (bf16*)(F.ws + WS_WGLU), n0, glu_src(n0, 1024), 32, 64 * kb, nullptr, scr, F.lane); continue; } r -= I_GLU;
            if (r < I_UP) { const int kb = r / 176, nb = r % 176, n0 = 32 * nb; tr_item(F.in[26], UPN, DM, (bf16*)(F.ws + WS_WUP0), n0, glu_src(n0, DFF), 32, 64 * kb, F.in[9], scr, F.lane); continue; } r -= I_UP;
            if (r < I_DN) { const int kb = r / 32, nb = r % 32, n0 = 32 * nb; tr_item(F.in[28], DM, DFF, (bf16*)(F.ws + WS_WDN0), n0, n0, 32, 64 * kb, nullptr, scr, F.lane); continue; } r -= I_DN;
            { const int kb = r / 136, nb = r % 136, n0 = 32 * nb; int nv = GIN - n0; nv = nv < 0 ? 0 : (nv > 32 ? 32 : nv);
              tr_item(F.in[20], GIN, DM, (bf16*)(F.ws + WS_WIN), n0, n0, nv, 64 * kb, F.in[8] + DM, scr, F.lane); }
        }
    } else {
        const int NIT = I_O + I_UP + I_DN;
        for (int it = gw; it < NIT; it += NGW) {
            int r = it;
            if (r < I_O) { const int kb = r / 32, nb = r % 32, n0 = 32 * nb; tr_item(F.in[25], DM, DM, (bf16*)(F.ws + WS_WO), n0, n0, 32, 64 * kb, nullptr, scr, F.lane); continue; } r -= I_O;
            if (r < I_UP) { const int kb = r / 176, nb = r % 176, n0 = 32 * nb; tr_item(F.in[26] + (size_t)DM * UPN, UPN, DM, (bf16*)(F.ws + WS_WUP1), n0, glu_src(n0, DFF), 32, 64 * kb, F.in[9] + DM, scr, F.lane); continue; } r -= I_UP;
            { const int kb = r / 32, nb = r % 32, n0 = 32 * nb; tr_item(F.in[28] + (size_t)DFF * DM, DM, DFF, (bf16*)(F.ws + WS_WDN1), n0, n0, 32, 64 * kb, nullptr, scr, F.lane); }
        }
    }
}

__device__ __forceinline__ void p0_prologue(Frame& F) {
    SEGT(0);
    if (F.G == 256) p0_s5_group(F, F.vcu >> 2, F.vcu & 3);
    else for (int u = F.vcu; u < 256; u += F.G) p0_s5_group(F, u >> 2, u & 3);
    SEGT(1);
    const int gw = F.vcu * NWAVES + F.wave, NGW = F.G * NWAVES;
    { const float* nw = F.in[8]; bf16* U = (bf16*)(F.ws + WS_BIG); float* HS = (float*)(F.ws + WS_HS);
      f32x4 nv[4];
#pragma unroll
      for (int j = 0; j < 4; ++j) nv[j] = *(const f32x4*)(nw + 4 * F.lane + 256 * j);
#define P0_ROW_LOAD(V, ROW) do { const float* xr_ = xin_ptr(F.in[0], F.in[1], F.in[7], (ROW)); \
        _Pragma("unroll") for (int j = 0; j < 4; ++j) V[j] = *(const f32x4*)(xr_ + 4 * F.lane + 256 * j); } while (0)
#define P0_ROW_DO(V, ROW) do { const int row_ = (ROW); float s = 0.f; \
        _Pragma("unroll") for (int j = 0; j < 4; ++j) s += (V[j].x * V[j].x + V[j].y * V[j].y) + (V[j].z * V[j].z + V[j].w * V[j].w); \
        const float r = 1.f / sqrtf(wave_sum(s) * (1.f / DM) + EPS); \
        if (row_ < ROWS_P) {        \
            _Pragma("unroll") for (int j = 0; j < 4; ++j) { const f32x4 h = V[j] * r * nv[j]; \
                u32x2 w; w.x = pk2(h.x, h.y); w.y = pk2(h.z, h.w); \
                *(u32x2*)(U + (size_t)row_ * DM + 4 * F.lane + 256 * j) = w; } } \
        else { \
            _Pragma("unroll") for (int j = 0; j < 4; ++j) *(f32x4*)(HS + (size_t)(row_ - ROWS_P) * DM + 4 * F.lane + 256 * j) = V[j] * r * nv[j]; } } while (0)
      f32x4 va[4], vb[4];
      if (gw < ROWS) P0_ROW_LOAD(va, gw);
      if (gw + NGW < ROWS) P0_ROW_LOAD(vb, gw + NGW);
      for (int row = gw; row < ROWS; row += 2 * NGW) {
        P0_ROW_DO(va, row);
        if (row + 2 * NGW < ROWS) P0_ROW_LOAD(va, row + 2 * NGW);
        if (row + NGW < ROWS) { P0_ROW_DO(vb, row + NGW);
            if (row + 3 * NGW < ROWS) P0_ROW_LOAD(vb, row + 3 * NGW); }
      }
#undef P0_ROW_LOAD
#undef P0_ROW_DO
    }
    SEGT(2);
    p0_weights(F, 0, gw, NGW);
    SEGT(3);
}

#define MFMA16(a, b, c) __builtin_amdgcn_mfma_f32_16x16x32_bf16((a), (b), (c), 0, 0, 0)
constexpr int S5_UST = 528, S5_HL = 68608;
__device__ __forceinline__ void s5_prompt_item(Frame& F, int b, int g) {
    SEGT(10);
    LAS unsigned char* UT = F.lds; LAS unsigned char* HL = F.lds + S5_HL;
    const int fr = F.lane & 15, fq = F.lane >> 4, w = F.wave;
    { const unsigned char* src = F.ws + WS_BIG + ((size_t)(b * TP) * DM + 16 * g) * 2;
      for (int piece = F.tid; piece < TP * 2; piece += 512) { const int r = piece >> 1, hf = piece & 1;
          *(LAS u32x4*)(UT + (r >> 4) * S5_UST + (r & 15) * 32 + hf * 16) = *(const u32x4*)(src + (size_t)r * (DM * 2) + hf * 16); } }
    __syncthreads();
    SEGT(11);
    const unsigned char* wg = F.ws + WS_S5M + (size_t)g * S5M_G; const unsigned char* tv = wg + S5M_WG;
    {
        bf16x8 af[8];
#pragma unroll
        for (int ks = 0; ks < 8; ++ks) af[ks] = *(const bf16x8*)(wg + ((size_t)(16 * w + fr) * 256 + 32 * ks + 8 * fq) * 2);
        for (int jt = 0; jt < 9; ++jt) { const int chunk = 16 * jt + fr, cr = chunk < S5NCH ? chunk : S5NCH - 1;
            f32x4 acc = (f32x4){0.f, 0.f, 0.f, 0.f};
#pragma unroll
            for (int ks = 0; ks < 8; ++ks) acc = MFMA16(af[ks], *(const LAS bf16x8*)(UT + cr * S5_UST + (32 * ks + 8 * fq) * 2), acc);
            if (chunk < S5NCH) *(LAS f32x4*)(HL + chunk * 512 + (16 * w + 4 * fq) * 4) = acc; }
    }
    __syncthreads();
    SEGT(12);
    {
        const int p = F.lane, c0 = 16 * w, nc = (w == 7) ? 17 : 16; const float* misc = (const float*)(F.ws + WS_MISC);
        const float lr = misc[(g * 64 + p) * 2], li = misc[(g * 64 + p) * 2 + 1];
        f32x2 hv[17];
#pragma unroll
        for (int e = 0; e < 17; ++e) { const int c = (e < nc) ? c0 + e : c0; hv[e] = *(const LAS f32x2*)(HL + c * 512 + 8 * p); }
        f32x2 loc[17]; float tr = 0.f, ti = 0.f, pr = 1.f, pi = 0.f;
#pragma unroll
        for (int e = 0; e < 17; ++e) { loc[e] = (f32x2){tr, ti};
            if (e < nc) { const float nr = lr * tr - li * ti + hv[e].x, ni = lr * ti + li * tr + hv[e].y; tr = nr; ti = ni;
                const float qr = lr * pr - li * pi, qi = lr * pi + li * pr; pr = qr; pi = qi; } }
        LAS float* XT = (LAS float*)(HL + S5NCH * 512);
        *(LAS f32x4*)(XT + (w * 64 + p) * 4) = (f32x4){tr, ti, pr, pi};
        __syncthreads();
        float cr = 0.f, ci = 0.f;
        for (int v = 0; v < w; ++v) { const f32x4 x = *(const LAS f32x4*)(XT + (v * 64 + p) * 4);
            const float nr = x.z * cr - x.w * ci + x.x, ni = x.z * ci + x.w * cr + x.y; cr = nr; ci = ni; }
        float wr_ = 1.f, wi_ = 0.f;
#pragma unroll
        for (int e = 0; e < 17; ++e) {
            if (e < nc) { const int c = c0 + e; const float sr = loc[e].x + wr_ * cr - wi_ * ci, si = loc[e].y + wr_ * ci + wi_ * cr;
                *(LAS unsigned*)(HL + c * 512 + (((p >> 2) ^ (c & 15)) * 16) + (p & 3) * 4) = pk2(sr, si);
                const float qr = lr * wr_ - li * wi_, qi = lr * wi_ + li * wr_; wr_ = qr; wi_ = qi; } }
        if (w == 7) { const float fr_ = tr + wr_ * cr - wi_ * ci, fi_ = ti + wr_ * ci + wi_ * cr;
            F.out[O_PS5RE + (size_t)(b * 64 + g) * 64 + p] = fr_; F.out[O_PS5IM + (size_t)(b * 64 + g) * 64 + p] = fi_; }
    }
    __syncthreads();
    SEGT(13);
    {
        bf16x8 af[2][12];
#pragma unroll
        for (int il = 0; il < 2; ++il)
#pragma unroll
            for (int ks = 0; ks < 12; ++ks) af[il][ks] = *(const bf16x8*)(tv + ((size_t)(16 * (2 * w + il) + fr) * 384 + 32 * ks + 8 * fq) * 2);
        bf16* A1 = (bf16*)(F.ws + WS_B2);
#pragma unroll 3
        for (int jt = 0; jt < 9; ++jt) { const int chunk = 16 * jt + fr, cr = chunk < S5NCH ? chunk : S5NCH - 1;
            bf16x8 bfr[12];
#pragma unroll
            for (int ks = 0; ks < 8; ++ks) bfr[ks] = *(const LAS bf16x8*)(UT + cr * S5_UST + (32 * ks + 8 * fq) * 2);
#pragma unroll
            for (int ks = 0; ks < 4; ++ks) bfr[8 + ks] = *(const LAS bf16x8*)(HL + cr * 512 + (((4 * ks + fq) ^ (cr & 15)) * 16));
#pragma unroll
            for (int il = 0; il < 2; ++il) { f32x4 acc = (f32x4){0.f, 0.f, 0.f, 0.f};
#pragma unroll
                for (int ks = 0; ks < 12; ++ks) acc = MFMA16(af[il][ks], bfr[ks], acc);
                if (chunk < S5NCH) { u32x2 o; o.x = pk2(gelu_tanh(acc[0]), gelu_tanh(acc[1])); o.y = pk2(gelu_tanh(acc[2]), gelu_tanh(acc[3]));
                    *(u32x2*)(A1 + (size_t)(b * TP + chunk * 16 + 2 * w + il) * DM + 16 * g + 4 * fq) = o; } } }
    }
    __syncthreads();
    SEGT(14);
}
__device__ __forceinline__ void p1_s5(Frame& F) {
    for (int it = F.vcu; it < NB * S5G; it += F.G) s5_prompt_item(F, it >> 6, it & 63);
    SEGT(15);
    const int gw = F.vcu * NWAVES + F.wave, NGW = F.G * NWAVES, p = F.lane;
    const float* misc = (const float*)(F.ws + WS_MISC); const float* HS = (const float*)(F.ws + WS_HS); bf16* A1 = (bf16*)(F.ws + WS_B2);
    const float* c_re = F.in[16]; const float* c_im = F.in[17]; const float* dsk = F.in[18];
    for (int it = gw; it < NS * S5G; it += NGW) { const int s = it >> 6, g = it & 63;
        float u[16];
#pragma unroll
        for (int j = 0; j < 16; ++j) u[j] = ldv_f32(HS + (size_t)s * DM + 16 * g + j);
        const size_t si = (size_t)(s * 64 + g) * 64 + p;
        const float h0r = F.in[2][si], h0i = F.in[3][si], lr = misc[8192 + (g * 64 + p) * 2], li = misc[8192 + (g * 64 + p) * 2 + 1];
        float hr = lr * h0r - li * h0i, hi = lr * h0i + li * h0r;
        const float* bb = misc + 32768 + (size_t)(g * 64 + p) * 32;
#pragma unroll
        for (int j = 0; j < 8; ++j) { const f32x4 t = *(const f32x4*)(bb + 4 * j); hr += t.x * u[2 * j] + t.z * u[2 * j + 1]; hi += t.y * u[2 * j] + t.w * u[2 * j + 1]; }
        F.out[O_SS5RE + si] = hr; F.out[O_SS5IM + si] = hi;
        LAS float* hb = (LAS float*)(F.lds + F.wave * 512);
        *(LAS f32x2*)(hb + 2 * p) = (f32x2){hr, hi};
        { const int c = p & 15, pq = p >> 4; const float* cr = c_re + (size_t)(g * 16 + c) * 64 + 16 * pq; const float* ci = c_im + (size_t)(g * 16 + c) * 64 + 16 * pq;
          float acc = 0.f;
#pragma unroll
          for (int j = 0; j < 4; ++j) { const f32x4 a = *(const f32x4*)(cr + 4 * j), b = *(const f32x4*)(ci + 4 * j);
              const f32x4 h0 = *(const LAS f32x4*)(hb + 2 * (16 * pq + 4 * j)), h1 = *(const LAS f32x4*)(hb + 2 * (16 * pq + 4 * j) + 4);
              acc += a.x * h0.x - b.x * h0.y + a.y * h0.z - b.y * h0.w + a.z * h1.x - b.z * h1.y + a.w * h1.z - b.w * h1.w; }
          acc = xsum_16_32(acc);
          if (p < 16) { const float y = acc + dsk[16 * g + p] * HS[(size_t)s * DM + 16 * g + p];
              A1[(size_t)(ROWS_P + s) * DM + 16 * g + p] = (bf16)f2bf(gelu_tanh(y)); } }
    }
    SEGT(16);
}

struct Slot { unsigned char* base; int stride; };
__device__ __forceinline__ Slot gdn_slot(unsigned char* ws, int bh, int c, int which) {
    Slot s;
    if (c == 0) { s.base = ws + WS_C0 + (size_t)((bh & 7) * 3 + which) * 16384; s.stride = 256; }
    else { const int b = bh >> 3, h = bh & 7; s.base = ws + WS_BIG + ((size_t)(b * TP + NMETA + 64 * (c - 1)) * GCONV + which * 1024 + 128 * h) * 2; s.stride = GCONV * 2; }
    return s;
}
__device__ __forceinline__ int gdn_row(int b, int c, int i) { return c == 0 ? (i >= GNULL ? b * TP + i - GNULL : -1) : b * TP + NMETA + 64 * (c - 1) + i; }
__device__ __forceinline__ float softplusf_(float x) { return x > 20.f ? x : log1pf(__expf(x)); }
__device__ __forceinline__ bf16x8 mk8(u32x2 lo, u32x2 hi) { u32x4 t; t.x = lo.x; t.y = lo.y; t.z = hi.x; t.w = hi.y; return __builtin_bit_cast(bf16x8, t); }
__device__ __forceinline__ float sq8(bf16x8 v) { const u32x4 t = __builtin_bit_cast(u32x4, v); float s = 0.f;
#pragma unroll
    for (int e = 0; e < 4; ++e) { const float a = bflo(t[e]), b = bfhi(t[e]); s += a * a + b * b; } return s; }

__device__ __forceinline__ f32x4 ld4bf(const void* p) { const u32x2 v = *(const u32x2*)p; return (f32x4){bflo(v.x), bfhi(v.x), bflo(v.y), bfhi(v.y)}; }
__device__ __forceinline__ bf16x8 pack2(const f32x4& a, const f32x4& b) { u32x2 lo, hi; lo.x = pk2(a[0], a[1]); lo.y = pk2(a[2], a[3]); hi.x = pk2(b[0], b[1]); hi.y = pk2(b[2], b[3]); return mk8(lo, hi); }
__device__ __forceinline__ float dot4_asm(float a0, float a1, float a2, float a3, const f32x4& v) {
    float t;
    asm("v_mul_f32 %0, %1, %2" : "=v"(t) : "v"(a0), "v"(v.x));
    asm("v_fmac_f32 %0, %1, %2" : "+v"(t) : "v"(a1), "v"(v.y));
    asm("v_fmac_f32 %0, %1, %2" : "+v"(t) : "v"(a2), "v"(v.z));
    asm("v_fmac_f32 %0, %1, %2" : "+v"(t) : "v"(a3), "v"(v.w));
    return t;
}
#ifdef P6_SEG
#define P6S(i) do { if (!C0) { __builtin_amdgcn_sched_barrier(0); const unsigned long long t_ = __builtin_amdgcn_s_memrealtime(); \
    if ((i) == P6_SEG) p6_t0 = t_; if ((i) == P6_SEG + 1) { if (blockIdx.x == 3 && F.wave == 0 && l == 0) *(volatile LAS unsigned long long*)(F.lds + LDSCTL_OFF + 64) += t_ - p6_t0; } __builtin_amdgcn_sched_barrier(0); } } while (0)
#else
#define P6S(i) do {} while (0)
#endif
template <bool C0> __device__ __forceinline__ void p6_item(Frame& F, int bh, int c, LAS unsigned char* wl) {
    constexpr int R0 = C0 ? 3 : 0;
    const int item = bh * GNCH + c;
    unsigned long long p6_t0 = 0;
    int l_ = F.lane; asm volatile("" : "+v"(l_));
    const int b = bh >> 3, h = bh & 7, l = l_, fr = l & 15, fq = l >> 4;
    LAS float* LmT = (LAS float*)wl; LAS float* SC = (LAS float*)(wl + 16384);
    LAS unsigned char* TM = wl; LAS unsigned char* AT = wl + 8192;
    const f32x4 z4 = (f32x4){0.f, 0.f, 0.f, 0.f};
    const bf16x8 zf = (bf16x8){0, 0, 0, 0, 0, 0, 0, 0};
    const int rb0 = C0 ? b * TP - GNULL : b * TP + NMETA + 64 * (c - 1);
    const unsigned char* qkvu = F.ws + WS_BIG + ((size_t)rb0 * GCONV + 128 * h) * 2;
    const Slot qs = gdn_slot(F.ws, bh, c, 0), ksl = gdn_slot(F.ws, bh, c, 1), vsl = gdn_slot(F.ws, bh, c, 2);
    unsigned char* wxu = F.ws + WS_WX + (size_t)item * 16384;
    constexpr int ONS = C0 ? 256 : DM * 2;
    unsigned char* onu = C0 ? F.ws + WS_OL0 + (size_t)h * 16384 : (unsigned char*)(F.out + O_YP) + ((size_t)rb0 * DM + 128 * h) * 2;
    const unsigned vo_f = (unsigned)(fr * (GCONV * 2) + fq * 16);
    const unsigned vo_q = (unsigned)(fr * (GCONV * 2) + fq * 8);
    const unsigned vo_u = (unsigned)((fr >> 1) * ksl.stride + (fr & 1) * 128 + fq * 8);
    const unsigned vo_t = (unsigned)((fr >> 1) * ksl.stride + (fr & 1) * 128 + fq * 16);
    const unsigned vo_p = (unsigned)(fr * qs.stride + fq * 16);
    const unsigned vo_w = (unsigned)(fr * 256 + fq * 16);
    const unsigned vo_o = (unsigned)(fr * ONS + fq * 8);
#define P6_RTV(rt) (!C0 || (rt) == 3)
    if (C0) {
        const u32x4 z = (u32x4){0u, 0u, 0u, 0u};
#pragma unroll 4
        for (int q = 0; q < 16; ++q) { *(u32x4*)(qs.base + (q * 64 + l) * 16) = z; *(u32x4*)(ksl.base + (q * 64 + l) * 16) = z; *(u32x4*)(vsl.base + (q * 64 + l) * 16) = z; *(u32x4*)(wxu + (q * 64 + l) * 16) = z; }
    }
#pragma unroll
    for (int q = 0; q < 16; ++q) *(LAS f32x4*)(wl + (q * 64 + l) * 16) = z4;
    P6S(0);
    bf16x8 kf0[4][4];
#pragma unroll
    for (int rt = R0; rt < 4; ++rt)
#pragma unroll
        for (int ks = 0; ks < 4; ++ks) kf0[rt][ks] = *(const bf16x8*)(qkvu + (size_t)(rt * 16 * GCONV * 2 + 2048 + ks * 64) + vo_f);
    float gl;
    { const bool rv = !C0 || (l >= GNULL); float g = 0.f, be = 0.f;
      if (rv) { const float* ab = (const float*)(F.ws + WS_AB) + (size_t)(rb0 + l) * 16; const float a = ab[h], bq = ab[8 + h];
          g = -__expf(F.in[22][h]) * softplusf_(a + F.in[23][h]); be = sigmoidf_(bq); }
      float gc = g;
#pragma unroll
      for (int o = 1; o < 64; o <<= 1) { const float t = __shfl_up(gc, o); if (l >= o) gc += t; }
      gl = __shfl(gc, 63);
      SC[l] = gc; SC[64 + l] = be; }
    {
        bf16x8 kf[4][4];
#pragma unroll
        for (int rt = 0; rt < R0; ++rt) { if (fq == 0) SC[128 + 16 * rt + fr] = 1000.f; }
#pragma unroll
        for (int rt = R0; rt < 4; ++rt) {
#pragma unroll
            for (int ks = 0; ks < 4; ++ks) kf[rt][ks] = kf0[rt][ks];
            float sk = 0.f;
#pragma unroll
            for (int ks = 0; ks < 4; ++ks) sk += sq8(kf[rt][ks]);
            sk = xsum_16_32(sk);
            if (fq == 0) SC[128 + 16 * rt + fr] = 1.f / sqrtf(sk + 1e-6f); }
#pragma unroll
        for (int it = R0; it < 4; ++it) {
            const f32x4 gci = *(const LAS f32x4*)(SC + 16 * it + 4 * fq), bei = *(const LAS f32x4*)(SC + 64 + 16 * it + 4 * fq), rki = *(const LAS f32x4*)(SC + 128 + 16 * it + 4 * fq);
#pragma unroll
            for (int jt = R0; jt <= it; ++jt) {
                f32x4 dk = z4;
#pragma unroll
                for (int ks = 0; ks < 4; ++ks) dk = MFMA16(kf[it][ks], kf[jt][ks], dk);
                const int j = 16 * jt + fr; const float gcj = SC[j], rkj = SC[128 + j];
                f32x4 lm;
#pragma unroll
                for (int r = 0; r < 4; ++r) { const int i = 16 * it + 4 * fq + r; lm[r] = (j < i) ? bei[r] * rki[r] * __expf(gci[r] - gcj) * rkj * dk[r] : 0.f; }
                *(LAS f32x4*)(LmT + j * 64 + 16 * it + 4 * fq) = lm;
            } }
    }
    LAS float* CW = (LAS float*)(F.lds + NWAVES * 17408 + F.wave * 512);
    { const float gcl = SC[l], rkl = SC[128 + l]; CW[l] = SC[64 + l] * rkl * __expf(gcl); CW[64 + l] = rkl * __expf(gl - gcl); }
    P6S(1);
    __builtin_amdgcn_sched_barrier(0);
    {
        const int hb = l >> 5, il = l & 31, b0 = 32 * hb;
        const LAS float* Lb = LmT + b0 * 64 + b0;
        f32x2 r2[16];
#pragma unroll
        for (int j = 0; j < 16; ++j) r2[j] = (f32x2){0.f, 0.f};
#pragma unroll
        for (int jl = 31; jl >= 0; --jl) { f32x2 acc = (f32x2){(il == jl) ? 1.f : 0.f, 0.f};
#pragma unroll
            for (int kg = ((jl + 1) & ~3); kg < 32; kg += 4) { const f32x4 v = *(const LAS f32x4*)(Lb + jl * 64 + kg);
                acc -= r2[kg >> 1] * (f32x2){v.x, v.y}; acc -= r2[(kg >> 1) + 1] * (f32x2){v.z, v.w}; }
            r2[jl >> 1][jl & 1] = acc.x + acc.y; }
        unsigned rp[16];
#pragma unroll
        for (int m = 0; m < 16; ++m) rp[m] = pk2(r2[m].x, r2[m].y);
        if (hb) {
#pragma unroll
            for (int q = 0; q < 4; ++q) *(LAS u32x4*)(wl + (32 + il) * 256 + 16 * q) = (u32x4){rp[4 * q], rp[4 * q + 1], rp[4 * q + 2], rp[4 * q + 3]};
        } else {
#pragma unroll
            for (int j = 0; j < 32; ++j) *(LAS unsigned short*)(wl + j * 256 + 64 + 2 * il) = (unsigned short)(rp[j >> 1] >> (16 * (j & 1)));
        }
        f32x4 t21[2][2];
        {
            bf16x8 Af[2], Bf[2];
#pragma unroll
            for (int ct = 0; ct < 2; ++ct) { const LAS float* ap = LmT + (16 * ct + fr) * 64 + 32 + 8 * fq;
                const f32x4 a0 = *(const LAS f32x4*)ap, a1 = *(const LAS f32x4*)(ap + 4); Af[ct] = pack2(a0, a1); }
#pragma unroll
            for (int at = 0; at < 2; ++at) Bf[at] = *(const LAS bf16x8*)(wl + (32 + 16 * at + fr) * 256 + 16 * fq);
#pragma unroll
            for (int ct = 0; ct < 2; ++ct)
#pragma unroll
                for (int at = 0; at < 2; ++at) { const f32x4 d = MFMA16(Af[ct], Bf[at], z4);
                    u32x2 o; o.x = pk2(d[0], d[1]); o.y = pk2(d[2], d[3]);
                    *(LAS u32x2*)(wl + (16 * at + fr) * 256 + (16 * ct + 4 * fq) * 2) = o; }
        }
        {
            bf16x8 Af[2], Bf[2];
#pragma unroll
            for (int jt = 0; jt < 2; ++jt) Af[jt] = *(const LAS bf16x8*)(wl + (16 * jt + fr) * 256 + 64 + 16 * fq);
#pragma unroll
            for (int at = 0; at < 2; ++at) Bf[at] = *(const LAS bf16x8*)(wl + (16 * at + fr) * 256 + 16 * fq);
#pragma unroll
            for (int jt = 0; jt < 2; ++jt)
#pragma unroll
                for (int at = 0; at < 2; ++at) t21[jt][at] = MFMA16(Af[jt], Bf[at], z4);
        }
#pragma unroll
        for (int q = 0; q < 4; ++q) *(LAS u32x4*)(TM + l * 128 + b0 * 2 + 16 * q) = (u32x4){rp[4 * q], rp[4 * q + 1], rp[4 * q + 2], rp[4 * q + 3]};
        if (!hb) {
#pragma unroll
            for (int q = 0; q < 4; ++q) *(LAS u32x4*)(TM + l * 128 + 64 + 16 * q) = (u32x4){0u, 0u, 0u, 0u};
        }
#pragma unroll
        for (int jt = 0; jt < 2; ++jt)
#pragma unroll
            for (int at = 0; at < 2; ++at) { const f32x4 d = t21[jt][at];
                u32x2 o; o.x = pk2(-d[0], -d[1]); o.y = pk2(-d[2], -d[3]);
                *(LAS u32x2*)(TM + (32 + 16 * at + fr) * 128 + (16 * jt + 4 * fq) * 2) = o; }
    }
    __builtin_amdgcn_sched_barrier(0);
    P6S(2);
    bf16x8 sel[2];
#pragma unroll
    for (int hf = 0; hf < 2; ++hf) {
#pragma unroll
        for (int jj = 0; jj < 8; ++jj) sel[hf][jj] = (8 * fq + jj == 16 * hf + fr) ? (short)0x3F80 : (short)0; }
    bf16x8 tmF[4][2], atF[4][2];
    {
#pragma unroll
        for (int q = 0; q < 8; ++q) *(LAS u32x4*)(AT + (q * 64 + l) * 16) = (u32x4){0u, 0u, 0u, 0u};
        bf16x8 kf[4][4];
#pragma unroll
        for (int rt = R0; rt < 4; ++rt)
#pragma unroll
            for (int ks = 0; ks < 4; ++ks) kf[rt][ks] = *(const bf16x8*)(qkvu + (size_t)(rt * 16 * GCONV * 2 + 2048 + ks * 64) + vo_f);
        bf16x8 qfa[4][4];
#pragma unroll
        for (int it = R0; it < 4; ++it)
#pragma unroll
            for (int ks = 0; ks < 4; ++ks) qfa[it][ks] = *(const bf16x8*)(qkvu + (size_t)(it * 16 * GCONV * 2 + ks * 64) + vo_f);
#pragma unroll
        for (int it = R0; it < 4; ++it) {
            bf16x8 qf[4];
#pragma unroll
            for (int ks = 0; ks < 4; ++ks) qf[ks] = qfa[it][ks];
            { float sq = 0.f;
#pragma unroll
              for (int ks = 0; ks < 4; ++ks) sq += sq8(qf[ks]);
              sq = xsum_16_32(sq);
              if (fq == 0) SC[192 + 16 * it + fr] = 0.08838834764831845f / sqrtf(sq + 1e-6f); }
            const f32x4 gci = *(const LAS f32x4*)(SC + 16 * it + 4 * fq), rqi = *(const LAS f32x4*)(SC + 192 + 16 * it + 4 * fq);
#pragma unroll
            for (int jt = R0; jt <= it; ++jt) {
                f32x4 dq = z4;
#pragma unroll
                for (int ks = 0; ks < 4; ++ks) dq = MFMA16(qf[ks], kf[jt][ks], dq);
                const int j = 16 * jt + fr; const float gcj = SC[j], rkj = SC[128 + j];
                LAS unsigned short* ap = (LAS unsigned short*)(AT + ((16 * it + 4 * fq) * 64 + j) * 2);
#pragma unroll
                for (int r = 0; r < 4; ++r) { const int i = 16 * it + 4 * fq + r; const float aa = (j <= i) ? rqi[r] * __expf(gci[r] - gcj) * rkj * dq[r] : 0.f; ap[64 * r] = (unsigned short)f2bf(aa); }
            } }
        __builtin_amdgcn_sched_barrier(0);
        asm volatile("s_waitcnt vmcnt(0)" ::: "memory");
#pragma unroll
        for (int it = R0; it < 4; ++it)
#pragma unroll
            for (int js = 0; js < 2; ++js) {
                tmF[it][js] = mk8(*(const LAS u32x2*)(TM + (16 * it + fr) * 128 + (32 * js + 4 * fq) * 2), *(const LAS u32x2*)(TM + (16 * it + fr) * 128 + (32 * js + 16 + 4 * fq) * 2));
                atF[it][js] = mk8(*(const LAS u32x2*)(AT + (16 * it + fr) * 128 + (32 * js + 4 * fq) * 2), *(const LAS u32x2*)(AT + (16 * it + fr) * 128 + (32 * js + 16 + 4 * fq) * 2)); }
        P6S(3);
        bf16x8 wA[8][2];
        float qsc[4];
#pragma unroll
        for (int it2 = R0; it2 < 4; ++it2) qsc[it2] = SC[192 + 16 * it2 + fr] * __expf(SC[16 * it2 + fr]);
#pragma unroll
        for (int ks = 0; ks < 4; ++ks)
#pragma unroll
            for (int hf = 0; hf < 2; ++hf) { const int dt = 2 * ks + hf; u32x2 hh[4];
#pragma unroll
                for (int rt = 0; rt < R0; ++rt) hh[rt] = (u32x2){0u, 0u};
#pragma unroll
                for (int rt = R0; rt < 4; ++rt) { const f32x4 d = MFMA16(kf[rt][ks], sel[hf], z4);
                    const f32x4 cwi = *(const LAS f32x4*)(CW + 16 * rt + 4 * fq), cdi = *(const LAS f32x4*)(CW + 64 + 16 * rt + 4 * fq);
                    const f32x4 sw = d * cwi, sd = d * cdi;
                    hh[rt].x = pk2(sw[0], sw[1]); hh[rt].y = pk2(sw[2], sw[3]);
                    u32x2 kd; kd.x = pk2(sd[0], sd[1]); kd.y = pk2(sd[2], sd[3]);
                    *(u32x2*)(ksl.base + (size_t)(8 * dt * ksl.stride + 64 * (rt >> 1) + 8 * (rt & 1)) + vo_t) = kd; }
                const bf16x8 Rw0 = mk8(hh[0], hh[1]), Rw1 = mk8(hh[2], hh[3]);
                f32x4 wD[4];
#pragma unroll
                for (int it = 0; it < R0; ++it) wD[it] = z4;
#pragma unroll
                for (int it = R0; it < 4; ++it) { f32x4 a = MFMA16(tmF[it][0], Rw0, z4); a = MFMA16(tmF[it][1], Rw1, a); f32x4 t = MFMA16(Rw0, tmF[it][0], z4); t = MFMA16(Rw1, tmF[it][1], t);
                    wD[it] = a;
                    u32x2 o; o.x = pk2(t[0], t[1]); o.y = pk2(t[2], t[3]);
                    *(u32x2*)(wxu + (size_t)(it * 4096 + 64 * (dt >> 1) + 8 * (dt & 1)) + vo_w) = o; }
                wA[dt][0] = pack2(wD[0], wD[1]); wA[dt][1] = pack2(wD[2], wD[3]);
                __builtin_amdgcn_sched_barrier(0);
            }
        u32x2 qv[8][4];
#pragma unroll
        for (int dt = 0; dt < 8; ++dt)
#pragma unroll
            for (int it2 = R0; it2 < 4; ++it2) qv[dt][it2] = *(const u32x2*)(qkvu + (size_t)(it2 * 16 * GCONV * 2 + 32 * dt) + vo_q);
#pragma unroll
        for (int dt = 0; dt < 8; ++dt)
#pragma unroll
            for (int it2 = R0; it2 < 4; ++it2) { f32x4 a = MFMA16(wA[dt][0], atF[it2][0], z4); a = MFMA16(wA[dt][1], atF[it2][1], a);
                const float sc = qsc[it2]; const u32x2 q2 = qv[dt][it2];
                u32x2 o; o.x = pk2(bflo(q2.x) * sc - a[0], bfhi(q2.x) * sc - a[1]); o.y = pk2(bflo(q2.y) * sc - a[2], bfhi(q2.y) * sc - a[3]);
                *(u32x2*)(qs.base + (size_t)(16 * it2 * qs.stride + 64 * (dt >> 1) + 8 * (dt & 1)) + vo_p) = o; }
    }
    __builtin_amdgcn_sched_barrier(0);
    P6S(4);
    {
        bf16x8 vf[4][4];
#pragma unroll
        for (int rt = R0; rt < 4; ++rt)
#pragma unroll
            for (int ks = 0; ks < 4; ++ks) vf[rt][ks] = *(const bf16x8*)(qkvu + (size_t)(rt * 16 * GCONV * 2 + 4096 + ks * 64) + vo_f);
        asm volatile("s_waitcnt vmcnt(0)" ::: "memory");
        __builtin_amdgcn_sched_barrier(0);
#pragma unroll
        for (int ks = 0; ks < 4; ++ks)
#pragma unroll
            for (int hf = 0; hf < 2; ++hf) { const int dt = 2 * ks + hf; u32x2 hh[4];
#pragma unroll
                for (int rt = 0; rt < R0; ++rt) hh[rt] = (u32x2){0u, 0u};
#pragma unroll
                for (int rt = R0; rt < 4; ++rt) { const f32x4 d = MFMA16(vf[rt][ks], sel[hf], z4); const f32x4 sb = *(const LAS f32x4*)(SC + 64 + 16 * rt + 4 * fq);
                    hh[rt].x = pk2(d[0] * sb[0], d[1] * sb[1]); hh[rt].y = pk2(d[2] * sb[2], d[3] * sb[3]); }
                const bf16x8 Ru0 = mk8(hh[0], hh[1]), Ru1 = mk8(hh[2], hh[3]);
                f32x4 uD[4];
#pragma unroll
                for (int it = 0; it < R0; ++it) uD[it] = z4;
#pragma unroll
                for (int it = R0; it < 4; ++it) { f32x4 a = MFMA16(tmF[it][0], Ru0, z4); a = MFMA16(tmF[it][1], Ru1, a); uD[it] = a;
                    u32x2 o; o.x = pk2(a[0], a[1]); o.y = pk2(a[2], a[3]);
                    *(u32x2*)(vsl.base + (size_t)(8 * dt * vsl.stride + 32 * it) + vo_u) = o; }
                const bf16x8 uA0 = pack2(uD[0], uD[1]), uA1 = pack2(uD[2], uD[3]);
#pragma unroll
                for (int it2 = R0; it2 < 4; ++it2) { f32x4 a = MFMA16(uA0, atF[it2][0], z4); a = MFMA16(uA1, atF[it2][1], a);
                    u32x2 o; o.x = pk2(a[0], a[1]); o.y = pk2(a[2], a[3]); *(u32x2*)(onu + (size_t)(it2 * 16 * ONS + 32 * dt) + vo_o) = o; }
                __builtin_amdgcn_sched_barrier(0);
            }
    }
    P6S(5);
#undef P6_RTV
    if (l == 0) ((float*)(F.ws + WS_HS + 768 * 1024))[item] = __expf(gl);
}
__device__ __forceinline__ void p6_gdn_pre(Frame& F) {
    const int gw = F.vcu * NWAVES + F.wave, NGW = F.G * NWAVES;
    LAS unsigned char* wl = F.lds + F.wave * 17408;
    for (int m = gw; m < NB * GH * (GNCH - 1); m += NGW) p6_item<false>(F, m >> 5, 1 + (m & 31), wl);
}

__device__ __forceinline__ bf16x8 p7_ld16(const LAS unsigned char* tb, int r, int ch) { return *(const LAS bf16x8*)(tb + r * 256 + ((ch ^ (r & 15)) << 4)); }
#define GAS __attribute__((address_space(1)))
struct SSlot { bool in_out; unsigned off; };
__device__ __forceinline__ SSlot p7_sslot(int s) {
    const unsigned so = (unsigned)s * 32768u; SSlot r;
    r.off = (unsigned)(O_YP * 4 + (size_t)ROWS * DM * 2) + so; r.in_out = true;
    if (s >= 1024) { r.off = (unsigned)WS_SLAB + (so - 1024u * 32768u); r.in_out = false; }
    if (s >= 1376) r.off = (unsigned)WS_WIN + (so - 1376u * 32768u);
    if (s >= 1648) r.off = (unsigned)(WS_WX + (size_t)(NB * GH * GNCH) * 16384) + (so - 1648u * 32768u);
    if (s >= 1776) { r.off = (unsigned)(((size_t)O_SFCONV + (size_t)NS * 2 * UPN) * 4) + (so - 1776u * 32768u); r.in_out = true; }
    if (s >= 1952) { r.off = (unsigned)(WS_C0 + 512 * 1024) + (so - 1952u * 32768u); r.in_out = false; }
    if (s >= 2032) r.off = (unsigned)WS_XS + (so - 2032u * 32768u);
    return r;
}
__device__ __forceinline__ __amdgpu_buffer_rsrc_t p7_srsrc(Frame& F, const SSlot& sl) {
    return __builtin_amdgcn_make_buffer_rsrc(sl.in_out ? (void*)F.out : (void*)F.ws, 0, sl.in_out ? (int)((size_t)O_END * 4) : (int)WS_END, 0x00020000); }
static_assert((size_t)O_END * 4 < (1ull << 31) && WS_END < (1ull << 31), "buffer sizes");
static_assert(1024 + 352 + 272 + 128 + 176 + 80 + 32 >= NB * GH * (GNCH - 1), "state slots");
static_assert((size_t)ROWS * DM * 2 + (size_t)1024 * 32768 <= (size_t)ROWS_P * DM * 4, "y_prompt half");
static_assert(WS_SLAB + (size_t)352 * 32768 <= WS_END && WS_WIN + (size_t)272 * 32768 <= WS_WO && WS_WX + (size_t)(NB * GH * GNCH) * 16384 + (size_t)128 * 32768 <= WS_B1, "slot areas");
static_assert((size_t)176 * 32768 <= (size_t)NS * 2 * UPN * 4 && WS_C0 + 512 * 1024 + (size_t)80 * 32768 <= WS_OL0 && WS_XS + (size_t)32 * 32768 <= WS_MISC, "slot areas");

__device__ __forceinline__ void p7_chain(Frame& F, int bh, GAS unsigned* flag) {
    const int h = bh & 7, l = F.lane, fr = l & 15, fq = l >> 4, w = F.wave;
    const f32x4 z4 = (f32x4){0.f, 0.f, 0.f, 0.f};
    f32x4 S[8];
#pragma unroll
    for (int mt = 0; mt < 8; ++mt) S[mt] = z4;
    const float* EG = (const float*)(F.ws + WS_HS + 768 * 1024);
    const int dv = 16 * w + fr;
#define P7_FETCHA(cc, SG, UT, EGV) do { \
        const Slot ks_ = gdn_slot(F.ws, bh, (cc), 1); \
        const unsigned char* wx_ = F.ws + WS_WX + (size_t)(((cc) == 0 ? (bh & 7) : bh) * GNCH + (cc)) * 16384; \
        _Pragma("unroll") for (int i = 0; i < 4; ++i) { const int r = 4 * ((i & 1) * 8 + w) + (l >> 4); \
            const unsigned char* src_ = (i < 2) ? wx_ + (size_t)r * 256 : ks_.base + (size_t)r * ks_.stride; \
            SG[i] = *(const u32x4*)(src_ + (l & 15) * 16); } \
        const Slot vsl_ = gdn_slot(F.ws, bh, (cc), 2); \
        _Pragma("unroll") for (int it = 0; it < 4; ++it) UT[it] = *(const u32x2*)(vsl_.base + (size_t)(dv >> 1) * vsl_.stride + (dv & 1) * 128 + (16 * it + 4 * fq) * 2); \
        EGV = ldv_f32(EG + ((cc) == 0 ? h : bh) * GNCH + (cc)); } while (0)
#define P7_PUT(cc, SG) do { LAS unsigned char* stg_ = F.lds + ((cc) & 1) * 32768; \
        _Pragma("unroll") for (int i = 0; i < 4; ++i) { const int r = 4 * ((i & 1) * 8 + w) + (l >> 4); \
            *(LAS u32x4*)(stg_ + (i >> 1) * 16384 + r * 256 + (((l & 15) ^ (r & 15)) << 4)) = SG[i]; } } while (0)
#ifdef P7_DRAIN
#define P7_CHAIN_SYNC(c) do { asm volatile("s_waitcnt vmcnt(0) lgkmcnt(0)\n\ts_barrier" ::: "memory"); \
        if ((c) >= 1 && F.tid == 0) __hip_atomic_store(flag, (unsigned)(c), __ATOMIC_RELAXED, __HIP_MEMORY_SCOPE_AGENT); } while (0)
#else
#define P7_CHAIN_SYNC(c) do { asm volatile("s_waitcnt lgkmcnt(0)\n\ts_barrier" ::: "memory"); \
        if ((c) >= 2 && F.tid == 0) __hip_atomic_store(flag, (unsigned)((c) - 1), __ATOMIC_RELAXED, __HIP_MEMORY_SCOPE_AGENT); } while (0)
#endif
#define P7_ITER(c, FIRST, UTC, EGC, UTN, EGN) do { \
        const LAS unsigned char* T0 = F.lds + ((c) & 1) * 32768; const LAS unsigned char* T2 = T0 + 16384; \
        { const int cn_ = (c) + 1 < GNCH ? (c) + 1 : GNCH - 1; P7_FETCHA(cn_, sg, UTN, EGN); }        \
        bf16x8 Sb[4]; \
        _Pragma("unroll") for (int ks = 0; ks < 4; ++ks) Sb[ks] = pack2(S[2 * ks], S[2 * ks + 1]); \
        if (!(FIRST)) { const SSlot sl_ = p7_sslot(((c) - 1) * (NB * GH) + bh); const __amdgpu_buffer_rsrc_t rs_ = p7_srsrc(F, sl_); \
            _Pragma("unroll") for (int ks = 0; ks < 4; ++ks) __builtin_amdgcn_raw_buffer_store_b128(__builtin_bit_cast(u32x4, Sb[ks]), rs_, sl_.off + (unsigned)(((ks * 8 + w) * 64 + l) * 16), 0,   16); } \
        f32x4 vn[4]; \
        _Pragma("unroll") for (int it = 0; it < 4; ++it) { f32x4 a = z4; const int r = 16 * it + fr; \
            _Pragma("unroll") for (int ks = 0; ks < 4; ++ks) a = MFMA16(p7_ld16(T0, r, 4 * ks + fq), Sb[ks], a); \
            vn[it] = (f32x4){bflo(UTC[it].x), bfhi(UTC[it].x), bflo(UTC[it].y), bfhi(UTC[it].y)} - a; } \
        const bf16x8 Vb0 = pack2(vn[0], vn[1]), Vb1 = pack2(vn[2], vn[3]); \
        _Pragma("unroll") for (int mt = 0; mt < 8; ++mt) { const int r = 8 * mt + (fr >> 1), ch = 8 * (fr & 1) + fq; \
            f32x4 a = S[mt] * EGC; \
            a = MFMA16(p7_ld16(T2, r, ch), Vb0, a); \
            a = MFMA16(p7_ld16(T2, r, ch + 4), Vb1, a); \
            S[mt] = a; } \
        P7_PUT((c) + 1, sg); \
        P7_CHAIN_SYNC(c); \
    } while (0)
    u32x4 sg[4];
    u32x2 uTa[4], uTb[4]; float ega, egb;
    P7_FETCHA(0, sg, uTa, ega);
    P7_PUT(0, sg);
    asm volatile("s_waitcnt vmcnt(0) lgkmcnt(0)" ::: "memory");
    __syncthreads();
    static_assert((GNCH & 1) == 1, "chunk 0, then pairs");
    P7_ITER(0, true, uTa, ega, uTb, egb);
    for (int c = 1; c < GNCH; c += 2) {
        P7_ITER(c, false, uTb, egb, uTa, ega);
        P7_ITER(c + 1, false, uTa, ega, uTb, egb);
    }
#undef P7_ITER
#undef P7_FETCHA
#undef P7_PUT
    asm volatile("s_waitcnt vmcnt(0)" ::: "memory");
    __syncthreads();
    if (F.tid == 0) __hip_atomic_store(flag, (unsigned)(GNCH - 1), __ATOMIC_RELAXED, __HIP_MEMORY_SCOPE_AGENT);
#pragma unroll
    for (int mt = 0; mt < 8; ++mt)
#pragma unroll
        for (int r = 0; r < 4; ++r) F.out[O_PGDN + ((size_t)bh * 128 + 16 * mt + 4 * fq + r) * 128 + dv] = S[mt][r];
    __syncthreads();
}

__device__ __forceinline__ void p7_opart(Frame& F, int bx, int G, bool flow, GAS unsigned* flags) {
    int t_ = (int)threadIdx.x; asm volatile("" : "+v"(t_));
    const int l = t_ & 63, fr = l & 15, fq = l >> 4, w = F.wave;
    constexpr int NITEM = NB * GH * GNCH;
    const f32x4 z4 = (f32x4){0.f, 0.f, 0.f, 0.f};
    bf16* ON = (bf16*)(F.out + O_YP); const bf16* GATE = (const bf16*)(F.ws + WS_B2); const float* onw = F.in[24];
    const int dv = 16 * w + fr;
    LAS unsigned short* Obase = (LAS unsigned short*)(F.lds + 98304);
    const int ni = t_ >> 3, part = t_ & 7;
    float onv[16];
#pragma unroll
    for (int e = 0; e < 16; ++e) onv[e] = onw[16 * part + e];
#ifdef P7_ACQ
#define P7_CONS_ACQ() do { asm volatile("" ::: "memory"); __builtin_amdgcn_fence(__ATOMIC_ACQUIRE, "agent"); asm volatile("s_waitcnt vmcnt(0)" ::: "memory"); } while (0)
#else
#define P7_CONS_ACQ() asm volatile("" ::: "memory")
#endif
#define P7B_RDY(idx) (!flow || ((idx) >> 6) == 0 || __builtin_amdgcn_readfirstlane((int)__hip_atomic_load(flags + ((idx) & 63) * 32, __ATOMIC_RELAXED, __HIP_MEMORY_SCOPE_AGENT)) >= ((idx) >> 6))
#define P7B_WAIT(idx) do { while (!P7B_RDY(idx)) __builtin_amdgcn_s_sleep(4); P7_CONS_ACQ(); } while (0)
#define P7B_FETCHQ(idx, QR) do { const int c_ = (idx) >> 6, bh_ = (idx) & 63; \
        const Slot qs_ = gdn_slot(F.ws, bh_, c_, 0); \
        _Pragma("unroll") for (int j = 0; j < 2; ++j) { const int pc_ = t_ + 512 * j, r = pc_ >> 4; QR[j] = *(const u32x4*)(qs_.base + (size_t)r * qs_.stride + (pc_ & 15) * 16); } } while (0)
#define P7B_FETCHA(idx, QR, SB) do { const int c_ = (idx) >> 6, bh_ = (idx) & 63; \
        const SSlot sl_ = p7_sslot((c_ > 0 ? c_ - 1 : 0) * (NB * GH) + bh_); const __amdgpu_buffer_rsrc_t rs_ = p7_srsrc(F, sl_);        \
        _Pragma("unroll") for (int ks = 0; ks < 4; ++ks) SB[ks] = __builtin_bit_cast(bf16x8, __builtin_amdgcn_raw_buffer_load_b128(rs_, sl_.off + (unsigned)(((ks * 8 + w) * 64 + l) * 16), 0,   16)); } while (0)
#define P7B_PUT(k, QR) do { LAS unsigned char* qt_ = F.lds + ((k) & 1) * 16384; \
        _Pragma("unroll") for (int j = 0; j < 2; ++j) { const int pc_ = t_ + 512 * j, r = pc_ >> 4; *(LAS u32x4*)(qt_ + r * 256 + (((pc_ & 15) ^ (r & 15)) << 4)) = QR[j]; } } while (0)
#define P7B_FETCHB(idx, VALID, OL0, OL1, GT0, GT1, OO) do { const int c_ = (idx) >> 6, bh_ = (idx) & 63, b_ = bh_ >> 3, h_ = bh_ & 7; \
        const int nrow_ = gdn_row(b_, c_, ni); const int o_ = (nrow_ >= 0 ? nrow_ : 0) * DM + 128 * h_ + 16 * part; \
        const bf16* olp_ = (c_ == 0) ? (const bf16*)(F.ws + WS_OL0) + (size_t)(h_ * 64 + ni) * 128 + 16 * part : ON + o_; \
        OL0 = *(const u32x4*)(olp_); OL1 = *(const u32x4*)(olp_ + 8); GT0 = *(const u32x4*)(GATE + o_); GT1 = *(const u32x4*)(GATE + o_ + 8); \
        OO = (nrow_ >= 0 && (VALID)) ? o_ : -1; } while (0)
#define P7B_NORM(OT, OL0, OL1, GT0, GT1, OO) do { \
        float o[16]; float ss = 0.f; \
        _Pragma("unroll") for (int e = 0; e < 4; ++e) { o[2 * e] = bflo(OL0[e]); o[2 * e + 1] = bfhi(OL0[e]); o[8 + 2 * e] = bflo(OL1[e]); o[8 + 2 * e + 1] = bfhi(OL1[e]); } \
        { const u32x4 q0 = *(const LAS u32x4*)((OT) + ni * 136 + 16 * part), q1 = *(const LAS u32x4*)((OT) + ni * 136 + 16 * part + 8); \
          _Pragma("unroll") for (int e = 0; e < 4; ++e) { o[2 * e] += bflo(q0[e]); o[2 * e + 1] += bfhi(q0[e]); o[8 + 2 * e] += bflo(q1[e]); o[8 + 2 * e + 1] += bfhi(q1[e]); } } \
        _Pragma("unroll") for (int e = 0; e < 16; ++e) ss += o[e] * o[e]; \
        ss += __shfl_xor(ss, 1); ss += __shfl_xor(ss, 2); ss += __shfl_xor(ss, 4); \
        const float rn = 1.f / sqrtf(ss * (1.f / 128.f) + EPS); \
        float gt[16]; \
        _Pragma("unroll") for (int e = 0; e < 4; ++e) { gt[2 * e] = bflo(GT0[e]); gt[2 * e + 1] = bfhi(GT0[e]); gt[8 + 2 * e] = bflo(GT1[e]); gt[8 + 2 * e + 1] = bfhi(GT1[e]); } \
        float v[16]; \
        _Pragma("unroll") for (int e = 0; e < 16; ++e) v[e] = o[e] * rn * onv[e] * siluf_(gt[e]); \
        u32x4 s0, s1; \
        _Pragma("unroll") for (int e = 0; e < 4; ++e) { s0[e] = pk2(v[2 * e], v[2 * e + 1]); s1[e] = pk2(v[8 + 2 * e], v[8 + 2 * e + 1]); } \
        bf16* dst_ = (OO) >= 0 ? ON + (OO) : dump; \
        *(u32x4*)(dst_) = s0; *(u32x4*)(dst_ + 8) = s1; } while (0)
#define P7B_ITER(k, FIRST, SBC, SBN, OLP0, OLP1, GTP0, GTP1, OOP, OLQ0, OLQ1, GTQ0, GTQ1, OOQ) do { \
        const int idt_ = bx + G * (k), idc_ = idt_ < NITEM ? idt_ : NITEM - 1, idn_ = idt_ + G < NITEM ? idt_ + G : idc_;        \
        const bool rdy_ = P7B_RDY(idn_);        \
        P7B_FETCHQ(idn_, qr);        \
        if (rdy_) { P7_CONS_ACQ(); P7B_FETCHA(idn_, qr, SBN); } \
        P7B_FETCHB(idc_, idt_ < NITEM, OLQ0, OLQ1, GTQ0, GTQ1, OOQ); \
        if (!(FIRST)) P7B_NORM(Obase + (((k) - 1) & 1) * (64 * 136), OLP0, OLP1, GTP0, GTP1, OOP); \
        { LAS unsigned short* O = Obase + ((k) & 1) * (64 * 136); const LAS unsigned char* QT = F.lds + ((k) & 1) * 16384; const bool zs_ = idc_ < NB * GH;        \
            _Pragma("unroll") for (int it = 0; it < 4; ++it) { f32x4 o = z4; const int r = 16 * it + fr; \
                _Pragma("unroll") for (int ks = 0; ks < 4; ++ks) o = MFMA16(p7_ld16(QT, r, 4 * ks + fq), SBC[ks], o); \
                _Pragma("unroll") for (int rr = 0; rr < 4; ++rr) O[(16 * it + 4 * fq + rr) * 136 + dv] = zs_ ? (unsigned short)0 : (unsigned short)(pk2(o[rr], 0.f) & 0xffffu); } } \
        if (!rdy_) { P7B_WAIT(idn_); P7B_FETCHA(idn_, qr, SBN); } \
        P7B_PUT((k) + 1, qr); \
        asm volatile("s_waitcnt lgkmcnt(0)\n\ts_barrier" ::: "memory"); } while (0)
    bf16* dump = (bf16*)(F.ws + WS_MISC) + (size_t)t_ * 16;
    u32x4 qr[2]; bf16x8 sba[4], sbb[4];
    u32x4 pl0, pl1, pg0, pg1, ql0, ql1, qg0, qg1; int poo = -1, qoo = -1;
    __syncthreads();
    const int K = (NITEM + G - 1) / G;
    P7B_FETCHQ(bx, qr);
    P7B_WAIT(bx);
    P7B_FETCHA(bx, qr, sba);
    P7B_PUT(0, qr);
    asm volatile("s_waitcnt vmcnt(0) lgkmcnt(0)" ::: "memory");
    __syncthreads();
    P7B_ITER(0, true, sba, sbb, pl0, pl1, pg0, pg1, poo, ql0, ql1, qg0, qg1, qoo);
    int k = 1;
    for (; k + 1 < K; k += 2) {
        P7B_ITER(k, false, sbb, sba, ql0, ql1, qg0, qg1, qoo, pl0, pl1, pg0, pg1, poo);
        P7B_ITER(k + 1, false, sba, sbb, pl0, pl1, pg0, pg1, poo, ql0, ql1, qg0, qg1, qoo);
    }
    if (k < K) { P7B_ITER(k, false, sbb, sba, ql0, ql1, qg0, qg1, qoo, pl0, pl1, pg0, pg1, poo);
        P7B_NORM(Obase + (k & 1) * (64 * 136), pl0, pl1, pg0, pg1, poo); }
    else { P7B_NORM(Obase + ((k - 1) & 1) * (64 * 136), ql0, ql1, qg0, qg1, qoo); }
#undef P7B_ITER
#undef P7B_NORM
#undef P7B_FETCHB
#undef P7B_PUT
#undef P7B_FETCHA
#undef P7B_FETCHQ
#undef P7B_RDY
#undef P7B_WAIT
    __syncthreads();
}
__device__ __forceinline__ void p7_sample(Frame& F, int sh) {
    const int s = sh >> 3, h = sh & 7, t = F.tid, row = ROWS_P + s;
    LAS float* qkv = (LAS float*)F.lds;
    LAS float* part = (LAS float*)(F.lds + 2048);
    LAS float* red = (LAS float*)(F.lds + 4096);
    const bf16* QKV = (const bf16*)(F.ws + WS_BIG); const float* AB = (const float*)(F.ws + WS_AB);
    if (t < 384) qkv[t] = bflo((unsigned)QKV[(size_t)row * GCONV + (t >> 7) * 1024 + 128 * h + (t & 127)]);
    __syncthreads();
    if (F.wave < 2) { const float a0 = qkv[F.wave * 128 + F.lane], a1 = qkv[F.wave * 128 + 64 + F.lane]; const float ssum = wave_sum(a0 * a0 + a1 * a1); if (F.lane == 0) red[F.wave] = ssum; }
    __syncthreads();
    const float rq = 0.08838834764831845f / sqrtf(red[0] + 1e-6f), rk = 1.f / sqrtf(red[1] + 1e-6f);
    const float a = ldv_f32(AB + (size_t)row * 16 + h), bq = ldv_f32(AB + (size_t)row * 16 + 8 + h);
    const float eg = __expf(-__expf(F.in[22][h]) * softplusf_(a + F.in[23][h])), be = sigmoidf_(bq);
    const int j = t & 127, qd = t >> 7;
    const float* S0 = F.in[4] + ((size_t)sh * 128 + 32 * qd) * 128 + j; float* S1 = F.out + O_SGDN + ((size_t)sh * 128 + 32 * qd) * 128 + j;
    float s0[32]; float ks = 0.f;
#pragma unroll
    for (int e = 0; e < 32; ++e) { s0[e] = S0[(size_t)e * 128]; ks += qkv[128 + 32 * qd + e] * s0[e]; }
    part[qd * 128 + j] = ks * rk;
    __syncthreads();
    const float kS = part[j] + part[128 + j] + part[256 + j] + part[384 + j];
    const float vnew = be * (qkv[256 + j] - eg * kS);
    __syncthreads();
    float op = 0.f;
#pragma unroll
    for (int e = 0; e < 32; ++e) { const float v1 = eg * s0[e] + qkv[128 + 32 * qd + e] * rk * vnew; S1[(size_t)e * 128] = v1; op += qkv[32 * qd + e] * v1; }
    part[qd * 128 + j] = op * rq;
    __syncthreads();
    const float o = part[j] + part[128 + j] + part[256 + j] + part[384 + j];
    { const float ssum = wave_sum(o * o); if (F.lane == 0) red[2 + F.wave] = ssum; }
    __syncthreads();
    if (t < 128) { const float rn = 1.f / sqrtf((red[2] + red[3]) * (1.f / 128.f) + EPS);
        const float gt = bflo((unsigned)((const bf16*)(F.ws + WS_B2))[(size_t)row * DM + 128 * h + j]);
        ((bf16*)(F.out + O_YP))[(size_t)row * DM + 128 * h + j] = (bf16)f2bf(o * rn * F.in[24][j] * siluf_(gt)); }
    __syncthreads();
}
__device__ __forceinline__ void p7_gdn_rec(Frame& F) {
    const int bx = (int)blockIdx.x;
    if (bx < NB * GH) p7_chain(F, bx, (GAS unsigned*)(F.ws + WS_CTL) + bx * 32);
    const int nsb = F.G - NB * GH;
    if (nsb > 0) { if (bx >= NB * GH) { for (int it = bx - NB * GH; it < NS * GH; it += nsb) p7_sample(F, it);
            p0_weights(F, 1, (bx - NB * GH) * NWAVES + F.wave, nsb * NWAVES);
#ifdef DUP_W1
            p0_weights(F, 1, (bx - NB * GH) * NWAVES + F.wave, nsb * NWAVES);
#endif
            } }
    else { for (int it = bx; it < NS * GH; it += F.G) p7_sample(F, it); p0_weights(F, 1, bx * NWAVES + F.wave, F.G * NWAVES); }
}

__device__ __forceinline__ void p11_final(Frame& F, const bf16* XB, const float* slab, int nsplit) {
    int t_ = (int)threadIdx.x; asm volatile("" : "+v"(t_)); const int lane = t_ & 63;
    const int gw = F.vcu * NWAVES + F.wave, NGW = F.G * NWAVES;
    const float* SS = (const float*)(F.ws + WS_SS); const float* nf = F.in[10];
    f32x4 nv[4];
#pragma unroll
    for (int j = 0; j < 4; ++j) nv[j] = *(const f32x4*)(nf + 4 * lane + 256 * j);
#define P11_LOAD(XV, SL, ROW) do { const int r_ = (ROW); \
        _Pragma("unroll") for (int j = 0; j < 4; ++j) XV[j] = *(const u32x2*)(XB + (size_t)r_ * DM + 4 * lane + 256 * j); \
        SL = (lane < 32 && r_ < 64 * 256) ? SS[(size_t)r_ * 32 + lane] : 0.f; } while (0)
#define P11_DO(XV, SL, ROW) do { const int row_ = (ROW); float* y = yrow_ptr(F.out, row_); \
        if (y) { f32x4 v[4]; float ss = 0.f; \
            _Pragma("unroll") for (int j = 0; j < 4; ++j) v[j] = (f32x4){bflo(XV[j].x), bfhi(XV[j].x), bflo(XV[j].y), bfhi(XV[j].y)}; \
            float rs; \
            if (row_ < 64 * 256) rs = 1.f / sqrtf(wave_sum(SL) * (1.f / DM) + EPS); \
            else {                     \
                const int r = row_ - 64 * 256; \
                _Pragma("unroll") for (int j = 0; j < 4; ++j) { \
                    for (int s = 0; s < nsplit; ++s) v[j] += *(const f32x4*)(slab + ((size_t)(j * nsplit + s) * 256 + r) * 256 + 4 * lane); \
                    ss += (v[j].x * v[j].x + v[j].y * v[j].y) + (v[j].z * v[j].z + v[j].w * v[j].w); } \
                rs = 1.f / sqrtf(wave_sum(ss) * (1.f / DM) + EPS); } \
            _Pragma("unroll") for (int j = 0; j < 4; ++j) *(f32x4*)(y + 4 * lane + 256 * j) = v[j] * rs * nv[j]; } } while (0)
    u32x2 xa[4], xb2[4]; float sla = 0.f, slb = 0.f;
    if (gw < ROWS) P11_LOAD(xa, sla, gw);
    if (gw + NGW < ROWS) P11_LOAD(xb2, slb, gw + NGW);
    for (int row = gw; row < ROWS; row += 2 * NGW) {
        P11_DO(xa, sla, row);
        if (row + 2 * NGW < ROWS) P11_LOAD(xa, sla, row + 2 * NGW);
        if (row + NGW < ROWS) { P11_DO(xb2, slb, row + NGW);
            if (row + 3 * NGW < ROWS) P11_LOAD(xb2, slb, row + 3 * NGW); }
    }
#undef P11_LOAD
#undef P11_DO
}

constexpr int NPHASE = 12;
__global__ void __launch_bounds__(NWAVES * 64, 2) hybrid_fwd(Args args) {
    extern __shared__ __attribute__((aligned(16))) unsigned char lds[];
    Frame F;
    F.lds = (LAS unsigned char*)lds;
    F.tid = threadIdx.x; F.lane = F.tid & 63; F.wave = __builtin_amdgcn_readfirstlane(F.tid >> 6);
    F.G = gridDim.x; { const int bx = blockIdx.x; F.vcu = (F.G % 8 == 0) ? (bx % 8) * (F.G / 8) + bx / 8 : bx; }
    F.in = args.in; F.out = args.out; F.ws = args.ws;
    for (int u = F.tid; u < (LDS_BYTES - LDSCTL_OFF) / 4; u += NWAVES * 64) ((LAS unsigned*)(F.lds + LDSCTL_OFF))[u] = 0u;
    __syncthreads();
#if !MK_PER_PHASE
    const XcdBarrier bar = xcd_barrier_post((unsigned*)(F.ws + WS_CTL) + 4096, (volatile LAS unsigned*)(F.lds + LDSCTL_OFF + 32));
#define GRID_BAR() xcd_barrier(bar)
#else
#define GRID_BAR() do {} while (0)
#endif
    const int lo = args.ph_lo, hi = args.ph_hi;
#ifdef PROBE_PHASE
    unsigned long long pr_t0 = 0, pr_t1 = 0, pr_ta = 0;
#define PROBE_BEGIN(k) do { if ((k) == PROBE_PHASE) pr_t0 = __builtin_amdgcn_s_memrealtime(); } while (0)
#ifdef PROBE_PRE
#define PROBE_PRE_END(k) do { if ((k) == PROBE_PHASE) pr_t1 = __builtin_amdgcn_s_memrealtime(); } while (0)
#define PROBE_END(k) do {} while (0)
#else
#define PROBE_PRE_END(k) do {} while (0)
#define PROBE_END(k) do { if ((k) == PROBE_PHASE) pr_t1 = __builtin_amdgcn_s_memrealtime(); } while (0)
#endif
#ifndef PROBE_BLOCK
#define PROBE_BLOCK 0
#endif
#else
#define PROBE_PRE_END(k) do {} while (0)
#define PROBE_BEGIN(k) do {} while (0)
#define PROBE_END(k) do {} while (0)
#endif
#if defined(PROBE_PHASE) && defined(PROBE_P7A)
#define P7A_END() do { if (PROBE_PHASE == 7) pr_ta = __builtin_amdgcn_s_memrealtime(); } while (0)
#else
#define P7A_END() do {} while (0)
#endif
#define IN(k) (lo <= (k) && (k) < hi)
#define BOTH(k) (IN(k) && IN((k) + 1))
    float* SS = (float*)(F.ws + WS_SS); bf16* ONB = (bf16*)(F.out + O_YP);
    bf16* B1 = (bf16*)(F.ws + WS_B1); bf16* B2 = (bf16*)(F.ws + WS_B2); bf16* BIG = (bf16*)(F.ws + WS_BIG);
    LAS unsigned char* ex = F.lds + EXCH_OFF; float* slab = (float*)(F.ws + WS_SLAB);

    PROBE_BEGIN(0); if (IN(0)) { p0_prologue(F); PROBE_PRE_END(0); if (BOTH(0)) GRID_BAR(); } PROBE_END(0);
    PROBE_BEGIN(1); if (IN(1)) { p1_s5(F); PROBE_PRE_END(1); if (BOTH(1)) GRID_BAR(); } PROBE_END(1);
    PROBE_BEGIN(2); if (IN(2)) {
        pg8::Gemm g{B2, (const bf16*)(F.ws + WS_WGLU), DM, 0, 0}; pg8::StaticOrder S; S.init(64, 8, F.G, (int)blockIdx.x, DM / 64, 4, 4);
        EpiGlu E{F.in[0], F.in[1], F.in[7], B1, SS, slab};
        pg8::gemm_phase<EpiGlu, pg8::StaticOrder, true, true>(F.lds, g, S, E);
        GRID_BAR(); glu_fixup(F, B1, SS, slab, 4);
        PROBE_PRE_END(2); if (BOTH(2)) GRID_BAR(); } PROBE_END(2);
    PROBE_BEGIN(3); if (IN(3)) {
#ifdef DRY_P3
        { pg8::Gemm g{B1, (const bf16*)(F.ws + WS_WUP0), DM, 2, 65}; pg8::StaticOrder S; S.init(66, 22, F.G, (int)blockIdx.x, DM / 64);
          EpiNull E{}; pg8::gemm_phase<EpiNull, pg8::StaticOrder, true, true>(F.lds, g, S, E); GRID_BAR(); }
#endif
        pg8::Gemm g{B1, (const bf16*)(F.ws + WS_WUP0), DM, 2, 65}; pg8::StaticOrder S; S.init(66, 22, F.G, (int)blockIdx.x, DM / 64);
        EpiUp E{BIG, SS, F.in[27], F.in[6], F.out + O_PFCONV, F.out + O_SFCONV, ex, 65};
        pg8::gemm_phase<EpiUp, pg8::StaticOrder, true, true>(F.lds, g, S, E);
        PROBE_PRE_END(3); if (BOTH(3)) GRID_BAR(); } PROBE_END(3);
    PROBE_BEGIN(4); if (IN(4)) {
        pg8::Gemm g{BIG, (const bf16*)(F.ws + WS_WDN0), DFF, 0, 0}; pg8::StaticOrder S; S.init(64, 4, F.G, (int)blockIdx.x, DFF / 64, 11, 4);
        EpiRes<false> E{B1, F.out, SS, slab};
        pg8::gemm_phase<EpiRes<false>, pg8::StaticOrder, true, true>(F.lds, g, S, E);
        GRID_BAR(); res_fixup<false>(F, B1, SS, slab, 11);
        PROBE_PRE_END(4); if (BOTH(4)) GRID_BAR(); } PROBE_END(4);
    PROBE_BEGIN(5); if (IN(5)) {
        pg8::Gemm g{B1, (const bf16*)(F.ws + WS_WIN), DM, 3, 66}; pg8::StaticOrder S; S.init(67, 17, F.G, (int)blockIdx.x, DM / 64);
        GAS unsigned* c0cnt = (GAS unsigned*)(F.ws + WS_CTL) + 3072;
        EpiIn E{BIG, B2, (float*)(F.ws + WS_AB), SS, F.in[21], F.in[5], F.out + O_PGCONV, F.out + O_SGCONV, ex, 66, c0cnt};
        pg8::gemm_phase<EpiIn, pg8::StaticOrder, true, true>(F.lds, g, S, E);
        __syncthreads();
        if (F.wave == 0) for (int h = F.G - 1 - (int)blockIdx.x; h < GH; h += F.G) {
            while (__hip_atomic_load(c0cnt, __ATOMIC_RELAXED, __HIP_MEMORY_SCOPE_AGENT) < 17u) __builtin_amdgcn_s_sleep(8);
            __builtin_amdgcn_fence(__ATOMIC_ACQUIRE, "agent"); asm volatile("s_waitcnt vmcnt(0)" ::: "memory");
            p6_item<true>(F, h, 0, F.lds); }
        PROBE_PRE_END(5); if (BOTH(5)) GRID_BAR(); } PROBE_END(5);
    PROBE_BEGIN(6); if (IN(6)) { p6_gdn_pre(F); PROBE_PRE_END(6); if (BOTH(6)) GRID_BAR(); } PROBE_END(6);
    PROBE_BEGIN(7); if (IN(7)) { const int nsb = F.G - NB * GH; const bool flow = nsb >= NB * GH;
        p7_gdn_rec(F); P7A_END(); if (!flow) GRID_BAR();
        if (!flow || (int)blockIdx.x >= NB * GH) p7_opart(F, flow ? (int)blockIdx.x - NB * GH : (int)blockIdx.x, flow ? nsb : F.G, flow, (GAS unsigned*)(F.ws + WS_CTL));
        PROBE_PRE_END(7); if (BOTH(7)) GRID_BAR(); } PROBE_END(7);
    PROBE_BEGIN(8); if (IN(8)) {
        pg8::Gemm g{ONB, (const bf16*)(F.ws + WS_WO), DM, 0, 0}; pg8::StaticOrder S; S.init(64, 4, F.G, (int)blockIdx.x, DM / 64, 8, 2);
        EpiRes<false> E{B1, F.out, SS, slab};
        pg8::gemm_phase<EpiRes<false>, pg8::StaticOrder, true, true>(F.lds, g, S, E);
        GRID_BAR(); res_fixup<false>(F, B1, SS, slab, 8);
        PROBE_PRE_END(8); if (BOTH(8)) GRID_BAR(); } PROBE_END(8);
    PROBE_BEGIN(9); if (IN(9)) {
        pg8::Gemm g{B1, (const bf16*)(F.ws + WS_WUP1), DM, 2, 65}; pg8::StaticOrder S; S.init(66, 22, F.G, (int)blockIdx.x, DM / 64);
        EpiUp E{BIG, SS, F.in[27] + 3 * UPN, F.in[6] + (size_t)NS * 2 * UPN, F.out + O_PFCONV + (size_t)NB * 2 * UPN, F.out + O_SFCONV + (size_t)NS * 2 * UPN, ex, 65};
        pg8::gemm_phase<EpiUp, pg8::StaticOrder, true, true>(F.lds, g, S, E);
        PROBE_PRE_END(9); if (BOTH(9)) GRID_BAR(); } PROBE_END(9);
    PROBE_BEGIN(10); if (IN(10)) {
        pg8::Gemm g{BIG, (const bf16*)(F.ws + WS_WDN1), DFF, 0, 0}; pg8::StaticOrder S; S.init(64, 4, F.G, (int)blockIdx.x, DFF / 64, 11, 4);
        EpiRes<false> E{B1, F.out, SS, slab};
        pg8::gemm_phase<EpiRes<false>, pg8::StaticOrder, true, true>(F.lds, g, S, E);
        PROBE_PRE_END(10); if (BOTH(10)) GRID_BAR(); } PROBE_END(10);
    PROBE_BEGIN(11); if (IN(11)) p11_final(F, B1, slab, 11); PROBE_END(11);
#ifdef SEG_ID
    __syncthreads();
    if (F.vcu == SEG_BLOCK) { const unsigned long long tend = __builtin_amdgcn_s_memrealtime(), wait = *(volatile LAS unsigned long long*)(F.lds + LDSCTL_OFF + 64) * SEG_AMP; while (__builtin_amdgcn_s_memrealtime() - tend < wait) __builtin_amdgcn_s_sleep(8); }
#endif
#ifdef P6_SEG
    __syncthreads();
    if (blockIdx.x == 3) { const unsigned long long tend = __builtin_amdgcn_s_memrealtime(), wait = *(volatile LAS unsigned long long*)(F.lds + LDSCTL_OFF + 64) * P6_AMP; while (__builtin_amdgcn_s_memrealtime() - tend < wait) __builtin_amdgcn_s_sleep(8); }
#endif
#ifdef P7_SEG
    __syncthreads();
    if (blockIdx.x == 0) { const unsigned long long tend = __builtin_amdgcn_s_memrealtime(), wait = *(volatile LAS unsigned long long*)(F.lds + LDSCTL_OFF + 64) * P7_AMP; while (__builtin_amdgcn_s_memrealtime() - tend < wait) __builtin_amdgcn_s_sleep(8); }
#endif
#ifdef PROBE_PHASE
#ifdef PROBE_P7A
    pr_t1 = pr_ta;
#endif
    if (F.vcu == PROBE_BLOCK) { const unsigned long long tend = __builtin_amdgcn_s_memrealtime(), wait = (pr_t1 - pr_t0) * PROBE_AMP; while (__builtin_amdgcn_s_memrealtime() - tend < wait) __builtin_amdgcn_s_sleep(8); }
#endif
#undef IN
#undef BOTH
}

extern "C" void kernel_launch(void* const* d_in, const int* in_sizes, int n_in, void* d_out, int out_size, void* d_ws, size_t ws_size, hipStream_t stream) {
    static int grid = 0;
    if (grid == 0) {
        if (n_in != 29 || (size_t)out_size != O_END || ws_size < WS_END) { fprintf(stderr, "kernel_launch: unexpected shapes (n_in %d, out %d, ws %zu); nothing launched\n", n_in, out_size, ws_size); grid = -1; return; }
        int dev = 0, cus = 0, per_cu = 0;
        if (hipGetDevice(&dev) != hipSuccess || hipDeviceGetAttribute(&cus, hipDeviceAttributeMultiprocessorCount, dev) != hipSuccess) { grid = -1; return; }
        if (hipFuncSetAttribute((const void*)hybrid_fwd, hipFuncAttributeMaxDynamicSharedMemorySize, LDS_BYTES) != hipSuccess) { fprintf(stderr, "kernel_launch: hipFuncSetAttribute failed\n"); grid = -1; return; }
        if (hipOccupancyMaxActiveBlocksPerMultiprocessor(&per_cu, (const void*)hybrid_fwd, NWAVES * 64, LDS_BYTES) != hipSuccess || per_cu < 1)
            fprintf(stderr, "kernel_launch: note: occupancy query reports %d workgroups per CU\n", per_cu);
        (void)hipGetLastError();
        grid = cus;
    }
    if (grid < 0) return;
    if (hipMemsetAsync((char*)d_ws + WS_CTL, 0, CTL_ZERO_BYTES, stream) != hipSuccess) { fprintf(stderr, "kernel_launch: memset failed\n"); return; }
    Args a{};
    for (int i = 0; i < 29; ++i) a.in[i] = (const float*)d_in[i];
    a.out = (float*)d_out; a.ws = (unsigned char*)d_ws;
#if MK_PER_PHASE
    for (int p = 0; p < NPHASE; ++p) { a.ph_lo = p; a.ph_hi = p + 1; hipLaunchKernelGGL(hybrid_fwd, dim3(grid), dim3(NWAVES * 64), LDS_BYTES, stream, a); }
#else
    a.ph_lo = 0; a.ph_hi = NPHASE;
    hipLaunchKernelGGL(hybrid_fwd, dim3(grid), dim3(NWAVES * 64), LDS_BYTES, stream, a);
#endif
    const hipError_t le = hipPeekAtLastError();
    if (le != hipSuccess) fprintf(stderr, "kernel_launch: launch failed: %s\n", hipGetErrorName(le));
}
```
